# Optimizing an MI355X kernel written in HIP

```python
import math
import jax, jax.numpy as jnp
from jax import lax
import numpy as np

D_MODEL = 2048
BATCH = 4
SEQ = 4096
DEPTH = 4

N_HY = (DEPTH + 1) // 2
N_SSD = DEPTH // 2

LRU_WIDTH = D_MODEL // 2
LRU_HEADS = 8
LRU_BLOCK = LRU_WIDTH // LRU_HEADS
LRU_C = 8.0
CONV_K = 4

FOX_HEADS = 8
FOX_HEAD_DIM = (D_MODEL // 2) // FOX_HEADS
FOX_WIDTH = FOX_HEADS * FOX_HEAD_DIM
Q_BLOCK = 128

HY_IN = 2 * LRU_WIDTH + 3 * FOX_WIDTH + FOX_HEADS
MIX_WIDTH = LRU_WIDTH + FOX_WIDTH

SSD_INNER = 2 * D_MODEL
SSD_HEAD_DIM = 64
SSD_HEADS = SSD_INNER // SSD_HEAD_DIM
SSD_GROUPS = 8
SSD_STATE = 128
SSD_CHUNK = 128
SSD_CONV_DIM = SSD_INNER + 2 * SSD_GROUPS * SSD_STATE
SSD_IN = SSD_INNER + SSD_CONV_DIM + SSD_HEADS

MOE_GROUPS = 4
MOE_PER_GROUP = 4
MOE_TOPK = 2
MOE_FF = D_MODEL // 2

ALPHA = (2 * DEPTH) ** 0.25
BETA = (8 * DEPTH) ** -0.25
LN_EPS = 1e-5
RMS_EPS = 1e-5

kernel_name = "hybrid_rglru_fox_ssd_hmoe_deepnorm"


def layer_norm(x, g, b):
    xf = x.astype(jnp.float32)
    mu = jnp.mean(xf, axis=-1, keepdims=True)
    var = jnp.mean(jnp.square(xf - mu), axis=-1, keepdims=True)
    return ((xf - mu) * lax.rsqrt(var + LN_EPS) * g + b).astype(x.dtype)


def causal_dwconv(x, w, b):
    k_width = w.shape[0]
    s = x.shape[1]
    xp = jnp.pad(x, ((0, 0), (k_width - 1, 0), (0, 0)))
    out = b
    for k in range(k_width):
        out = out + xp[:, k:k + s] * w[k]
    return out


def rg_lru(xc, w_r, b_r, w_i, b_i, lam):
    bn, s, w = xc.shape
    xh = xc.reshape(bn, s, LRU_HEADS, LRU_BLOCK)
    r = jax.nn.sigmoid((jnp.einsum('bshi,hij->bshj', xh, w_r) + b_r).astype(jnp.float32)).reshape(bn, s, w)
    i = jax.nn.sigmoid((jnp.einsum('bshi,hij->bshj', xh, w_i) + b_i).astype(jnp.float32)).reshape(bn, s, w)
    log_a = -LRU_C * r * jax.nn.softplus(-lam.astype(jnp.float32))
    a = jnp.exp(log_a)
    u = jnp.sqrt(-jnp.expm1(2.0 * log_a)) * (i * xc.astype(jnp.float32))

    def combine(left, right):
        a1, b1 = left
        a2, b2 = right
        return a1 * a2, a2 * b1 + b2

    _, h = lax.associative_scan(combine, (a, u), axis=1)
    return h


def fox_attention(q, k, v, logf):
    bn, s, h, dh = q.shape
    nb = s // Q_BLOCK
    F = jnp.cumsum(logf, axis=1).transpose(0, 2, 1)
    qb = q.reshape(bn, nb, Q_BLOCK, h, dh).transpose(1, 0, 2, 3, 4)
    fb = F.reshape(bn, h, nb, Q_BLOCK).transpose(2, 0, 1, 3)
    kpos = jnp.arange(s)
    scale = dh ** -0.5

    def block(args):
        qi, fi, bi = args
        sc = jnp.einsum('bqhd,bkhd->bhqk', qi, k, preferred_element_type=jnp.float32) * scale
        sc = sc + fi[..., :, None] - F[:, :, None, :]
        qpos = bi * Q_BLOCK + jnp.arange(Q_BLOCK)
        sc = jnp.where(kpos[None, :] <= qpos[:, None], sc, -jnp.inf)
        p = jax.nn.softmax(sc, axis=-1)
        return jnp.einsum('bhqk,bkhd->bqhd', p.astype(v.dtype), v)

    out = lax.map(block, (qb, fb, jnp.arange(nb)))
    return out.transpose(1, 0, 2, 3, 4).reshape(bn, s, h, dh)


def hybrid_mixer(x, w_in, conv_w, conv_b, w_r, b_r, w_i, b_i, lam, b_f, w_out):
    bn, s, _ = x.shape
    proj = x @ w_in
    o1 = LRU_WIDTH
    o2 = 2 * LRU_WIDTH
    o3 = o2 + FOX_WIDTH
    o4 = o3 + FOX_WIDTH
    o5 = o4 + FOX_WIDTH
    xl, gate, q, k, v, fl = jnp.split(proj, [o1, o2, o3, o4, o5], axis=-1)
    xc = causal_dwconv(xl, conv_w, conv_b)
    h = rg_lru(xc, w_r, b_r, w_i, b_i, lam)
    y_lru = (h * jax.nn.gelu(gate.astype(jnp.float32))).astype(x.dtype)
    logf = jax.nn.log_sigmoid(fl.astype(jnp.float32) + b_f)
    shp = (bn, s, FOX_HEADS, FOX_HEAD_DIM)
    y_att = fox_attention(q.reshape(shp), k.reshape(shp), v.reshape(shp), logf).reshape(bn, s, FOX_WIDTH)
    return jnp.concatenate([y_lru, y_att.astype(x.dtype)], axis=-1) @ w_out


def ssd_scan(xs, dt, A, bm, cm):
    bn, s, h, p = xs.shape
    g = bm.shape[2]
    n = bm.shape[3]
    e = h // g
    L = SSD_CHUNK
    nc = s // L
    X = (xs * dt[..., None]).reshape(bn, nc, L, g, e, p)
    acs = jnp.cumsum((dt * A).reshape(bn, nc, L, g, e), axis=2)
    bc = bm.reshape(bn, nc, L, g, n)
    cc = cm.reshape(bn, nc, L, g, n)
    seg = acs[:, :, :, None] - acs[:, :, None, :]
    causal = jnp.tril(jnp.ones((L, L), dtype=bool))
    decay = jnp.exp(jnp.where(causal[:, :, None, None], seg, -jnp.inf))
    cb = jnp.einsum('bclgn,bcsgn->bclsg', cc, bc)
    y_diag = jnp.einsum('bclsge,bcsgep->bclgep', cb[..., None] * decay, X)
    xd = X * jnp.exp(acs[:, :, -1:] - acs)[..., None]
    states = jnp.einsum('bclgn,bclgep->bcgepn', bc, xd)
    chunk_decay = jnp.exp(acs[:, :, -1])

    def step(carry, inp):
        st, dec = inp
        return carry * dec[..., None, None] + st, carry

    init = jnp.zeros((bn, g, e, p, n), dtype=jnp.float32)
    _, prev = lax.scan(step, init, (states.transpose(1, 0, 2, 3, 4, 5), chunk_decay.transpose(1, 0, 2, 3)))
    prev = prev.transpose(1, 0, 2, 3, 4, 5)
    y_off = jnp.einsum('bclgn,bcgepn->bclgep', cc, prev) * jnp.exp(acs)[..., None]
    return (y_diag + y_off).reshape(bn, s, h, p)


def ssd_mixer(x, w_in, conv_w, conv_b, dt_bias, a_log, d_skip, norm_g, w_out):
    bn, s, _ = x.shape
    proj = x @ w_in
    z, xbc, dt = jnp.split(proj, [SSD_INNER, SSD_INNER + SSD_CONV_DIM], axis=-1)
    xbc = jax.nn.silu(causal_dwconv(xbc, conv_w, conv_b).astype(jnp.float32))
    xs, bm, cm = jnp.split(xbc, [SSD_INNER, SSD_INNER + SSD_GROUPS * SSD_STATE], axis=-1)
    xs = xs.reshape(bn, s, SSD_HEADS, SSD_HEAD_DIM)
    bm = bm.reshape(bn, s, SSD_GROUPS, SSD_STATE)
    cm = cm.reshape(bn, s, SSD_GROUPS, SSD_STATE)
    dt = jax.nn.softplus(dt.astype(jnp.float32) + dt_bias)
    A = -jnp.exp(a_log.astype(jnp.float32))
    y = ssd_scan(xs, dt, A, bm, cm) + d_skip.astype(jnp.float32)[:, None] * xs
    y = y.reshape(bn, s, SSD_INNER) * jax.nn.silu(z.astype(jnp.float32))
    yg = y.reshape(bn, s, SSD_GROUPS, SSD_INNER // SSD_GROUPS)
    yg = yg * lax.rsqrt(jnp.mean(jnp.square(yg), axis=-1, keepdims=True) + RMS_EPS)
    y = yg.reshape(bn, s, SSD_INNER) * norm_g
    return y.astype(x.dtype) @ w_out


def hier_moe(x, w_r1, b_r1, w_r2, b_r2, w_gate, w_up, w_down):
    bn, s, d = x.shape
    t = x.reshape(-1, d)
    p1 = jax.nn.softmax((t @ w_r1).astype(jnp.float32) + b_r1, axis=-1)
    pg, g_idx = lax.top_k(p1, 1)
    l2 = jnp.einsum('td,gde->tge', t, w_r2).astype(jnp.float32) + b_r2
    l2 = jnp.take_along_axis(l2, g_idx[:, :, None], axis=1)[:, 0]
    v2, e_idx = lax.top_k(l2, MOE_TOPK)
    p2 = jax.nn.softmax(v2, axis=-1)
    w_e = jnp.einsum('tk,tke->te', p2, jax.nn.one_hot(e_idx, MOE_PER_GROUP, dtype=jnp.float32))
    comb = (pg * jax.nn.one_hot(g_idx[:, 0], MOE_GROUPS, dtype=jnp.float32))[:, :, None] * w_e[:, None, :]
    comb = comb.astype(x.dtype)
    out = jnp.zeros_like(t)
    for gi in range(MOE_GROUPS):
        for ei in range(MOE_PER_GROUP):
            hid = jax.nn.silu(t @ w_gate[gi, ei]) * (t @ w_up[gi, ei])
            out = out + (hid * comb[:, gi, ei, None]) @ w_down[gi, ei]
    return out.reshape(bn, s, d)


def setup_inputs(seed: int = 0) -> dict:
    key = jax.random.key(seed)
    ks = jax.random.split(key, 32)

    def nrm(k, shape, scale):
        return jax.random.normal(k, shape, jnp.float32) * scale

    x = nrm(ks[0], (BATCH, SEQ, D_MODEL), 1.0)
    ln_g = 1.0 + nrm(ks[1], (DEPTH, 2, D_MODEL), 0.02)
    ln_b = nrm(ks[2], (DEPTH, 2, D_MODEL), 0.02)

    hy_w_in = nrm(ks[3], (N_HY, D_MODEL, HY_IN), D_MODEL ** -0.5)
    hy_conv_w = nrm(ks[4], (N_HY, CONV_K, LRU_WIDTH), CONV_K ** -0.5)
    hy_conv_b = nrm(ks[5], (N_HY, LRU_WIDTH), 0.02)
    hy_w_r = nrm(ks[6], (N_HY, LRU_HEADS, LRU_BLOCK, LRU_BLOCK), LRU_BLOCK ** -0.5)
    hy_b_r = nrm(ks[7], (N_HY, LRU_HEADS, LRU_BLOCK), 0.02)
    hy_w_i = nrm(ks[8], (N_HY, LRU_HEADS, LRU_BLOCK, LRU_BLOCK), LRU_BLOCK ** -0.5)
    hy_b_i = nrm(ks[9], (N_HY, LRU_HEADS, LRU_BLOCK), 0.02)
    u = jax.random.uniform(ks[10], (N_HY, LRU_WIDTH), jnp.float32, 0.9, 0.999)
    sg = u ** (1.0 / LRU_C)
    hy_lambda = jnp.log(sg) - jnp.log1p(-sg)
    hy_b_f = jnp.linspace(2.0, 6.0, FOX_HEADS, dtype=jnp.float32)[None, :] + nrm(ks[11], (N_HY, FOX_HEADS), 0.1)
    hy_w_out = nrm(ks[12], (N_HY, MIX_WIDTH, D_MODEL), BETA * MIX_WIDTH ** -0.5)

    ssd_w_in = nrm(ks[13], (N_SSD, D_MODEL, SSD_IN), D_MODEL ** -0.5)
    ssd_conv_w = nrm(ks[14], (N_SSD, CONV_K, SSD_CONV_DIM), CONV_K ** -0.5)
    ssd_conv_b = nrm(ks[15], (N_SSD, SSD_CONV_DIM), 0.02)
    ud = jax.random.uniform(ks[16], (N_SSD, SSD_HEADS), jnp.float32)
    dt0 = jnp.exp(ud * (math.log(0.1) - math.log(0.001)) + math.log(0.001))
    ssd_dt_bias = dt0 + jnp.log(-jnp.expm1(-dt0))
    ssd_a_log = jnp.log(jax.random.uniform(ks[17], (N_SSD, SSD_HEADS), jnp.float32, 1.0, 16.0))
    ssd_d = 1.0 + nrm(ks[18], (N_SSD, SSD_HEADS), 0.1)
    ssd_norm_g = 1.0 + nrm(ks[19], (N_SSD, SSD_INNER), 0.02)
    ssd_w_out = nrm(ks[20], (N_SSD, SSD_INNER, D_MODEL), BETA * SSD_INNER ** -0.5)

    moe_w_r1 = nrm(ks[21], (DEPTH, D_MODEL, MOE_GROUPS), D_MODEL ** -0.5)
    moe_b_r1 = nrm(ks[22], (DEPTH, MOE_GROUPS), 0.01)
    moe_w_r2 = nrm(ks[23], (DEPTH, MOE_GROUPS, D_MODEL, MOE_PER_GROUP), D_MODEL ** -0.5)
    moe_b_r2 = nrm(ks[24], (DEPTH, MOE_GROUPS, MOE_PER_GROUP), 0.01)
    moe_w_gate = nrm(ks[25], (DEPTH, MOE_GROUPS, MOE_PER_GROUP, D_MODEL, MOE_FF), D_MODEL ** -0.5)
    moe_w_up = nrm(ks[26], (DEPTH, MOE_GROUPS, MOE_PER_GROUP, D_MODEL, MOE_FF), D_MODEL ** -0.5)
    moe_w_down = nrm(ks[27], (DEPTH, MOE_GROUPS, MOE_PER_GROUP, MOE_FF, D_MODEL), BETA * MOE_FF ** -0.5)

    return {
        "x": x, "ln_g": ln_g, "ln_b": ln_b,
        "hy_w_in": hy_w_in, "hy_conv_w": hy_conv_w, "hy_conv_b": hy_conv_b,
        "hy_w_r": hy_w_r, "hy_b_r": hy_b_r, "hy_w_i": hy_w_i, "hy_b_i": hy_b_i,
        "hy_lambda": hy_lambda, "hy_b_f": hy_b_f, "hy_w_out": hy_w_out,
        "ssd_w_in": ssd_w_in, "ssd_conv_w": ssd_conv_w, "ssd_conv_b": ssd_conv_b,
        "ssd_dt_bias": ssd_dt_bias, "ssd_a_log": ssd_a_log, "ssd_d": ssd_d,
        "ssd_norm_g": ssd_norm_g, "ssd_w_out": ssd_w_out,
        "moe_w_r1": moe_w_r1, "moe_b_r1": moe_b_r1, "moe_w_r2": moe_w_r2, "moe_b_r2": moe_b_r2,
        "moe_w_gate": moe_w_gate, "moe_w_up": moe_w_up, "moe_w_down": moe_w_down,
    }


def reference(x, ln_g, ln_b,
              hy_w_in, hy_conv_w, hy_conv_b, hy_w_r, hy_b_r, hy_w_i, hy_b_i, hy_lambda, hy_b_f, hy_w_out,
              ssd_w_in, ssd_conv_w, ssd_conv_b, ssd_dt_bias, ssd_a_log, ssd_d, ssd_norm_g, ssd_w_out,
              moe_w_r1, moe_b_r1, moe_w_r2, moe_b_r2, moe_w_gate, moe_w_up, moe_w_down):
    for layer in range(DEPTH):
        j = layer // 2
        if layer % 2 == 0:
            m = hybrid_mixer(x, hy_w_in[j], hy_conv_w[j], hy_conv_b[j], hy_w_r[j], hy_b_r[j],
                             hy_w_i[j], hy_b_i[j], hy_lambda[j], hy_b_f[j], hy_w_out[j])
        else:
            m = ssd_mixer(x, ssd_w_in[j], ssd_conv_w[j], ssd_conv_b[j], ssd_dt_bias[j],
                          ssd_a_log[j], ssd_d[j], ssd_norm_g[j], ssd_w_out[j])
        x = layer_norm(ALPHA * x + m, ln_g[layer, 0], ln_b[layer, 0])
        f = hier_moe(x, moe_w_r1[layer], moe_b_r1[layer], moe_w_r2[layer], moe_b_r2[layer],
                     moe_w_gate[layer], moe_w_up[layer], moe_w_down[layer])
        x = layer_norm(ALPHA * x + f, ln_g[layer, 1], ln_b[layer, 1])
    return x
```

```cpp
#include <hip/hip_runtime.h>
#include <cstdio>
#include <cstdint>
namespace pg8 {
#define PG8_LAS __attribute__((address_space(3)))
typedef unsigned short bf16_t;
typedef short bf16x8 __attribute__((ext_vector_type(8)));
typedef float f32x4 __attribute__((ext_vector_type(4)));
typedef unsigned u32x4 __attribute__((ext_vector_type(4)));
constexpr int BM = 256, BK = 64, HALF = 128, HTB = HALF * BK * 2  , STAGE_BYTES = 8 * HTB, NXCD = 8, WGM = 8;

__host__ __device__ __forceinline__ int lds_byte(int r, int c) { const int st = (r >> 4) * 2 + (c >> 5), rr = r & 15, cc = c & 31, ob = rr * 64 + cc * 2; return st * 1024 + (ob ^ (((ob >> 9) & 1) << 5)); }
__host__ __device__ __forceinline__ void stage_rc(int b, int& R, int& C) { const int st = b / 1024, sb = b % 1024, swz = sb ^ (((sb >> 9) & 1) << 5); R = (st >> 1) * 16 + swz / 64; C = (st & 1) * 32 + (swz % 64) / 2; }
__host__ __device__ __forceinline__ int perm32(int rho) { const int n = rho >> 4, i = rho & 15; return 8 * (i >> 2) + 4 * n + (i & 3); }

struct Unit { int pm, pn, pb; };
struct Gemm { const bf16_t* A; const bf16_t* Bt; int M, N, K; };

struct StaticOrder {
    int nM, nN, nwg, G, c;
    __host__ __device__ void init(int M, int N, int G_, int c_) { nM = M / BM; nN = N / BM; nwg = nM * nN; G = G_; c = c_; }
    __host__ __device__ bool next(int i, Unit& u) const {
        const long L = (long)i * G + c; if (L >= nwg) return false;
        int wgid = (int)L; { const int q = nwg / NXCD, r = nwg % NXCD, xcd = wgid % NXCD, off = wgid / NXCD; wgid = (xcd < r ? xcd * (q + 1) : r * (q + 1) + (xcd - r) * q) + off; }
        const int nig = WGM * nN, gid = wgid / nig, fm = gid * WGM, gsz = (nM - fm) < WGM ? (nM - fm) : WGM;
        u.pm = fm + ((wgid % nig) % gsz); u.pn = (wgid % nig) / gsz; u.pb = u.pn; return true;
    }
    __device__ __forceinline__ void a_ready(const Unit&) const {}
    __device__ __forceinline__ void done(const Unit&) const {}
};
struct MoeOrder {
    int tab[17]; int G, c;
    __device__ bool next(int i, Unit& u) const {
        const int nt = tab[16]; const int L = i * G + c; if (L >= nt * 8) return false;
        const int wgid = (L & 7) * nt + (L >> 3); const int t = wgid >> 3, pn = wgid & 7;
        int E = 0;
#pragma unroll
        for (int e = 1; e < 16; ++e) E += (t >= tab[e]) ? 1 : 0;
        u.pm = t; u.pn = pn; u.pb = E * 8 + pn; return true;
    }
    __device__ __forceinline__ void a_ready(const Unit&) const {}
    __device__ __forceinline__ void done(const Unit&) const {}
};
__device__ __forceinline__ unsigned cvt_pk_bf16(float lo, float hi) { unsigned r; asm volatile("v_cvt_pk_bf16_f32 %0, %1, %2" : "=v"(r) : "v"(lo), "v"(hi)); return r; }

struct EpiBf16P {
    static constexpr bool PERM = true, AFTER_DRAIN = false;
    bf16_t* O; int ldc;
    __device__ __forceinline__ void operator()(const f32x4 (&acc)[2][2][4][2], const Unit& u, int wr, int wc, int fr, int fq) const {
        const int row0 = u.pm * BM + wr * 64 + fr, col0 = u.pn * BM + wc * 32 + 8 * fq;
#pragma unroll
        for (int ai = 0; ai < 2; ++ai)
#pragma unroll
            for (int m = 0; m < 4; ++m) { bf16_t* rowp = O + (size_t)(row0 + ai * HALF + m * 16) * ldc + col0;
#pragma unroll
                for (int bj = 0; bj < 2; ++bj) { const f32x4 v0 = acc[ai][bj][m][0], v1 = acc[ai][bj][m][1];
                    u32x4 w; w.x = cvt_pk_bf16(v0[0], v0[1]); w.y = cvt_pk_bf16(v0[2], v0[3]); w.z = cvt_pk_bf16(v1[0], v1[1]); w.w = cvt_pk_bf16(v1[2], v1[3]);
                    *(u32x4*)(rowp + bj * HALF) = w; } }
    }
};
__device__ __forceinline__ float silu_fast(float x) { return x * __builtin_amdgcn_rcpf(1.0f + __expf(-x)); }
struct EpiSwiglu {
    static constexpr bool PERM = true, AFTER_DRAIN = false;
    bf16_t* H; const float* rg; int ldc;
    __device__ __forceinline__ void operator()(const f32x4 (&acc)[2][2][4][2], const Unit& u, int wr, int wc, int fr, int fq) const {
        const int row0 = u.pm * BM + wr * 64 + fr, col0 = u.pn * HALF + wc * 32 + 8 * fq;
#pragma unroll
        for (int ai = 0; ai < 2; ++ai)
#pragma unroll
            for (int m = 0; m < 4; ++m) { const int row = row0 + ai * HALF + m * 16; const float gt = rg[row];
                const f32x4 g0 = acc[ai][0][m][0], g1 = acc[ai][0][m][1], u0 = acc[ai][1][m][0], u1 = acc[ai][1][m][1];
                float h[8];
#pragma unroll
                for (int i = 0; i < 4; ++i) { h[i] = silu_fast(g0[i]) * u0[i] * gt; h[4 + i] = silu_fast(g1[i]) * u1[i] * gt; }
                u32x4 w; w.x = cvt_pk_bf16(h[0], h[1]); w.y = cvt_pk_bf16(h[2], h[3]); w.z = cvt_pk_bf16(h[4], h[5]); w.w = cvt_pk_bf16(h[6], h[7]);
                *(u32x4*)(H + (size_t)row * ldc + col0) = w; }
    }
};
template <class Epi, class Sched, bool ALIGN_EPI = false, bool SP2 = false>
__device__ __forceinline__ void gemm_phase(PG8_LAS unsigned char* lds, const Gemm g, const Sched& S, const Epi& E) {
    int tid_ = threadIdx.x; asm volatile("" : "+v"(tid_));
    const int tid = tid_, wid = __builtin_amdgcn_readfirstlane(tid >> 6), lane = tid & 63, wr = wid >> 2, wc = wid & 3, fr = lane & 15, fq = lane >> 4;
    const int K = g.K, nt = K / BK;
    unsigned voffA[2], voffB[2];
#pragma unroll
    for (int i = 0; i < 2; ++i) { int R, C; stage_rc(tid * 16 + i * 8192, R, C); const int Rb = Epi::PERM ? ((R & ~31) + perm32(R & 31)) : R;
        voffA[i] = (unsigned)(R * K + C) * 2u; voffB[i] = (unsigned)(Rb * K + C) * 2u; }
    const size_t kstep = (size_t)(BK * 2);
    const size_t hstep = (size_t)HALF * K * 2;
    const size_t tstep = 2 * hstep;
    const unsigned ldsw = (unsigned)wid * 1024u;
    const int aoff = lds_byte(wr * 64 + fr, fq * 8), boff = lds_byte(wc * 32 + fr, fq * 8);
#define PG8_SA(b, h) (((b) * 2 + (h)) * HTB)
#define PG8_SB(b, h) ((4 + (b) * 2 + (h)) * HTB)
#define PG8_STAGE(bufoff, gbase, voff) do { _Pragma("unroll") for (int _i = 0; _i < 2; ++_i) \
        __builtin_amdgcn_global_load_lds((const unsigned*)((const char*)(gbase) + (voff)[_i]), (PG8_LAS unsigned*)(lds + (bufoff) + ldsw + _i * 8192), 16, 0, 0); } while (0)
#define PG8_LDA(dst, b, h) do { _Pragma("unroll") for (int m = 0; m < 4; ++m) _Pragma("unroll") for (int k = 0; k < 2; ++k) dst[m][k] = *(const PG8_LAS bf16x8*)(lds + PG8_SA(b, h) + aoff + m * 2048 + k * 1024); } while (0)
#define PG8_LDB(dst, b, h) do { _Pragma("unroll") for (int n = 0; n < 2; ++n) _Pragma("unroll") for (int k = 0; k < 2; ++k) dst[n][k] = *(const PG8_LAS bf16x8*)(lds + PG8_SB(b, h) + boff + n * 2048 + k * 1024); } while (0)
#define PG8_MMA(ai, bj, At, Bt) do { __builtin_amdgcn_s_setprio(1); _Pragma("unroll") for (int m = 0; m < 4; ++m) _Pragma("unroll") for (int n = 0; n < 2; ++n) _Pragma("unroll") for (int k = 0; k < 2; ++k) \
        acc[ai][bj][m][n] = __builtin_amdgcn_mfma_f32_16x16x32_bf16(Bt[n][k], At[m][k], acc[ai][bj][m][n], 0, 0, 0); __builtin_amdgcn_s_setprio(0); } while (0)
#define PG8_WAIT_V(n) asm volatile("s_waitcnt vmcnt(" #n ")" ::: "memory")
#define PG8_WAIT_L(n) asm volatile("s_waitcnt lgkmcnt(" #n ")" ::: "memory")
#define PG8_BAR __builtin_amdgcn_s_barrier()
#define PG8_SCHED __builtin_amdgcn_sched_barrier(0)
    Unit cur, nxt; int ui = 0;
    if (!S.next(0, cur)) return;
    f32x4 acc[2][2][4][2];
#pragma unroll
    for (int a = 0; a < 2; ++a)
#pragma unroll
        for (int b = 0; b < 2; ++b)
#pragma unroll
            for (int m = 0; m < 4; ++m)
#pragma unroll
                for (int n = 0; n < 2; ++n) acc[a][b][m][n] = (f32x4){0.f, 0.f, 0.f, 0.f};
    bf16x8 At[4][2], B0[2][2], B1[2][2];
    const char* cA = (const char*)g.A + (size_t)cur.pm * tstep; const char* cB = (const char*)g.Bt + (size_t)cur.pb * tstep;
    S.a_ready(cur);
    if constexpr (SP2) {
        PG8_STAGE(PG8_SB(0, 0), cB, voffB); PG8_STAGE(PG8_SB(0, 1), cB + hstep, voffB); PG8_STAGE(PG8_SA(0, 0), cA, voffA); PG8_STAGE(PG8_SA(0, 1), cA + hstep, voffA);
        if (wr == 1) PG8_BAR;
        PG8_WAIT_V(2); PG8_BAR;
        PG8_STAGE(PG8_SB(1, 0), cB + kstep, voffB); PG8_STAGE(PG8_SA(1, 0), cA + kstep, voffA); PG8_STAGE(PG8_SB(1, 1), cB + hstep + kstep, voffB);
        PG8_WAIT_V(6); PG8_BAR;
    } else {
        PG8_STAGE(PG8_SB(0, 0), cB, voffB); PG8_STAGE(PG8_SA(0, 0), cA, voffA); PG8_STAGE(PG8_SB(0, 1), cB + hstep, voffB); PG8_STAGE(PG8_SA(0, 1), cA + hstep, voffA);
        if (wr == 1) PG8_BAR;
        PG8_WAIT_V(4); PG8_BAR;
        PG8_STAGE(PG8_SB(1, 0), cB + kstep, voffB); PG8_STAGE(PG8_SA(1, 0), cA + kstep, voffA); PG8_STAGE(PG8_SB(1, 1), cB + hstep + kstep, voffB);
        PG8_WAIT_V(6); PG8_BAR;
    }
    for (;;) {
        const bool has_next = S.next(ui + 1, nxt);
        const char* nA = has_next ? (const char*)g.A + (size_t)nxt.pm * tstep : cA; const char* nB = has_next ? (const char*)g.Bt + (size_t)nxt.pb * tstep : cB;
        for (int t = 0; t < nt; t += 2) {
            const bool last = (t == nt - 2);
            const char* a1 = cA + (size_t)(t + 1) * kstep;
            const char* a2 = last ? nA : cA + (size_t)(t + 2) * kstep; const char* b2 = last ? nB : cB + (size_t)(t + 2) * kstep;
            const char* a3 = a2 + kstep; const char* b3 = b2 + kstep;
            if (last && has_next) S.a_ready(nxt);
            if constexpr (SP2) {
            PG8_LDB(B0, 0, 0); PG8_LDB(B1, 0, 1); PG8_SCHED; PG8_LDA(At, 0, 0); PG8_STAGE(PG8_SA(1, 1), a1 + hstep, voffA);
            PG8_WAIT_V(8); PG8_WAIT_L(0); PG8_BAR; PG8_MMA(0, 0, At, B0); PG8_MMA(0, 1, At, B1); PG8_BAR; PG8_SCHED;
            PG8_LDA(At, 0, 1); PG8_STAGE(PG8_SB(0, 0), b2, voffB); PG8_STAGE(PG8_SB(0, 1), b2 + hstep, voffB); PG8_STAGE(PG8_SA(0, 0), a2, voffA);
            PG8_WAIT_V(8); PG8_WAIT_L(0); PG8_BAR; PG8_MMA(1, 0, At, B0); PG8_MMA(1, 1, At, B1); PG8_BAR; PG8_SCHED;
            PG8_LDB(B0, 1, 0); PG8_LDB(B1, 1, 1); PG8_SCHED; PG8_LDA(At, 1, 0); PG8_STAGE(PG8_SA(0, 1), a2 + hstep, voffA);
            PG8_WAIT_V(8); PG8_WAIT_L(0); PG8_BAR; PG8_MMA(0, 0, At, B0); PG8_MMA(0, 1, At, B1); PG8_BAR; PG8_SCHED;
            PG8_LDA(At, 1, 1); PG8_STAGE(PG8_SB(1, 0), b3, voffB); PG8_STAGE(PG8_SB(1, 1), b3 + hstep, voffB); PG8_STAGE(PG8_SA(1, 0), a3, voffA);
            PG8_WAIT_V(8); PG8_WAIT_L(0); PG8_BAR; PG8_MMA(1, 0, At, B0); PG8_MMA(1, 1, At, B1); PG8_BAR; PG8_SCHED;
            } else {
            PG8_LDB(B0, 0, 0); PG8_SCHED; PG8_LDA(At, 0, 0); PG8_STAGE(PG8_SA(1, 1), a1 + hstep, voffA);
            PG8_WAIT_L(8); PG8_BAR; PG8_WAIT_L(0); PG8_MMA(0, 0, At, B0); PG8_BAR; PG8_SCHED;
            PG8_LDB(B1, 0, 1); PG8_STAGE(PG8_SB(0, 0), b2, voffB);
            PG8_BAR; PG8_WAIT_L(0); PG8_MMA(0, 1, At, B1); PG8_BAR;
            PG8_LDA(At, 0, 1); PG8_STAGE(PG8_SA(0, 0), a2, voffA);
            PG8_BAR; PG8_WAIT_L(0); PG8_MMA(1, 0, At, B0); PG8_BAR; PG8_SCHED;
            PG8_STAGE(PG8_SB(0, 1), b2 + hstep, voffB);
            PG8_WAIT_V(6); PG8_BAR; PG8_MMA(1, 1, At, B1); PG8_BAR;
            PG8_LDB(B0, 1, 0); PG8_SCHED; PG8_LDA(At, 1, 0); PG8_STAGE(PG8_SA(0, 1), a2 + hstep, voffA);
            PG8_WAIT_L(8); PG8_BAR; PG8_WAIT_L(0); PG8_MMA(0, 0, At, B0); PG8_BAR; PG8_SCHED;
            PG8_LDB(B1, 1, 1); PG8_STAGE(PG8_SB(1, 0), b3, voffB);
            PG8_BAR; PG8_WAIT_L(0); PG8_MMA(0, 1, At, B1); PG8_BAR;
            PG8_LDA(At, 1, 1); PG8_STAGE(PG8_SA(1, 0), a3, voffA);
            PG8_BAR; PG8_WAIT_L(0); PG8_MMA(1, 0, At, B0); PG8_BAR; PG8_SCHED;
            PG8_STAGE(PG8_SB(1, 1), b3 + hstep, voffB);
            PG8_WAIT_V(6); PG8_BAR; PG8_MMA(1, 1, At, B1); PG8_BAR;
            }
        }
        if constexpr (ALIGN_EPI) { if (wr == 0) PG8_BAR; }
        if constexpr (!Epi::AFTER_DRAIN) { E(acc, cur, wr, wc, fr, fq); S.done(cur); }
        if (!has_next) break;
#pragma unroll
        for (int a = 0; a < 2; ++a)
#pragma unroll
            for (int b = 0; b < 2; ++b)
#pragma unroll
                for (int m = 0; m < 4; ++m)
#pragma unroll
                    for (int n = 0; n < 2; ++n) acc[a][b][m][n] = (f32x4){0.f, 0.f, 0.f, 0.f};
        cur = nxt; cA = nA; cB = nB; ++ui;
        if constexpr (ALIGN_EPI) { if (wr == 1) PG8_BAR; }
    }
    PG8_WAIT_V(0);
    if constexpr (!ALIGN_EPI) { if (wr == 0) PG8_BAR; }
    PG8_BAR;
    if constexpr (Epi::AFTER_DRAIN) { E.fused(acc, cur, wr, wc, fr, fq, lds, wid, lane); S.done(cur); }
#undef PG8_SA
#undef PG8_SB
#undef PG8_STAGE
#undef PG8_LDA
#undef PG8_LDB
#undef PG8_MMA
#undef PG8_WAIT_V
#undef PG8_WAIT_L
#undef PG8_BAR
#undef PG8_SCHED
}
}
#ifndef PG8_SP2
#define PG8_SP2 true
#endif
#ifndef PG8_ALIGN
#define PG8_ALIGN true
#endif
constexpr int BATCH = 4, SEQ = 4096, T = BATCH * SEQ, D = 2048, DEPTH = 4;
constexpr int HY_N = 5128, HY_NP = 5376;
constexpr int SS_N = 10304, SS_NP = 10496;
constexpr int LRU_W = 1024;
constexpr int SSD_INNER = 4096, SSD_CONV = 6144, SSD_H = 64, SSD_P = 64, SSD_G = 8, SSD_NS = 128, SSD_L = 128, SSD_NC = SEQ / SSD_L;
constexpr int MOE_FF = 1024, MOE_E = 16, MOE_ROWS = 2 * T + MOE_E * 256;
constexpr float ALPHA = 1.6817928305074290f;
constexpr float LN_EPS = 1e-5f, RMS_EPS = 1e-5f;
constexpr int NWAVES = 8, NTHR = 512;
constexpr size_t MiB = 1u << 20;
constexpr size_t WS_CTL = 0, CTL_ZERO_BYTES = 1 * MiB;
constexpr size_t WS_TOKSLOT = 1 * MiB;
constexpr size_t WS_TOKPOS = WS_TOKSLOT + 512 * 1024;
constexpr size_t WS_ROWGATE = WS_TOKPOS + 128 * 1024;
constexpr size_t WS_WRI = 3 * MiB;
constexpr size_t WS_WHYIN = 4 * MiB;
constexpr size_t WS_WHYOUT = 46 * MiB;
constexpr size_t WS_WSSIN = 62 * MiB;
constexpr size_t WS_WSSOUT = 144 * MiB;
constexpr size_t WS_WGU = 176 * MiB;
constexpr size_t WS_WD = 304 * MiB;
constexpr size_t WS_X = 368 * MiB;
constexpr size_t WS_XB = 496 * MiB;
constexpr size_t WS_MBUF = 560 * MiB;
constexpr size_t WS_ARENA = 624 * MiB;
constexpr size_t WS_PROJ = WS_ARENA;
constexpr size_t WS_HLOC = WS_ARENA + 168 * MiB;
constexpr size_t WS_CUMA = WS_ARENA + 232 * MiB;
constexpr size_t WS_LSUM = WS_ARENA + 296 * MiB;
constexpr size_t WS_YMIX = WS_ARENA + 298 * MiB;
constexpr size_t WS_FCUM = WS_ARENA + 362 * MiB;
constexpr size_t WS_STATES = WS_ARENA + 328 * MiB;
constexpr size_t WS_YN = WS_ARENA + 456 * MiB;
constexpr size_t WS_DTB = WS_ARENA + 584 * MiB;
constexpr size_t WS_ACSB = WS_ARENA + 588 * MiB;
constexpr size_t WS_XG = WS_ARENA;
constexpr size_t WS_HID = WS_ARENA + 144 * MiB;
constexpr size_t WS_YG = WS_ARENA + 216 * MiB;
constexpr size_t WS_NAIVE = WS_ARENA + 600 * MiB;
constexpr size_t WS_END = WS_NAIVE + 460 * MiB;
constexpr int CW_TMO = 0, CW_CODE = 1, CW_CNT = 64  , CW_BAR = 4096;
constexpr int N_BAR_REGIONS = 8;
constexpr int RING_OFF = 0, RING_BYTES = 131072, LDSCTL_OFF = RING_BYTES, MISC_OFF = LDSCTL_OFF + 320, LDS_BYTES = 147456;
constexpr int TAB_OFF = LDSCTL_OFF;

#define GAS __attribute__((address_space(1)))
#define LAS __attribute__((address_space(3)))
typedef unsigned short bf16_t;
typedef unsigned v4u __attribute__((ext_vector_type(4)));
typedef unsigned v2u __attribute__((ext_vector_type(2)));
typedef float f32x4 __attribute__((ext_vector_type(4)));
typedef short bf16x8 __attribute__((ext_vector_type(8)));
typedef GAS unsigned gu32;
#define RLX_AGENT __ATOMIC_RELAXED, __HIP_MEMORY_SCOPE_AGENT
#define LDS_WAIT() asm volatile("s_waitcnt lgkmcnt(0)" ::: "memory")
#define VM_WAIT() asm volatile("s_waitcnt vmcnt(0)" ::: "memory")
__device__ __forceinline__ unsigned f2bf(float f) { unsigned u = __builtin_bit_cast(unsigned, f); return (u + 0x7fffu + ((u >> 16) & 1u)) >> 16; }
__device__ __forceinline__ unsigned pk2(float lo, float hi) { return f2bf(lo) | (f2bf(hi) << 16); }
__device__ __forceinline__ float bf2f(unsigned short v) { return __uint_as_float(((unsigned)v) << 16); }
__device__ __forceinline__ float bflo(unsigned w) { return __uint_as_float(w << 16); }
__device__ __forceinline__ float bfhi(unsigned w) { return __uint_as_float(w & 0xffff0000u); }
__device__ __forceinline__ float sigmoid_(float x) { return 1.0f / (1.0f + __expf(-x)); }
__device__ __forceinline__ float silu_(float x) { return x / (1.0f + __expf(-x)); }
__device__ __forceinline__ float softplus_(float x) { return x > 20.f ? x : log1pf(__expf(x)); }
__device__ __forceinline__ float gelu_tanh_(float x) { const float u = 0.7978845608028654f * (x + 0.044715f * x * x * x); return 0.5f * x * (1.0f + tanhf(u)); }
#define XB_TMO      128
#define XB_XCNT(j)  (256  + 64 * (j))
#define XB_XSUB(j)  (1280 + 64 * (j))
#define XB_XGEN(j)  (2304 + 64 * (j))
#define XB_TOP      3328
#define XB_TOPGEN   3392
#define XCD_BAR_WORDS 3456
#define XB_SPIN_CAP (1u << 18)

__device__ __forceinline__ unsigned xb_ld(unsigned* p)              { return __hip_atomic_load(p, __ATOMIC_RELAXED, __HIP_MEMORY_SCOPE_AGENT); }
__device__ __forceinline__ unsigned xb_add(unsigned* p, unsigned v) { return __hip_atomic_fetch_add(p, v, __ATOMIC_RELAXED, __HIP_MEMORY_SCOPE_AGENT); }
__device__ __forceinline__ unsigned xb_xcc_id() { return (unsigned)__builtin_amdgcn_s_getreg((3 << 11) | 20) & 0xFu; }
#define XB_SPIN(cond, bar) do { unsigned _sp = 0; while (cond) { __builtin_amdgcn_s_sleep(1); \
    if ((++_sp & 255u) == 0u) { if (xb_ld(&(bar)[XB_TMO])) break; if (_sp > XB_SPIN_CAP) { atomicAdd(&(bar)[XB_TMO], 1u); break; } } } } while (0)

struct XcdBarrier {
    unsigned* bar; unsigned x;
    volatile LAS unsigned* st;
};

__device__ __forceinline__ XcdBarrier xcd_barrier_post(unsigned* bar, volatile LAS unsigned* st) {
    XcdBarrier b; b.bar = bar; b.x = xb_xcc_id(); b.st = st;
    if (threadIdx.x == 0) (void)xb_add(&bar[XB_XCNT(b.x)], 1u);
    return b;
}
__device__ __forceinline__ void xcd_barrier_complete(unsigned* bar, unsigned x, unsigned& nloc, unsigned& nx) {
    const unsigned G = gridDim.x * gridDim.y * gridDim.z;
    unsigned sum, cnt, mine, sp = 0u;
    for (;;) {
        sum = 0u; cnt = 0u; mine = 0u;
#pragma unroll
        for (unsigned j = 0; j < 16; ++j) { const unsigned c = xb_ld(&bar[XB_XCNT(j)]); sum += c; cnt += (c > 0u) ? 1u : 0u; mine = (j == x) ? c : mine; }
        if (sum == G) break;
        __builtin_amdgcn_s_sleep(1);
        if ((++sp & 255u) == 0u) { if (xb_ld(&bar[XB_TMO])) break; if (sp > XB_SPIN_CAP) { atomicAdd(&bar[XB_TMO], 1u); break; } }
    }
    nloc = mine > 0u ? mine : 1u; nx = cnt > 0u ? cnt : 1u;
}

__device__ __forceinline__ void xcd_barrier(const XcdBarrier& b) {
    asm volatile("s_waitcnt vmcnt(0)" ::: "memory");
    __syncthreads();
    if (threadIdx.x == 0) {
        unsigned* bar = b.bar;
        __builtin_amdgcn_s_waitcnt(0);
        unsigned nloc = b.st[0], nx = b.st[1];
        if (nloc == 0u) { xcd_barrier_complete(bar, b.x, nloc, nx); b.st[0] = nloc; b.st[1] = nx; }
        const unsigned old = xb_add(&bar[XB_XSUB(b.x)], 1u);
        const unsigned gen = old / nloc;
        if (old + 1u == (gen + 1u) * nloc) {
            __builtin_amdgcn_fence(__ATOMIC_RELEASE, "agent");
            asm volatile("s_waitcnt vmcnt(0)" ::: "memory");
            const unsigned og = xb_add(&bar[XB_TOP], 1u);
            const unsigned tg = og / nx;
            if (og + 1u == (tg + 1u) * nx) xb_add(&bar[XB_TOPGEN], 1u);
            else XB_SPIN(xb_ld(&bar[XB_TOPGEN]) == tg, bar);
            __builtin_amdgcn_fence(__ATOMIC_ACQUIRE, "agent");
            xb_add(&bar[XB_XGEN(b.x)], 1u);
            asm volatile("s_waitcnt vmcnt(0)" ::: "memory");
        } else {
            XB_SPIN(xb_ld(&bar[XB_XGEN(b.x)]) == gen, bar);
            __builtin_amdgcn_fence(__ATOMIC_ACQUIRE, "agent");
            asm volatile("s_waitcnt vmcnt(0)" ::: "memory");
        }
    }
    __syncthreads();
}
struct Ctx {
    LAS unsigned char* lds;
    volatile LAS unsigned* MISC;
    gu32* ctl;
    int tid, lane, wave, vcu, G;
    const float* in[28];
    float* out; unsigned char* ws;
};
__device__ __forceinline__ float wave_sum(float v) {
#pragma unroll
    for (int o = 1; o < 64; o <<= 1) v += __shfl_xor(v, o);
    return v;
}
__device__ __forceinline__ void cvt_item(const float* W, int K, int N, bf16_t* WT, int mode, int row_off, LAS float* scr, int item, int nblk, int lane) {
    const int kb = item / nblk, nb = item - kb * nblk, k0 = 64 * kb, n0 = 32 * nb;
    const int nn = n0 + (lane & 31); const bool ok = nn < N;
#pragma unroll 8
    for (int i = 0; i < 32; ++i) { const int kk = 2 * i + (lane >> 5); scr[kk * 33 + (lane & 31)] = ok ? W[(size_t)(k0 + kk) * N + nn] : 0.f; }
    LDS_WAIT(); asm volatile("" ::: "memory");
    const int c = lane & 7;
#pragma unroll
    for (int j = 0; j < 4; ++j) { const int n = (lane >> 3) + 8 * j; const LAS float* s = scr + (8 * c) * 33 + n;
        v4u o; o.x = pk2(s[0 * 33], s[1 * 33]); o.y = pk2(s[2 * 33], s[3 * 33]); o.z = pk2(s[4 * 33], s[5 * 33]); o.w = pk2(s[6 * 33], s[7 * 33]);
        const int ns = n0 + n; const int drow = mode == 0 ? row_off + ns : ((ns >> 7) * 256 + (ns & 127) + (mode == 2 ? 128 : 0));
        *(GAS v4u*)(WT + (size_t)drow * K + k0 + 8 * c) = o; }
    LDS_WAIT(); asm volatile("" ::: "memory");
}
__device__ __forceinline__ void s0_convert(Ctx& F, int layer) {
    LAS float* scr = (LAS float*)(F.lds + RING_OFF + F.wave * 16384);
    const int gw = F.vcu * NWAVES + F.wave, NGW = F.G * NWAVES;
    bf16_t* WGU = (bf16_t*)(F.ws + WS_WGU); bf16_t* WD = (bf16_t*)(F.ws + WS_WD);
    const float* wg = F.in[25] + (size_t)layer * 16 * 2048 * 1024; const float* wu = F.in[26] + (size_t)layer * 16 * 2048 * 1024; const float* wd = F.in[27] + (size_t)layer * 16 * 1024 * 2048;
    for (int it = gw; it < 48 * 1024; it += NGW) {
        const int mat = it >> 10, r = it & 1023, E = mat / 3, which = mat - 3 * E;
        if (which == 0) cvt_item(wg + (size_t)E * 2048 * 1024, 2048, 1024, WGU + (size_t)E * 2048 * 2048, 1, 0, scr, r, 32, F.lane);
        else if (which == 1) cvt_item(wu + (size_t)E * 2048 * 1024, 2048, 1024, WGU + (size_t)E * 2048 * 2048, 2, 0, scr, r, 32, F.lane);
        else cvt_item(wd + (size_t)E * 1024 * 2048, 1024, 2048, WD + (size_t)E * 2048 * 1024, 0, 0, scr, r, 64, F.lane);
    }
    if (layer == 0) {
        constexpr int I_HI = 32 * (HY_NP / 32), I_HO = 32 * 64, I_SI = 32 * (SS_NP / 32), I_SO = 64 * 64, I_RI = 2 * 4;
        constexpr int NIT = 2 * I_HI + 2 * I_HO + 2 * I_SI + 2 * I_SO + 32 * I_RI;
        for (int it = gw; it < NIT; it += NGW) {
            int r = it;
            if (r < 2 * I_HI) { const int j = r / I_HI; r -= j * I_HI; cvt_item(F.in[3] + (size_t)j * 2048 * HY_N, 2048, HY_N, (bf16_t*)(F.ws + WS_WHYIN) + (size_t)j * HY_NP * 2048, 0, 0, scr, r, HY_NP / 32, F.lane); continue; } r -= 2 * I_HI;
            if (r < 2 * I_HO) { const int j = r / I_HO; r -= j * I_HO; cvt_item(F.in[12] + (size_t)j * 2048 * 2048, 2048, 2048, (bf16_t*)(F.ws + WS_WHYOUT) + (size_t)j * 2048 * 2048, 0, 0, scr, r, 64, F.lane); continue; } r -= 2 * I_HO;
            if (r < 2 * I_SI) { const int j = r / I_SI; r -= j * I_SI; cvt_item(F.in[13] + (size_t)j * 2048 * SS_N, 2048, SS_N, (bf16_t*)(F.ws + WS_WSSIN) + (size_t)j * SS_NP * 2048, 0, 0, scr, r, SS_NP / 32, F.lane); continue; } r -= 2 * I_SI;
            if (r < 2 * I_SO) { const int j = r / I_SO; r -= j * I_SO; cvt_item(F.in[20] + (size_t)j * 4096 * 2048, 4096, 2048, (bf16_t*)(F.ws + WS_WSSOUT) + (size_t)j * 2048 * 4096, 0, 0, scr, r, 64, F.lane); continue; } r -= 2 * I_SO;
            { const int m = r / I_RI; r -= m * I_RI; const int jh = m >> 1, which = m & 1;
              cvt_item((which ? F.in[8] : F.in[6]) + (size_t)jh * 128 * 128, 128, 128, (bf16_t*)(F.ws + WS_WRI) + (size_t)jh * 256 * 128, 0, which * 128, scr, r, 4, F.lane); }
        }
        const float* x = F.in[0]; bf16_t* XB = (bf16_t*)(F.ws + WS_XB);
        for (int m = gw; m < T; m += NGW) { const GAS f32x4* xr = (const GAS f32x4*)(x + (size_t)m * D) + F.lane; GAS v2u* o = (GAS v2u*)(XB + (size_t)m * D) + F.lane;
#pragma unroll
            for (int j = 0; j < 8; ++j) { const f32x4 v = xr[64 * j]; v2u w; w.x = pk2(v.x, v.y); w.y = pk2(v.z, v.w); o[64 * j] = w; } }
    }
}
template <int MODE> __device__ __forceinline__ void ln_phase(Ctx& F, int layer) {
    const float* xin = (MODE == 1 && layer == 0) ? F.in[0] : (const float*)(F.ws + WS_X);
    float* xout = (MODE == 2 && layer == DEPTH - 1) ? F.out : (float*)(F.ws + WS_X);
    bf16_t* XB = (bf16_t*)(F.ws + WS_XB);
    const float* gam = F.in[1] + (size_t)(layer * 2 + (MODE - 1)) * D; const float* bet = F.in[2] + (size_t)(layer * 2 + (MODE - 1)) * D;
    const bf16_t* MB = (const bf16_t*)(F.ws + WS_MBUF); const bf16_t* YG = (const bf16_t*)(F.ws + WS_YG); const int* TOKPOS = (const int*)(F.ws + WS_TOKPOS);
    LAS int* hist = (LAS int*)(F.lds + RING_OFF); LAS int* hbase = hist + 16; LAS int* sE = hist + 32; LAS int* sI = sE + 128; LAS float* sW = (LAS float*)(sI + 128);
    if (MODE == 1) { if (F.tid < 16) hist[F.tid] = 0; __syncthreads(); }
    const int rpb = T / F.G;
    for (int it = F.wave; it < rpb; it += NWAVES) {
        const int row = blockIdx.x * rpb + it;
        const GAS f32x4* xr = (const GAS f32x4*)(xin + (size_t)row * D) + F.lane;
        f32x4 v[8]; float s = 0.f;
        if (MODE == 1) { const GAS v2u* mr = (const GAS v2u*)(MB + (size_t)row * D) + F.lane;
#pragma unroll
            for (int j = 0; j < 8; ++j) { const f32x4 xv = xr[64 * j]; const v2u mw = mr[64 * j];
                v[j].x = ALPHA * xv.x + bflo(mw.x); v[j].y = ALPHA * xv.y + bfhi(mw.x); v[j].z = ALPHA * xv.z + bflo(mw.y); v[j].w = ALPHA * xv.w + bfhi(mw.y); }
        } else { const int p0 = TOKPOS[row * 2], p1 = TOKPOS[row * 2 + 1];
            const GAS v2u* y0 = (const GAS v2u*)(YG + (size_t)p0 * D) + F.lane; const GAS v2u* y1 = (const GAS v2u*)(YG + (size_t)p1 * D) + F.lane;
#pragma unroll
            for (int j = 0; j < 8; ++j) { const f32x4 xv = xr[64 * j]; const v2u a = y0[64 * j], b = y1[64 * j];
                v[j].x = ALPHA * xv.x + (bflo(a.x) + bflo(b.x)); v[j].y = ALPHA * xv.y + (bfhi(a.x) + bfhi(b.x)); v[j].z = ALPHA * xv.z + (bflo(a.y) + bflo(b.y)); v[j].w = ALPHA * xv.w + (bfhi(a.y) + bfhi(b.y)); }
        }
#pragma unroll
        for (int j = 0; j < 8; ++j) s += (v[j].x + v[j].y) + (v[j].z + v[j].w);
        const float mean = wave_sum(s) * (1.f / D); float s2 = 0.f;
#pragma unroll
        for (int j = 0; j < 8; ++j) { v[j] = v[j] - mean; s2 += (v[j].x * v[j].x + v[j].y * v[j].y) + (v[j].z * v[j].z + v[j].w * v[j].w); }
        const float rstd = 1.f / sqrtf(wave_sum(s2) * (1.f / D) + LN_EPS);
        GAS f32x4* xo = (GAS f32x4*)(xout + (size_t)row * D) + F.lane; GAS v2u* bo = (GAS v2u*)(XB + (size_t)row * D) + F.lane;
#pragma unroll
        for (int j = 0; j < 8; ++j) { const f32x4 gj = ((const GAS f32x4*)gam)[F.lane + 64 * j], bj = ((const GAS f32x4*)bet)[F.lane + 64 * j]; v[j] = v[j] * rstd * gj + bj; xo[64 * j] = v[j];
            if (!(MODE == 2 && layer == DEPTH - 1)) { v2u w; w.x = pk2(v[j].x, v[j].y); w.y = pk2(v[j].z, v[j].w); bo[64 * j] = w; } }
        if (MODE == 1) {
            const GAS f32x4* w1 = (const GAS f32x4*)(F.in[21] + (size_t)layer * D * 4); const GAS f32x4* w2 = (const GAS f32x4*)(F.in[23] + (size_t)layer * 4 * D * 4);
            int lq = F.lane; asm volatile("" : "+v"(lq));
            float a1[4] = {0.f, 0.f, 0.f, 0.f}; float a2[16];
#pragma unroll
            for (int k = 0; k < 16; ++k) a2[k] = 0.f;
#pragma unroll
            for (int j = 0; j < 8; ++j) {
#pragma unroll
                for (int i = 0; i < 4; ++i) { const int c = 4 * lq + 256 * j + i; const float xv = v[j][i];
                    const f32x4 q = w1[c]; a1[0] += xv * q.x; a1[1] += xv * q.y; a1[2] += xv * q.z; a1[3] += xv * q.w;
#pragma unroll
                    for (int g = 0; g < 4; ++g) { const f32x4 r = w2[g * D + c]; a2[4 * g] += xv * r.x; a2[4 * g + 1] += xv * r.y; a2[4 * g + 2] += xv * r.z; a2[4 * g + 3] += xv * r.w; }
                    if (i & 1) asm volatile("" ::: "memory"); } }
#pragma unroll
            for (int k = 0; k < 4; ++k) a1[k] = wave_sum(a1[k]) + F.in[22][layer * 4 + k];
#pragma unroll
            for (int k = 0; k < 16; ++k) a2[k] = wave_sum(a2[k]) + F.in[24][layer * 16 + k];
            int gi = 0; float lm = a1[0];
#pragma unroll
            for (int k = 1; k < 4; ++k) if (a1[k] > lm) { lm = a1[k]; gi = k; }
            float den = 0.f;
#pragma unroll
            for (int k = 0; k < 4; ++k) den += __expf(a1[k] - lm);
            const float pg = 1.0f / den;
            float l2[4];
#pragma unroll
            for (int e = 0; e < 4; ++e) l2[e] = gi == 0 ? a2[e] : gi == 1 ? a2[4 + e] : gi == 2 ? a2[8 + e] : a2[12 + e];
            int e1 = 0; float v1 = l2[0];
#pragma unroll
            for (int e = 1; e < 4; ++e) if (l2[e] > v1) { v1 = l2[e]; e1 = e; }
            int e2 = -1; float v2 = 0.f;
#pragma unroll
            for (int e = 0; e < 4; ++e) if (e != e1 && (e2 < 0 || l2[e] > v2)) { v2 = l2[e]; e2 = e; }
            const float t = __expf(v2 - v1); const float p1 = 1.0f / (1.0f + t), p2 = t / (1.0f + t);
            if (F.lane == 0) { const int E1 = gi * 4 + e1, E2 = gi * 4 + e2;
                const int i1 = __hip_atomic_fetch_add(&hist[E1], 1, __ATOMIC_RELAXED, __HIP_MEMORY_SCOPE_WORKGROUP); const int i2 = __hip_atomic_fetch_add(&hist[E2], 1, __ATOMIC_RELAXED, __HIP_MEMORY_SCOPE_WORKGROUP);
                sE[2 * it] = E1; sI[2 * it] = i1; sW[2 * it] = pg * p1; sE[2 * it + 1] = E2; sI[2 * it + 1] = i2; sW[2 * it + 1] = pg * p2; }
        }
    }
    if (MODE == 1) {
        __syncthreads();
        if (F.tid < 16) hbase[F.tid] = (int)__hip_atomic_fetch_add((unsigned*)(F.ctl + CW_CNT + layer * 16 + F.tid), (unsigned)hist[F.tid], RLX_AGENT);
        __syncthreads();
        int* TS = (int*)(F.ws + WS_TOKSLOT);
        if (F.tid < 2 * rpb) { const int s = F.tid; const int row = blockIdx.x * rpb + (s >> 1); const int E = sE[s];
            GAS v4u* dst = (GAS v4u*)(TS + (size_t)(row * 2 + (s & 1)) * 4); v4u w; w.x = (unsigned)E; w.y = (unsigned)(hbase[E] + sI[s]); w.z = __float_as_uint(sW[s]); w.w = 0u; *dst = w; }
        __syncthreads();
    }
}
__device__ __forceinline__ void moe_tables(Ctx& F, int layer, int (&tab)[17]) {
    int acc = 0;
#pragma unroll
    for (int e = 0; e < 16; ++e) { const unsigned c = __hip_atomic_load((unsigned*)(F.ctl + CW_CNT + layer * 16 + e), RLX_AGENT); tab[e] = __builtin_amdgcn_readfirstlane(acc); acc += (int)((c + 255u) >> 8); }
    tab[16] = __builtin_amdgcn_readfirstlane(acc);
}
__device__ __forceinline__ void s7_gather(Ctx& F, int layer) {
    int tab[17]; moe_tables(F, layer, tab);
    const int gw = F.vcu * NWAVES + F.wave, NGW = F.G * NWAVES;
    const int* TS = (const int*)(F.ws + WS_TOKSLOT); int* TOKPOS = (int*)(F.ws + WS_TOKPOS); float* RG = (float*)(F.ws + WS_ROWGATE);
    const bf16_t* XB = (const bf16_t*)(F.ws + WS_XB); bf16_t* XG = (bf16_t*)(F.ws + WS_XG);
    for (int s = gw; s < 2 * T; s += NGW) {
        const int E = TS[(size_t)s * 4], idx = TS[(size_t)s * 4 + 1]; const float w = __int_as_float(TS[(size_t)s * 4 + 2]);
        int tb = 0;
#pragma unroll
        for (int e = 0; e < 16; ++e) tb = (E == e) ? tab[e] : tb;
        const int srow = tb * 256 + idx; const int tok = s >> 1;
        const GAS v4u* src = (const GAS v4u*)(XB + (size_t)tok * D) + F.lane; GAS v4u* dst = (GAS v4u*)(XG + (size_t)srow * D) + F.lane;
#pragma unroll
        for (int j = 0; j < 4; ++j) dst[64 * j] = src[64 * j];
        if (F.lane == 0) { RG[srow] = w; TOKPOS[s] = srow; }
    }
}
struct Params { const float* in[28]; float* out; unsigned char* ws; int layer_lo, layer_hi, st_lo, st_hi, bar_region, pad; };
constexpr int N_STEPS = 11;
#ifndef NAIVE_MIX
#define NAIVE_MIX 1
#endif
__global__ void __launch_bounds__(NTHR, 2) mk_fwd(Params args) {
    extern __shared__ __attribute__((aligned(16))) unsigned char lds_raw[];
    Ctx F;
    F.lds = (LAS unsigned char*)lds_raw; F.MISC = (volatile LAS unsigned*)(F.lds + MISC_OFF);
    F.tid = threadIdx.x; F.lane = F.tid & 63; F.wave = __builtin_amdgcn_readfirstlane(F.tid >> 6);
    F.G = gridDim.x; { const int bx = blockIdx.x; F.vcu = (F.G % 8 == 0) ? (bx % 8) * (F.G / 8) + bx / 8 : bx; }
#pragma unroll
    for (int i = 0; i < 28; ++i) F.in[i] = args.in[i];
    F.out = args.out; F.ws = args.ws; F.ctl = (gu32*)(args.ws + WS_CTL);
    for (int u = F.tid; u < (LDS_BYTES - LDSCTL_OFF) / 4; u += NTHR) ((LAS unsigned*)(F.lds + LDSCTL_OFF))[u] = 0u;
    __syncthreads();
    XcdBarrier bar; bar.bar = (unsigned*)(F.ctl + CW_BAR); bar.x = 0; bar.st = nullptr;
    const bool has_bar = args.bar_region >= 0;
    if (has_bar) bar = xcd_barrier_post((unsigned*)(F.ctl + CW_BAR) + args.bar_region * XCD_BAR_WORDS, F.MISC + 8);
    const int lo = args.st_lo, hi = args.st_hi;
#ifdef STEP_MASK
#define IN(k) (((STEP_MASK >> (k)) & 1) && lo <= (k) && (k) < hi)
#else
#define IN(k) (lo <= (k) && (k) < hi)
#endif
#define SEAM(k) do { if (has_bar && (IN((k) + 1) || ((k) == N_STEPS - 1 && layer + 1 < args.layer_hi))) xcd_barrier(bar); } while (0)
#define FRESH() do { int t_ = threadIdx.x; asm volatile("" : "+v"(t_)); F.tid = t_; F.lane = t_ & 63; } while (0)
    for (int layer = args.layer_lo; layer < args.layer_hi; ++layer) {
        const int j = layer >> 1; const bool even = (layer & 1) == 0;
        if (IN(0)) { FRESH(); s0_convert(F, layer); SEAM(0); }
        if (IN(1)) {
            pg8::Gemm g{(const pg8::bf16_t*)(F.ws + WS_XB), even ? (const pg8::bf16_t*)(F.ws + WS_WHYIN) + (size_t)j * HY_NP * 2048 : (const pg8::bf16_t*)(F.ws + WS_WSSIN) + (size_t)j * SS_NP * 2048, T, even ? HY_NP : SS_NP, D};
            pg8::StaticOrder S; S.init(T, g.N, F.G, (int)blockIdx.x);
            pg8::EpiBf16P E{(pg8::bf16_t*)(F.ws + WS_PROJ), g.N};
            pg8::gemm_phase<pg8::EpiBf16P, pg8::StaticOrder, PG8_ALIGN, PG8_SP2>(F.lds + RING_OFF, g, S, E);
            SEAM(1);
        }
#if !NAIVE_MIX
        if (IN(2)) { SEAM(2); }
        if (IN(3)) { SEAM(3); }
        if (IN(4)) { SEAM(4); }
#endif
        if (IN(5)) {
            pg8::Gemm g{even ? (const pg8::bf16_t*)(F.ws + WS_YMIX) : (const pg8::bf16_t*)(F.ws + WS_YN), even ? (const pg8::bf16_t*)(F.ws + WS_WHYOUT) + (size_t)j * 2048 * 2048 : (const pg8::bf16_t*)(F.ws + WS_WSSOUT) + (size_t)j * 2048 * 4096, T, D, even ? 2048 : 4096};
            pg8::StaticOrder S; S.init(T, D, F.G, (int)blockIdx.x);
            pg8::EpiBf16P E{(pg8::bf16_t*)(F.ws + WS_MBUF), D};
            pg8::gemm_phase<pg8::EpiBf16P, pg8::StaticOrder, PG8_ALIGN, PG8_SP2>(F.lds + RING_OFF, g, S, E);
            SEAM(5);
        }
        if (IN(6)) { FRESH(); ln_phase<1>(F, layer); SEAM(6); }
        if (IN(7)) { FRESH(); s7_gather(F, layer); SEAM(7); }
        if (IN(8)) {
            pg8::MoeOrder S; moe_tables(F, layer, S.tab); S.G = F.G; S.c = (int)blockIdx.x;
            pg8::Gemm g{(const pg8::bf16_t*)(F.ws + WS_XG), (const pg8::bf16_t*)(F.ws + WS_WGU), MOE_ROWS, 2048, D};
            pg8::EpiSwiglu E{(pg8::bf16_t*)(F.ws + WS_HID), (const float*)(F.ws + WS_ROWGATE), MOE_FF};
            pg8::gemm_phase<pg8::EpiSwiglu, pg8::MoeOrder, PG8_ALIGN, PG8_SP2>(F.lds + RING_OFF, g, S, E);
            SEAM(8);
        }
        if (IN(9)) {
            pg8::MoeOrder S; moe_tables(F, layer, S.tab); S.G = F.G; S.c = (int)blockIdx.x;
            pg8::Gemm g{(const pg8::bf16_t*)(F.ws + WS_HID), (const pg8::bf16_t*)(F.ws + WS_WD), MOE_ROWS, 2048, MOE_FF};
            pg8::EpiBf16P E{(pg8::bf16_t*)(F.ws + WS_YG), D};
            pg8::gemm_phase<pg8::EpiBf16P, pg8::MoeOrder, PG8_ALIGN, PG8_SP2>(F.lds + RING_OFF, g, S, E);
            SEAM(9);
        }
        if (IN(10)) { FRESH(); ln_phase<2>(F, layer); SEAM(10); }
    }
#undef IN
#undef SEAM
}
__device__ __forceinline__ float wave_max(float v) {
#pragma unroll
    for (int o = 1; o < 64; o <<= 1) v = fmaxf(v, __shfl_xor(v, o));
    return v;
}
__global__ void nk_lru_conv(const bf16_t* PROJ, const float* cw, const float* cb, float* XC) {
    const size_t idx = (size_t)blockIdx.x * 256 + threadIdx.x; if (idx >= (size_t)T * 1024) return;
    const int row = (int)(idx >> 10), ch = (int)(idx & 1023), s = row & (SEQ - 1);
    float a = cb[ch];
    for (int k = 0; k < 4; ++k) { const int sp = s - 3 + k; if (sp >= 0) a += bf2f(PROJ[(size_t)(row - 3 + k) * HY_NP + ch]) * cw[k * 1024 + ch]; }
    XC[idx] = a;
}
__global__ void nk_lru_gate(const float* XC, const float* w_r, const float* b_r, const float* w_i, const float* b_i, const float* lam, float* A, float* U) {
    const size_t idx = (size_t)blockIdx.x * 256 + threadIdx.x; if (idx >= (size_t)T * 1024) return;
    const int row = (int)(idx >> 10), ch = (int)(idx & 1023), h = ch >> 7, jj = ch & 127;
    float sr = b_r[ch], si = b_i[ch]; const float* xr = XC + (size_t)row * 1024 + h * 128;
    for (int i = 0; i < 128; ++i) { const float xv = xr[i]; sr += xv * w_r[(size_t)(h * 128 + i) * 128 + jj]; si += xv * w_i[(size_t)(h * 128 + i) * 128 + jj]; }
    const float r = sigmoid_(sr), ig = sigmoid_(si); const float la = -8.0f * r * softplus_(-lam[ch]);
    A[idx] = expf(la); U[idx] = sqrtf(-expm1f(2.0f * la)) * (ig * XC[idx]);
}
__global__ void nk_lru_scan(const float* A, const float* U, const bf16_t* PROJ, bf16_t* YMIX) {
    const int idx = blockIdx.x * 64 + threadIdx.x; if (idx >= BATCH * 1024) return;
    const int b = idx >> 10, ch = idx & 1023; float h = 0.f;
    for (int s = 0; s < SEQ; ++s) { const size_t row = (size_t)b * SEQ + s; h = A[row * 1024 + ch] * h + U[row * 1024 + ch];
        const float gt = bf2f(PROJ[row * HY_NP + 1024 + ch]); YMIX[row * 2048 + ch] = (bf16_t)f2bf(h * gelu_tanh_(gt)); }
}
__global__ void nk_fcum(const bf16_t* PROJ, const float* b_f, float* FC) {
    const int bh = blockIdx.x, b = bh >> 3, h = bh & 7, lane = threadIdx.x; float carry = 0.f;
    for (int s0 = 0; s0 < SEQ; s0 += 64) { const int s = s0 + lane; const size_t row = (size_t)b * SEQ + s;
        float lf = -softplus_(-(bf2f(PROJ[row * HY_NP + 5120 + h]) + b_f[h]));
        for (int o = 1; o < 64; o <<= 1) { const float t = __shfl_up(lf, o); if (lane >= o) lf += t; }
        lf += carry; FC[(size_t)bh * SEQ + s] = lf; carry = __shfl(lf, 63); }
}
__global__ void nk_attn(const bf16_t* PROJ, const float* FC, bf16_t* YMIX) {
    __shared__ float sq[2][128]; __shared__ float sc[2][SEQ];
    const int w = threadIdx.x >> 6, lane = threadIdx.x & 63; const int gw = blockIdx.x * 2 + w; const int t = gw & (SEQ - 1), h = (gw >> 12) & 7, b = gw >> 15;
    const size_t row = (size_t)b * SEQ + t;
    { const unsigned qq = *(const unsigned*)(PROJ + row * HY_NP + 2048 + h * 128 + 2 * lane); sq[w][2 * lane] = bflo(qq); sq[w][2 * lane + 1] = bfhi(qq); }
    __syncthreads();
    float mx = -INFINITY;
    for (int s0 = 0; s0 <= t; s0 += 64) { const int s = s0 + lane; if (s <= t) {
        const v4u* kr = (const v4u*)(PROJ + ((size_t)b * SEQ + s) * HY_NP + 3072 + h * 128); float dot = 0.f;
        for (int c = 0; c < 16; ++c) { const v4u kk = kr[c]; const float* q = &sq[w][8 * c];
            dot += q[0] * bflo(kk.x) + q[1] * bfhi(kk.x) + q[2] * bflo(kk.y) + q[3] * bfhi(kk.y) + q[4] * bflo(kk.z) + q[5] * bfhi(kk.z) + q[6] * bflo(kk.w) + q[7] * bfhi(kk.w); }
        const float v = dot * 0.08838834764831845f - FC[(size_t)(b * 8 + h) * SEQ + s]; sc[w][s] = v; mx = fmaxf(mx, v); } }
    mx = wave_max(mx);
    float sum = 0.f;
    for (int s0 = 0; s0 <= t; s0 += 64) { const int s = s0 + lane; if (s <= t) { const float p = expf(sc[w][s] - mx); sc[w][s] = p; sum += p; } }
    sum = wave_sum(sum);
    __syncthreads();
    float o0 = 0.f, o1 = 0.f;
    for (int s = 0; s <= t; ++s) { const float p = sc[w][s]; const unsigned vv = *(const unsigned*)(PROJ + ((size_t)b * SEQ + s) * HY_NP + 4096 + h * 128 + 2 * lane); o0 += p * bflo(vv); o1 += p * bfhi(vv); }
    const float inv = 1.0f / sum;
    *(unsigned*)(YMIX + row * 2048 + 1024 + h * 128 + 2 * lane) = pk2(o0 * inv, o1 * inv);
}
__global__ void nk_ssd_conv(const bf16_t* PROJ, const float* cw, const float* cb, const float* dtb, float* XBCN, float* DT) {
    const size_t idx = (size_t)blockIdx.x * 256 + threadIdx.x; if (idx >= (size_t)T * SSD_CONV) return;
    const int row = (int)(idx / SSD_CONV), c = (int)(idx - (size_t)row * SSD_CONV), s = row & (SEQ - 1);
    float a = cb[c];
    for (int k = 0; k < 4; ++k) { const int sp = s - 3 + k; if (sp >= 0) a += bf2f(PROJ[(size_t)(row - 3 + k) * SS_NP + 4096 + c]) * cw[k * SSD_CONV + c]; }
    XBCN[idx] = silu_(a);
    if (c < 64) DT[(size_t)row * 64 + c] = softplus_(bf2f(PROJ[(size_t)row * SS_NP + 10240 + c]) + dtb[c]);
}
__global__ void nk_ssd_acs(const float* DT, const float* a_log, float* ACS) {
    const int idx = blockIdx.x * 64 + threadIdx.x; if (idx >= BATCH * SSD_NC * 64) return;
    const int h = idx & 63, bc = idx >> 6; const float A = -expf(a_log[h]); float acc = 0.f;
    for (int l = 0; l < 128; ++l) { const size_t row = (size_t)bc * 128 + l; acc += DT[row * 64 + h] * A; ACS[row * 64 + h] = acc; }
}
__global__ void nk_ssd_cb(const float* XBCN, float* CB) {
    const size_t idx = (size_t)blockIdx.x * 256 + threadIdx.x; if (idx >= (size_t)1024 * 128 * 128) return;
    const int s = (int)(idx & 127), l = (int)((idx >> 7) & 127), bcg = (int)(idx >> 14), bc = bcg >> 3, g = bcg & 7;
    if (s > l) { CB[idx] = 0.f; return; }
    const float* cm = XBCN + ((size_t)bc * 128 + l) * SSD_CONV + 5120 + g * 128; const float* bm = XBCN + ((size_t)bc * 128 + s) * SSD_CONV + 4096 + g * 128;
    float d = 0.f; for (int n = 0; n < 128; ++n) d += cm[n] * bm[n]; CB[idx] = d;
}
__global__ void nk_ssd_states(const float* XBCN, const float* DT, const float* ACS, bf16_t* ST) {
    const size_t idx = (size_t)blockIdx.x * 256 + threadIdx.x; if (idx >= (size_t)BATCH * SSD_NC * 64 * 64 * 128) return;
    const int n = (int)(idx & 127), p = (int)((idx >> 7) & 63), h = (int)((idx >> 13) & 63), bc = (int)(idx >> 19), g = h >> 3;
    const float al = ACS[((size_t)bc * 128 + 127) * 64 + h]; float sum = 0.f;
    for (int l = 0; l < 128; ++l) { const size_t row = (size_t)bc * 128 + l;
        sum += XBCN[row * SSD_CONV + 4096 + g * 128 + n] * XBCN[row * SSD_CONV + h * 64 + p] * DT[row * 64 + h] * expf(al - ACS[row * 64 + h]); }
    ST[idx] = (bf16_t)f2bf(sum);
}
__global__ void nk_ssd_scan(bf16_t* ST, const float* ACS) {
    const int idx = blockIdx.x * 256 + threadIdx.x; if (idx >= BATCH * 64 * 64 * 128) return;
    const int n = idx & 127, p = (idx >> 7) & 63, h = (idx >> 13) & 63, b = idx >> 19; float s = 0.f;
    for (int c = 0; c < SSD_NC; ++c) { const int bc = b * SSD_NC + c; const size_t off = (((size_t)bc * 64 + h) * 64 + p) * 128 + n;
        const float st = bf2f(ST[off]); ST[off] = (bf16_t)f2bf(s); s = s * expf(ACS[((size_t)bc * 128 + 127) * 64 + h]) + st; }
}
__global__ void nk_ssd_y(const float* XBCN, const float* DT, const float* ACS, const float* CB, const bf16_t* ST, const bf16_t* PROJ, const float* dsk, const float* ng, bf16_t* YN) {
    __shared__ float red[8];
    const int row = blockIdx.x >> 3, g = blockIdx.x & 7, tid = threadIdx.x, e = tid >> 6, p = tid & 63, h = g * 8 + e, bc = row >> 7, l = row & 127;
    const float al = ACS[(size_t)row * 64 + h]; float y = 0.f;
    for (int s = 0; s <= l; ++s) { const size_t rs = (size_t)bc * 128 + s;
        y += CB[(((size_t)bc * 8 + g) * 128 + l) * 128 + s] * expf(al - ACS[rs * 64 + h]) * DT[rs * 64 + h] * XBCN[rs * SSD_CONV + h * 64 + p]; }
    float yo = 0.f; const bf16_t* pv = ST + (((size_t)bc * 64 + h) * 64 + p) * 128; const float* cm = XBCN + (size_t)row * SSD_CONV + 5120 + g * 128;
    for (int n = 0; n < 128; ++n) yo += cm[n] * bf2f(pv[n]);
    y += yo * expf(al) + dsk[h] * XBCN[(size_t)row * SSD_CONV + h * 64 + p];
    y *= silu_(bf2f(PROJ[(size_t)row * SS_NP + h * 64 + p]));
    const float q = wave_sum(y * y); if (p == 0) red[e] = q; __syncthreads();
    float tot = 0.f; for (int i = 0; i < 8; ++i) tot += red[i];
    y = y * (1.0f / sqrtf(tot * (1.0f / 512.0f) + RMS_EPS)) * ng[h * 64 + p];
    YN[(size_t)row * 4096 + h * 64 + p] = (bf16_t)f2bf(y);
}
static void launch_mk(Params a, int layer, int s_lo, int s_hi, int grid, hipStream_t stream) {
    a.layer_lo = layer; a.layer_hi = layer + 1; a.st_lo = s_lo; a.st_hi = s_hi; a.bar_region = -1;
    hipLaunchKernelGGL(mk_fwd, dim3(grid), dim3(NTHR), LDS_BYTES, stream, a);
}
extern "C" void kernel_launch(void* const* d_in, const int* in_sizes, int n_in, void* d_out, int out_size, void* d_ws, size_t ws_size, hipStream_t stream) {
    static int grid = 0;
    if (grid == 0) {
        if (n_in != 28 || out_size != T * D || ws_size < WS_END) { fprintf(stderr, "kernel_launch: unexpected shapes (n_in %d out %d ws %zu need %zu)\n", n_in, out_size, ws_size, (size_t)WS_END); grid = -1; return; }
        int dev = 0, cus = 0; hipGetDevice(&dev); hipDeviceGetAttribute(&cus, hipDeviceAttributeMultiprocessorCount, dev);
        if (hipFuncSetAttribute((const void*)mk_fwd, hipFuncAttributeMaxDynamicSharedMemorySize, LDS_BYTES) != hipSuccess) { fprintf(stderr, "kernel_launch: hipFuncSetAttribute failed\n"); grid = -1; return; }
        grid = 256; if (cus != 256) fprintf(stderr, "kernel_launch: built for 256 CUs, device has %d\n", cus);
    }
    if (grid < 0) return;
    hipMemsetAsync((char*)d_ws + WS_CTL, 0, CTL_ZERO_BYTES, stream);
    Params a{};
    for (int i = 0; i < 28; ++i) a.in[i] = (const float*)d_in[i];
    a.out = (float*)d_out; a.ws = (unsigned char*)d_ws;
    unsigned char* ws = (unsigned char*)d_ws;
    const float* const* in = a.in;
    for (int layer = 0; layer < DEPTH; ++layer) {
        const int j = layer >> 1;
        launch_mk(a, layer, 0, 1, grid, stream);
        launch_mk(a, layer, 1, 2, grid, stream);
#if NAIVE_MIX
        const bf16_t* PROJ = (const bf16_t*)(ws + WS_PROJ);
        if ((layer & 1) == 0) {
            float* XC = (float*)(ws + WS_NAIVE); float* Ab = (float*)(ws + WS_CUMA); float* Ub = (float*)(ws + WS_HLOC); float* FC = (float*)(ws + WS_FCUM); bf16_t* YMIX = (bf16_t*)(ws + WS_YMIX);
            hipLaunchKernelGGL(nk_lru_conv, dim3(T * 1024 / 256), dim3(256), 0, stream, PROJ, in[4] + (size_t)j * 4 * 1024, in[5] + (size_t)j * 1024, XC);
            hipLaunchKernelGGL(nk_lru_gate, dim3(T * 1024 / 256), dim3(256), 0, stream, (const float*)XC, in[6] + (size_t)j * 8 * 128 * 128, in[7] + (size_t)j * 1024, in[8] + (size_t)j * 8 * 128 * 128, in[9] + (size_t)j * 1024, in[10] + (size_t)j * 1024, Ab, Ub);
            hipLaunchKernelGGL(nk_lru_scan, dim3(BATCH * 1024 / 64), dim3(64), 0, stream, (const float*)Ab, (const float*)Ub, PROJ, YMIX);
            hipLaunchKernelGGL(nk_fcum, dim3(32), dim3(64), 0, stream, PROJ, in[11] + (size_t)j * 8, FC);
            hipLaunchKernelGGL(nk_attn, dim3(T * 8 / 2), dim3(128), 0, stream, PROJ, (const float*)FC, YMIX);
        } else {
            float* XBCN = (float*)(ws + WS_NAIVE); float* CB = (float*)(ws + WS_NAIVE + 384 * MiB); float* DT = (float*)(ws + WS_DTB); float* ACS = (float*)(ws + WS_ACSB);
            bf16_t* ST = (bf16_t*)(ws + WS_STATES); bf16_t* YN = (bf16_t*)(ws + WS_YN);
            hipLaunchKernelGGL(nk_ssd_conv, dim3((unsigned)((size_t)T * SSD_CONV / 256)), dim3(256), 0, stream, PROJ, in[14] + (size_t)j * 4 * SSD_CONV, in[15] + (size_t)j * SSD_CONV, in[16] + (size_t)j * 64, XBCN, DT);
            hipLaunchKernelGGL(nk_ssd_acs, dim3(BATCH * SSD_NC), dim3(64), 0, stream, (const float*)DT, in[17] + (size_t)j * 64, ACS);
            hipLaunchKernelGGL(nk_ssd_cb, dim3(1024 * 128 * 128 / 256), dim3(256), 0, stream, (const float*)XBCN, CB);
            hipLaunchKernelGGL(nk_ssd_states, dim3((unsigned)((size_t)BATCH * SSD_NC * 64 * 64 * 128 / 256)), dim3(256), 0, stream, (const float*)XBCN, (const float*)DT, (const float*)ACS, ST);
            hipLaunchKernelGGL(nk_ssd_scan, dim3(BATCH * 64 * 64 * 128 / 256), dim3(256), 0, stream, ST, (const float*)ACS);
            hipLaunchKernelGGL(nk_ssd_y, dim3(T * 8), dim3(512), 0, stream, (const float*)XBCN, (const float*)DT, (const float*)ACS, (const float*)CB, (const bf16_t*)ST, PROJ, in[18] + (size_t)j * 64, in[19] + (size_t)j * 4096, YN);
        }
#else
        launch_mk(a, layer, 2, 3, grid, stream); launch_mk(a, layer, 3, 4, grid, stream); launch_mk(a, layer, 4, 5, grid, stream);
#endif
        for (int s = 5; s < N_STEPS; ++s) launch_mk(a, layer, s, s + 1, grid, stream);
    }
}
```

```cpp
#include <hip/hip_runtime.h>
#include <cstdio>
#include <cstdint>
__device__ __forceinline__ float shfl_xor_l(float v, int o, int lane) { return __int_as_float(__builtin_amdgcn_ds_bpermute((lane ^ o) << 2, __float_as_int(v))); }
__device__ __forceinline__ float shfl_up_l(float v, int o, int lane) { return __int_as_float(__builtin_amdgcn_ds_bpermute((lane - o) << 2, __float_as_int(v))); }
__device__ __forceinline__ int lane_id() { return (int)__builtin_amdgcn_mbcnt_hi(~0u, __builtin_amdgcn_mbcnt_lo(~0u, 0u)); }
__device__ __forceinline__ int fresh_tid(int wave) { int t; asm volatile("v_mbcnt_lo_u32_b32 %0, -1, 0\n\tv_mbcnt_hi_u32_b32 %0, -1, %0\n\tv_lshl_add_u32 %0, %1, 6, %0" : "=&v"(t) : "s"(wave)); return t; }
namespace pg8 {
#define PG8_LAS __attribute__((address_space(3)))
typedef unsigned short bf16_t;
typedef short bf16x8 __attribute__((ext_vector_type(8)));
typedef float f32x4 __attribute__((ext_vector_type(4)));
typedef unsigned u32x4 __attribute__((ext_vector_type(4)));
typedef int v8i __attribute__((ext_vector_type(8)));
constexpr int BM = 256, BK = 64, HALF = 128, HTB = HALF * BK * 2  , STAGE_BYTES = 8 * HTB, NXCD = 8, WGM = 8;

__host__ __device__ __forceinline__ int lds_byte(int r, int c) { const int st = (r >> 4) * 2 + (c >> 5), rr = r & 15, cc = c & 31, ob = rr * 64 + cc * 2; return st * 1024 + (ob ^ (((ob >> 9) & 1) << 5)); }
__host__ __device__ __forceinline__ void stage_rc(int b, int& R, int& C) { const int st = b / 1024, sb = b % 1024, swz = sb ^ (((sb >> 9) & 1) << 5); R = (st >> 1) * 16 + swz / 64; C = (st & 1) * 32 + (swz % 64) / 2; }
__host__ __device__ __forceinline__ int perm32(int rho) { const int n = rho >> 4, i = rho & 15; return 8 * (i >> 2) + 4 * n + (i & 3); }

struct Unit { int pm, pn, pb, e, lt; };
struct Gemm { const bf16_t* A; const bf16_t* Bt; int M, N, K; };

struct StaticOrder {
    static constexpr bool GATHER = false;
    int nM, nN, nwg, G, c;
    __host__ __device__ void init(int M, int N, int G_, int c_) { nM = M / BM; nN = N / BM; nwg = nM * nN; G = G_; c = c_; }
    __host__ __device__ bool next(int i, Unit& u) const {
        const long L = (long)i * G + c; if (L >= nwg) return false;
        int wgid = (int)L; { const int q = nwg / NXCD, r = nwg % NXCD, xcd = wgid % NXCD, off = wgid / NXCD; wgid = (xcd < r ? xcd * (q + 1) : r * (q + 1) + (xcd - r) * q) + off; }
        const int nig = WGM * nN, gid = wgid / nig, fm = gid * WGM, gsz = (nM - fm) < WGM ? (nM - fm) : WGM;
        u.pm = fm + ((wgid % nig) % gsz); u.pn = (wgid % nig) / gsz; u.pb = u.pn; u.e = 0; u.lt = 0; return true;
    }
    __device__ __forceinline__ void a_ready(const Unit&) const {}
    __device__ __forceinline__ void done(const Unit&) const {}
};
struct MoeOrder {
    static constexpr bool GATHER = false;
    int tab[17]; int G, c;
    __device__ bool next(int i, Unit& u) const {
        const int nt = tab[16]; const int L = i * G + c; if (L >= nt * 8) return false;
        const int wgid = (L & 7) * nt + (L >> 3); const int t = wgid >> 3, pn = wgid & 7;
        int E = 0;
#pragma unroll
        for (int e = 1; e < 16; ++e) E += (t >= tab[e]) ? 1 : 0;
        int t0 = 0;
#pragma unroll
        for (int e = 1; e < 16; ++e) t0 = (E == e) ? tab[e] : t0;
        u.pm = t; u.pn = pn; u.pb = E * 8 + pn; u.e = E; u.lt = t - t0; return true;
    }
    __device__ __forceinline__ void a_ready(const Unit&) const {}
    __device__ __forceinline__ void done(const Unit&) const {}
};
struct MoeGatherOrder : MoeOrder {
    static constexpr bool GATHER = true;
    const int* exptok; const unsigned* cnt; int cap;
    __device__ __forceinline__ int row_of(const Unit& u, int r) const { const int i = u.lt * 256 + r; const int n = (int)__hip_atomic_load(cnt + u.e, __ATOMIC_RELAXED, __HIP_MEMORY_SCOPE_AGENT);
        return i < n ? exptok[(size_t)u.e * cap + i] : 0; }
};
__device__ __forceinline__ unsigned cvt_pk_bf16(float lo, float hi) { unsigned r; asm volatile("v_cvt_pk_bf16_f32 %0, %1, %2" : "=v"(r) : "v"(lo), "v"(hi)); return r; }

template <bool F8> struct EpiBf16PT {
    static constexpr bool PERM = true, AFTER_DRAIN = false, FP8 = F8;
    bf16_t* O; int ldc; float oscale;
    __device__ __forceinline__ void operator()(const f32x4 (&acc)[2][2][4][2], const Unit& u, int wr, int wc, int fr, int fq) const {
        const int row0 = u.pm * BM + wr * 64 + fr, col0 = u.pn * BM + wc * 32 + 8 * fq;
#pragma unroll
        for (int ai = 0; ai < 2; ++ai)
#pragma unroll
            for (int m = 0; m < 4; ++m) { bf16_t* rowp = O + (size_t)(row0 + ai * HALF + m * 16) * ldc + col0;
#pragma unroll
                for (int bj = 0; bj < 2; ++bj) { f32x4 v0 = acc[ai][bj][m][0], v1 = acc[ai][bj][m][1]; if (F8) { v0 = v0 * oscale; v1 = v1 * oscale; }
                    u32x4 w; w.x = cvt_pk_bf16(v0[0], v0[1]); w.y = cvt_pk_bf16(v0[2], v0[3]); w.z = cvt_pk_bf16(v1[0], v1[1]); w.w = cvt_pk_bf16(v1[2], v1[3]);
                    *(u32x4*)(rowp + bj * HALF) = w; } }
    }
};
typedef EpiBf16PT<false> EpiBf16P;
typedef EpiBf16PT<true> EpiBf16P8;
__device__ __forceinline__ float silu_fast(float x) { return x * __builtin_amdgcn_rcpf(1.0f + __expf(-x)); }
struct EpiSwiglu {
    static constexpr bool PERM = true, AFTER_DRAIN = false, FP8 = true;
    unsigned char* H; const float* expw; const unsigned* cnt; int cap, ldc;
    __device__ __forceinline__ void operator()(const f32x4 (&acc)[2][2][4][2], const Unit& u, int wr, int wc, int fr, int fq) const {
        const int row0 = u.pm * BM + wr * 64 + fr, col0 = u.pn * HALF + wc * 32 + 8 * fq; const int nvalid = (int)__hip_atomic_load(cnt + u.e, __ATOMIC_RELAXED, __HIP_MEMORY_SCOPE_AGENT);
        float gtv[8];
#pragma unroll
        for (int k = 0; k < 8; ++k) { const int li = wr * 64 + fr + (k >> 2) * HALF + (k & 3) * 16 + u.lt * BM; gtv[k] = expw[(size_t)u.e * cap + li]; }
        asm volatile("" : "+v"(gtv[0]), "+v"(gtv[1]), "+v"(gtv[2]), "+v"(gtv[3]), "+v"(gtv[4]), "+v"(gtv[5]), "+v"(gtv[6]), "+v"(gtv[7]));
#pragma unroll
        for (int ai = 0; ai < 2; ++ai)
#pragma unroll
            for (int m = 0; m < 4; ++m) { const int row = row0 + ai * HALF + m * 16; const int li = row - u.pm * BM + u.lt * BM; const float gt = li < nvalid ? gtv[ai * 4 + m] : 0.f;
                const f32x4 g0 = acc[ai][0][m][0], g1 = acc[ai][0][m][1], u0 = acc[ai][1][m][0], u1 = acc[ai][1][m][1];
                float h[8]; const float ds = 1.0f / 512.0f, gs = gt * (4.0f / 512.0f);
#pragma unroll
                for (int i = 0; i < 4; ++i) { h[i] = __builtin_amdgcn_fmed3f(silu_fast(g0[i] * ds) * u0[i] * gs, -448.f, 448.f); h[4 + i] = __builtin_amdgcn_fmed3f(silu_fast(g1[i] * ds) * u1[i] * gs, -448.f, 448.f); }
                int w0 = __builtin_amdgcn_cvt_pk_fp8_f32(h[0], h[1], 0, false); w0 = __builtin_amdgcn_cvt_pk_fp8_f32(h[2], h[3], w0, true);
                int w1 = __builtin_amdgcn_cvt_pk_fp8_f32(h[4], h[5], 0, false); w1 = __builtin_amdgcn_cvt_pk_fp8_f32(h[6], h[7], w1, true);
                typedef int i32x2 __attribute__((ext_vector_type(2)));
                *(i32x2*)(H + (size_t)row * ldc + col0) = (i32x2){w0, w1}; }
    }
};
template <class Epi, class Sched, bool ALIGN_EPI = false, bool SP2 = true>
__device__ __forceinline__ void gemm_phase(PG8_LAS unsigned char* lds, const Gemm g, const Sched& S, const Epi& E, int wave_in) {
    static_assert(SP2, "only the two-super-phase K-loop is kept in this file");
    const int tid_ = fresh_tid(wave_in);
    const int tid = tid_, wid = __builtin_amdgcn_readfirstlane(tid >> 6), lane = tid & 63, wr = wid >> 2, wc = wid & 3, fr = lane & 15, fq = lane >> 4;
    const int K = g.K, nt = K / BK;
    constexpr bool GATHER = Sched::GATHER;
    unsigned voffB[2]; int RA[2], CA[2];
#pragma unroll
    for (int i = 0; i < 2; ++i) { int R, C; stage_rc(tid * 16 + i * 8192, R, C); const int Rb = Epi::PERM ? ((R & ~31) + perm32(R & 31)) : R; RA[i] = R; CA[i] = C; voffB[i] = (unsigned)(Rb * K + C) * 2u; }
    const size_t kstep = (size_t)(BK * 2);
    const size_t hstep = (size_t)HALF * K * 2;
    const size_t tstep = 2 * hstep;
    const unsigned ldsw = (unsigned)wid * 1024u;
    PG8_LAS int* IDX = (PG8_LAS int*)(lds + STAGE_BYTES);
    unsigned vc[2][2], vn[2][2];
#pragma unroll
    for (int h = 0; h < 2; ++h)
#pragma unroll
        for (int i = 0; i < 2; ++i) { vc[h][i] = (unsigned)((h * HALF + RA[i]) * K + CA[i]) * 2u; vn[h][i] = vc[h][i]; }
    const int aoff = lds_byte(wr * 64 + fr, fq * 8), boff = lds_byte(wc * 32 + fr, fq * 8);
#define PG8_SA(b, h) (((b) * 2 + (h)) * HTB)
#define PG8_SB(b, h) ((4 + (b) * 2 + (h)) * HTB)
#define PG8_STAGE(bufoff, gbase, voff) do { _Pragma("unroll") for (int _i = 0; _i < 2; ++_i) \
        __builtin_amdgcn_global_load_lds((const unsigned*)((const char*)(gbase) + (voff)[_i]), (PG8_LAS unsigned*)(lds + (bufoff) + ldsw + _i * 8192), 16, 0, 0); } while (0)
#define PG8_LDA(dst, b, h) do { _Pragma("unroll") for (int m = 0; m < 4; ++m) _Pragma("unroll") for (int k = 0; k < 2; ++k) dst[m][k] = *(const PG8_LAS bf16x8*)(lds + PG8_SA(b, h) + aoff + m * 2048 + k * 1024); } while (0)
#define PG8_LDB(dst, b, h) do { _Pragma("unroll") for (int n = 0; n < 2; ++n) _Pragma("unroll") for (int k = 0; k < 2; ++k) dst[n][k] = *(const PG8_LAS bf16x8*)(lds + PG8_SB(b, h) + boff + n * 2048 + k * 1024); } while (0)
#define PG8_MMA(ai, bj, At, Bt) do { __builtin_amdgcn_s_setprio(1); _Pragma("unroll") for (int m = 0; m < 4; ++m) _Pragma("unroll") for (int n = 0; n < 2; ++n) { \
        if constexpr (Epi::FP8) { v8i a8_, b8_; { const u32x4 x0_ = __builtin_bit_cast(u32x4, At[m][0]), x1_ = __builtin_bit_cast(u32x4, At[m][1]), y0_ = __builtin_bit_cast(u32x4, Bt[n][0]), y1_ = __builtin_bit_cast(u32x4, Bt[n][1]); \
                a8_ = (v8i){(int)x0_.x, (int)x0_.y, (int)x0_.z, (int)x0_.w, (int)x1_.x, (int)x1_.y, (int)x1_.z, (int)x1_.w}; b8_ = (v8i){(int)y0_.x, (int)y0_.y, (int)y0_.z, (int)y0_.w, (int)y1_.x, (int)y1_.y, (int)y1_.z, (int)y1_.w}; } \
            acc[ai][bj][m][n] = __builtin_amdgcn_mfma_scale_f32_16x16x128_f8f6f4(b8_, a8_, acc[ai][bj][m][n], 0, 0, 0, 0x7f7f7f7f, 0, 0x7f7f7f7f); asm volatile("" : "+v"(acc[ai][bj][m][n])); } \
        else { _Pragma("unroll") for (int k = 0; k < 2; ++k) acc[ai][bj][m][n] = __builtin_amdgcn_mfma_f32_16x16x32_bf16(Bt[n][k], At[m][k], acc[ai][bj][m][n], 0, 0, 0); } } \
        __builtin_amdgcn_s_setprio(0); } while (0)
#define PG8_WAIT_V(n) asm volatile("s_waitcnt vmcnt(" #n ")" ::: "memory")
#define PG8_WAIT_L(n) asm volatile("s_waitcnt lgkmcnt(" #n ")" ::: "memory")
#define PG8_BAR __builtin_amdgcn_s_barrier()
#define PG8_SCHED __builtin_amdgcn_sched_barrier(0)
#define PG8_FETCH_ROWS(u_, slot_) do { if (wid == 7) { int r4_[4]; _Pragma("unroll") for (int q_ = 0; q_ < 4; ++q_) r4_[q_] = S.row_of((u_), lane + 64 * q_); \
        asm volatile("s_waitcnt vmcnt(0)" ::: "memory"); _Pragma("unroll") for (int q_ = 0; q_ < 4; ++q_) IDX[(slot_) * 256 + lane + 64 * q_] = r4_[q_]; } } while (0)
#define PG8_ROW_OFFS(dst_, slot_) do { _Pragma("unroll") for (int h_ = 0; h_ < 2; ++h_) _Pragma("unroll") for (int i_ = 0; i_ < 2; ++i_) \
        dst_[h_][i_] = (unsigned)(IDX[(slot_) * 256 + h_ * HALF + RA[i_]] * K + CA[i_]) * 2u; } while (0)
    Unit cur, nxt; int ui = 0;
    if (!S.next(0, cur)) return;
    f32x4 acc[2][2][4][2];
#pragma unroll
    for (int a = 0; a < 2; ++a)
#pragma unroll
        for (int b = 0; b < 2; ++b)
#pragma unroll
            for (int m = 0; m < 4; ++m)
#pragma unroll
                for (int n = 0; n < 2; ++n) acc[a][b][m][n] = (f32x4){0.f, 0.f, 0.f, 0.f};
    bf16x8 At[4][2], B0[2][2], B1[2][2];
    const char* cA = GATHER ? (const char*)g.A : (const char*)g.A + (size_t)cur.pm * tstep; const char* cB = (const char*)g.Bt + (size_t)cur.pb * tstep;
    S.a_ready(cur);
    if constexpr (GATHER) { PG8_FETCH_ROWS(cur, 0); PG8_WAIT_L(0); PG8_BAR; asm volatile("" ::: "memory"); PG8_ROW_OFFS(vc, 0); }
    PG8_STAGE(PG8_SB(0, 0), cB, voffB); PG8_STAGE(PG8_SB(0, 1), cB + hstep, voffB); PG8_STAGE(PG8_SA(0, 0), cA, vc[0]); PG8_STAGE(PG8_SA(0, 1), cA, vc[1]);
    if (wr == 1) PG8_BAR;
    PG8_WAIT_V(2); PG8_BAR;
    PG8_STAGE(PG8_SB(1, 0), cB + kstep, voffB); PG8_STAGE(PG8_SA(1, 0), cA + kstep, vc[0]); PG8_STAGE(PG8_SB(1, 1), cB + hstep + kstep, voffB);
    PG8_WAIT_V(6); PG8_BAR;
    for (;;) {
        const bool has_next = S.next(ui + 1, nxt);
        const char* nA = GATHER ? (const char*)g.A : (has_next ? (const char*)g.A + (size_t)nxt.pm * tstep : cA); const char* nB = has_next ? (const char*)g.Bt + (size_t)nxt.pb * tstep : cB;
        if constexpr (GATHER) { if (has_next) PG8_FETCH_ROWS(nxt, (ui + 1) & 1); }
        for (int t = 0; t < nt; t += 2) {
            const bool last = (t == nt - 2);
            const char* a1 = cA + (size_t)(t + 1) * kstep;
            const char* a2 = last ? nA : cA + (size_t)(t + 2) * kstep; const char* b2 = last ? nB : cB + (size_t)(t + 2) * kstep;
            const char* a3 = a2 + kstep; const char* b3 = b2 + kstep;
            if (last && has_next) { S.a_ready(nxt); if constexpr (GATHER) { PG8_ROW_OFFS(vn, (ui + 1) & 1); } }
            unsigned v2[2][2];
#pragma unroll
            for (int h = 0; h < 2; ++h)
#pragma unroll
                for (int i = 0; i < 2; ++i) v2[h][i] = (GATHER && last && has_next) ? vn[h][i] : vc[h][i];
            PG8_LDB(B0, 0, 0); PG8_LDB(B1, 0, 1); PG8_SCHED; PG8_LDA(At, 0, 0); PG8_STAGE(PG8_SA(1, 1), a1, vc[1]);
            PG8_WAIT_V(8); PG8_WAIT_L(0); PG8_BAR; PG8_MMA(0, 0, At, B0); PG8_MMA(0, 1, At, B1); PG8_BAR; PG8_SCHED;
            PG8_LDA(At, 0, 1); PG8_STAGE(PG8_SB(0, 0), b2, voffB); PG8_STAGE(PG8_SB(0, 1), b2 + hstep, voffB); PG8_STAGE(PG8_SA(0, 0), a2, v2[0]);
            PG8_WAIT_V(8); PG8_WAIT_L(0); PG8_BAR; PG8_MMA(1, 0, At, B0); PG8_MMA(1, 1, At, B1); PG8_BAR; PG8_SCHED;
            PG8_LDB(B0, 1, 0); PG8_LDB(B1, 1, 1); PG8_SCHED; PG8_LDA(At, 1, 0); PG8_STAGE(PG8_SA(0, 1), a2, v2[1]);
            PG8_WAIT_V(8); PG8_WAIT_L(0); PG8_BAR; PG8_MMA(0, 0, At, B0); PG8_MMA(0, 1, At, B1); PG8_BAR; PG8_SCHED;
            PG8_LDA(At, 1, 1); PG8_STAGE(PG8_SB(1, 0), b3, voffB); PG8_STAGE(PG8_SB(1, 1), b3 + hstep, voffB); PG8_STAGE(PG8_SA(1, 0), a3, v2[0]);
            PG8_WAIT_V(8); PG8_WAIT_L(0); PG8_BAR; PG8_MMA(1, 0, At, B0); PG8_MMA(1, 1, At, B1); PG8_BAR; PG8_SCHED;
        }
        if constexpr (ALIGN_EPI) { if (wr == 0) PG8_BAR; }
        if constexpr (!Epi::AFTER_DRAIN) { E(acc, cur, wr, wc, fr, fq); S.done(cur); }
        if (!has_next) break;
#pragma unroll
        for (int a = 0; a < 2; ++a)
#pragma unroll
            for (int b = 0; b < 2; ++b)
#pragma unroll
                for (int m = 0; m < 4; ++m)
#pragma unroll
                    for (int n = 0; n < 2; ++n) acc[a][b][m][n] = (f32x4){0.f, 0.f, 0.f, 0.f};
        cur = nxt; cA = nA; cB = nB; ++ui;
        if constexpr (GATHER) {
#pragma unroll
            for (int h = 0; h < 2; ++h)
#pragma unroll
                for (int i = 0; i < 2; ++i) vc[h][i] = vn[h][i]; }
        if constexpr (ALIGN_EPI) { if (wr == 1) PG8_BAR; }
    }
    PG8_WAIT_V(0);
    if constexpr (!ALIGN_EPI) { if (wr == 0) PG8_BAR; }
    PG8_BAR;
    if constexpr (Epi::AFTER_DRAIN) { E.fused(acc, cur, wr, wc, fr, fq, lds, wid, lane); S.done(cur); }
#undef PG8_SA
#undef PG8_SB
#undef PG8_STAGE
#undef PG8_LDA
#undef PG8_LDB
#undef PG8_MMA
#undef PG8_WAIT_V
#undef PG8_WAIT_L
#undef PG8_BAR
#undef PG8_SCHED
#undef PG8_FETCH_ROWS
#undef PG8_ROW_OFFS
}
}
#ifndef PG8_SP2
#define PG8_SP2 true
#endif
#ifndef PG8_ALIGN
#define PG8_ALIGN true
#endif
constexpr int BATCH = 4, SEQ = 4096, T = BATCH * SEQ, D = 2048, DEPTH = 4;
constexpr int HY_N = 5128, HY_NP = 5376;
constexpr int SS_N = 10304, SS_NP = 10496;
constexpr int LRU_W = 1024;
constexpr int SSD_INNER = 4096, SSD_CONV = 6144, SSD_H = 64, SSD_P = 64, SSD_G = 8, SSD_NS = 128, SSD_L = 128, SSD_NC = SEQ / SSD_L;
constexpr int MOE_FF = 1024, MOE_E = 16, MOE_ROWS = 2 * T + MOE_E * 256;
constexpr float ALPHA = 1.6817928305074290f;
constexpr float LN_EPS = 1e-5f, RMS_EPS = 1e-5f;
constexpr int NWAVES = 8, NTHR = 512;
constexpr size_t MiB = 1u << 20;
constexpr size_t WS_CTL = 0, CTL_ZERO_BYTES = 1 * MiB;
constexpr size_t WS_TOKSLOT = 1 * MiB;
constexpr size_t WS_TOKPOS = WS_TOKSLOT + 512 * 1024;
constexpr size_t WS_ROWGATE = WS_TOKPOS + 128 * 1024;
constexpr size_t WS_WRT = 2 * MiB;
constexpr size_t WS_WRI = 3 * MiB;
constexpr size_t WS_WHYIN = 4 * MiB;
constexpr size_t WS_WHYOUT = 46 * MiB;
constexpr size_t WS_WSSIN = 62 * MiB;
constexpr size_t WS_WSSOUT = 144 * MiB;
constexpr size_t WS_WGU = 176 * MiB;
constexpr size_t WS_WD = 304 * MiB;
constexpr size_t WS_X = 368 * MiB;
#ifndef F8_HY_IN
#define F8_HY_IN 1
#endif
#ifndef F8_SS_IN
#define F8_SS_IN 0
#endif
#ifndef F8_HY_OUT
#define F8_HY_OUT 1
#endif
#ifndef F8_SS_OUT
#define F8_SS_OUT 0
#endif
constexpr size_t WS_YN8 = 420 * MiB;
constexpr size_t WS_XIN8 = 368 * MiB;
constexpr size_t WS_WHYIN8 = 400 * MiB;
constexpr size_t WS_WSSIN8 = 420 * MiB;
constexpr size_t WS_XB = 496 * MiB;
constexpr size_t WS_MBUF = 560 * MiB;
constexpr size_t WS_ARENA = 624 * MiB;
constexpr size_t WS_PROJ = WS_ARENA;
constexpr size_t WS_HLOC = WS_ARENA + 168 * MiB;
constexpr size_t WS_CUMA = WS_ARENA + 232 * MiB;
constexpr size_t WS_LSUM = WS_ARENA + 296 * MiB;
constexpr size_t WS_YMIX = WS_ARENA + 298 * MiB;
constexpr size_t WS_FCUM = WS_ARENA + 362 * MiB;
constexpr size_t WS_STATES = WS_ARENA + 328 * MiB;
constexpr size_t WS_YN = WS_ARENA + 456 * MiB;
constexpr size_t WS_YMIX8 = WS_ARENA + 298 * MiB;
constexpr size_t WS_DTB = WS_ARENA + 584 * MiB;
constexpr size_t WS_ACSB = WS_ARENA + 588 * MiB;
constexpr size_t WS_XS = WS_ARENA + 592 * MiB;
constexpr size_t WS_BS = WS_ARENA + 720 * MiB;
constexpr size_t WS_WGU_B = WS_ARENA + 752 * MiB;
constexpr size_t WS_WD_B = WS_ARENA + 880 * MiB;
constexpr size_t WS_EXPTOK = WS_ARENA;
constexpr size_t WS_EXPW = WS_ARENA + 1 * MiB;
constexpr size_t WS_XB8 = WS_ARENA + 4 * MiB;
constexpr size_t WS_XG = WS_ARENA;
constexpr size_t WS_HID = WS_ARENA + 144 * MiB;
constexpr size_t WS_YG = WS_ARENA + 216 * MiB;
constexpr size_t WS_NAIVE = WS_ARENA + 600 * MiB;
constexpr size_t WS_END = WS_ARENA + 1060 * MiB;
constexpr int CW_TMO = 0, CW_CODE = 1, CW_CNT = 64  , CW_CVTHEAD = 256  , CW_DONE = 512  , CW_BAR = 4096;
constexpr int N_BAR_REGIONS = 8;
constexpr int RING_OFF = 0, RING_BYTES = 159744, LDSCTL_OFF = RING_BYTES, MISC_OFF = LDSCTL_OFF + 320, LDS_BYTES = 163840;
constexpr int TAB_OFF = LDSCTL_OFF;

#define GAS __attribute__((address_space(1)))
#define LAS __attribute__((address_space(3)))
typedef unsigned short bf16_t;
typedef unsigned v4u __attribute__((ext_vector_type(4)));
typedef unsigned v2u __attribute__((ext_vector_type(2)));
typedef float f32x4 __attribute__((ext_vector_type(4)));
typedef short bf16x8 __attribute__((ext_vector_type(8)));
typedef GAS unsigned gu32;
#define RLX_AGENT __ATOMIC_RELAXED, __HIP_MEMORY_SCOPE_AGENT
#define LDS_WAIT() asm volatile("s_waitcnt lgkmcnt(0)" ::: "memory")
#define VM_WAIT() asm volatile("s_waitcnt vmcnt(0)" ::: "memory")
__device__ __forceinline__ unsigned f2bf(float f) { unsigned u = __builtin_bit_cast(unsigned, f); return (u + 0x7fffu + ((u >> 16) & 1u)) >> 16; }
typedef float f32x2_t __attribute__((ext_vector_type(2))); typedef __bf16 bf16x2_t __attribute__((ext_vector_type(2)));
__device__ __forceinline__ unsigned pk2(float lo, float hi) { f32x2_t v = {lo, hi}; bf16x2_t b = __builtin_convertvector(v, bf16x2_t); return __builtin_bit_cast(unsigned, b); }
__device__ __forceinline__ float bf2f(unsigned short v) { return __uint_as_float(((unsigned)v) << 16); }
__device__ __forceinline__ float bflo(unsigned w) { return __uint_as_float(w << 16); }
__device__ __forceinline__ float bfhi(unsigned w) { return __uint_as_float(w & 0xffff0000u); }
__device__ __forceinline__ float sigmoid_(float x) { return __builtin_amdgcn_rcpf(1.0f + __expf(-x)); }
__device__ __forceinline__ float silu_(float x) { return x / (1.0f + __expf(-x)); }
__device__ __forceinline__ int pk_fp8x4(f32x4 v, float sc) { v = v * sc;
    const float a = __builtin_amdgcn_fmed3f(v.x, -448.f, 448.f), b = __builtin_amdgcn_fmed3f(v.y, -448.f, 448.f), c = __builtin_amdgcn_fmed3f(v.z, -448.f, 448.f), d = __builtin_amdgcn_fmed3f(v.w, -448.f, 448.f);
    int w = __builtin_amdgcn_cvt_pk_fp8_f32(a, b, 0, false); return __builtin_amdgcn_cvt_pk_fp8_f32(c, d, w, true); }
__device__ __forceinline__ float silu_fast2(float x) { return x * __builtin_amdgcn_rcpf(1.0f + __expf(-x)); }
__device__ __forceinline__ float log1p_fast(float e) { return e < 0.06f ? e * (1.0f - e * (0.5f - e * (0.33333333f - e * 0.25f))) : __logf(1.0f + e); }
__device__ __forceinline__ float softplus_(float x) { return fmaxf(x, 0.f) + log1p_fast(__expf(-fabsf(x))); }
__device__ __forceinline__ float gelu_tanh_(float x) { const float u = 0.7978845608028654f * (x + 0.044715f * x * x * x); return 0.5f * x * (1.0f + tanhf(u)); }
#define XB_TMO      128
#define XB_XCNT(j)  (256  + 64 * (j))
#define XB_XSUB(j)  (1280 + 64 * (j))
#define XB_XGEN(j)  (2304 + 64 * (j))
#define XB_TOP      3328
#define XB_TOPGEN   3392
#define XCD_BAR_WORDS 3456
#define XB_SPIN_CAP (1u << 18)

__device__ __forceinline__ unsigned xb_ld(unsigned* p)              { return __hip_atomic_load(p, __ATOMIC_RELAXED, __HIP_MEMORY_SCOPE_AGENT); }
__device__ __forceinline__ unsigned xb_add(unsigned* p, unsigned v) { return __hip_atomic_fetch_add(p, v, __ATOMIC_RELAXED, __HIP_MEMORY_SCOPE_AGENT); }
__device__ __forceinline__ unsigned xb_xcc_id() { return (unsigned)__builtin_amdgcn_s_getreg((3 << 11) | 20) & 0xFu; }
#define XB_SPIN(cond, bar) do { unsigned _sp = 0; while (cond) { __builtin_amdgcn_s_sleep(1); \
    if ((++_sp & 255u) == 0u) { if (xb_ld(&(bar)[XB_TMO])) break; if (_sp > XB_SPIN_CAP) { atomicAdd(&(bar)[XB_TMO], 1u); break; } } } } while (0)

struct XcdBarrier {
    unsigned* bar; unsigned x;
    volatile LAS unsigned* st;
};

__device__ __forceinline__ XcdBarrier xcd_barrier_post(unsigned* bar, volatile LAS unsigned* st, int tid) {
    XcdBarrier b; b.bar = bar; b.x = xb_xcc_id(); b.st = st;
    if (tid == 0) (void)xb_add(&bar[XB_XCNT(b.x)], 1u);
    return b;
}
__device__ __forceinline__ void xcd_barrier_complete(unsigned* bar, unsigned x, unsigned& nloc, unsigned& nx) {
    const unsigned G = gridDim.x * gridDim.y * gridDim.z;
    unsigned sum, cnt, mine, sp = 0u;
    for (;;) {
        sum = 0u; cnt = 0u; mine = 0u;
#pragma unroll
        for (unsigned j = 0; j < 16; ++j) { const unsigned c = xb_ld(&bar[XB_XCNT(j)]); sum += c; cnt += (c > 0u) ? 1u : 0u; mine = (j == x) ? c : mine; }
        if (sum == G) break;
        __builtin_amdgcn_s_sleep(1);
        if ((++sp & 255u) == 0u) { if (xb_ld(&bar[XB_TMO])) break; if (sp > XB_SPIN_CAP) { atomicAdd(&bar[XB_TMO], 1u); break; } }
    }
    nloc = mine > 0u ? mine : 1u; nx = cnt > 0u ? cnt : 1u;
}

__device__ __forceinline__ void xcd_barrier(const XcdBarrier& b, int tid) {
    asm volatile("s_waitcnt vmcnt(0)" ::: "memory");
    __syncthreads();
    if (tid == 0) {
        unsigned* bar = b.bar;
        __builtin_amdgcn_s_waitcnt(0);
        unsigned nloc = b.st[0], nx = b.st[1];
        if (nloc == 0u) { xcd_barrier_complete(bar, b.x, nloc, nx); b.st[0] = nloc; b.st[1] = nx; }
        const unsigned old = xb_add(&bar[XB_XSUB(b.x)], 1u);
        const unsigned gen = old / nloc;
        if (old + 1u == (gen + 1u) * nloc) {
            __builtin_amdgcn_fence(__ATOMIC_RELEASE, "agent");
            asm volatile("s_waitcnt vmcnt(0)" ::: "memory");
            const unsigned og = xb_add(&bar[XB_TOP], 1u);
            const unsigned tg = og / nx;
            if (og + 1u == (tg + 1u) * nx) xb_add(&bar[XB_TOPGEN], 1u);
            else XB_SPIN(xb_ld(&bar[XB_TOPGEN]) == tg, bar);
            __builtin_amdgcn_fence(__ATOMIC_ACQUIRE, "agent");
            xb_add(&bar[XB_XGEN(b.x)], 1u);
            asm volatile("s_waitcnt vmcnt(0)" ::: "memory");
        } else {
            XB_SPIN(xb_ld(&bar[XB_XGEN(b.x)]) == gen, bar);
            __builtin_amdgcn_fence(__ATOMIC_ACQUIRE, "agent");
            asm volatile("s_waitcnt vmcnt(0)" ::: "memory");
        }
    }
    __syncthreads();
}
namespace fox {
using bf16 = unsigned short;
constexpr int D = 128, QPITCH = 5376, KVPITCH = 5376, OPITCH = 2048;
constexpr bool WSKIP = false;
constexpr float THR = 8.f;
constexpr float SCALE = 0.08838834764831845f;
constexpr int NW = 8, QBLK = 32, KVBLK = 64, QB = NW * QBLK;
constexpr int SHM_V = KVBLK * D * 2, SHM_K = KVBLK * D * 2;
constexpr int ATT_LDS = 2 * SHM_V + 2 * SHM_K + NW * 64 * 4;
constexpr int FB_OFF = ATT_LDS;
constexpr int ATT_LDS_TOTAL = FB_OFF + 4096 * 8;
typedef short bf16x8 __attribute__((ext_vector_type(8)));
typedef short s16x4 __attribute__((ext_vector_type(4)));
typedef float f32x16 __attribute__((ext_vector_type(16)));
typedef float f32x4 __attribute__((ext_vector_type(4)));
typedef unsigned u32x4 __attribute__((ext_vector_type(4)));
template <class A, class Bt> struct same_t { static constexpr bool v = false; };
template <class A> struct same_t<A, A> { static constexpr bool v = true; };

#define KSWZ(row, colB) ((row) * 256 + ((colB) ^ (((row) & 7) << 4)))
#define SBAR() __builtin_amdgcn_sched_barrier(0)
__device__ __forceinline__ int v_st(int k, int c) { const int kk = (k & ~0xC) | ((k & 4) << 1) | ((k & 8) >> 1); return ((kk >> 3) * 4 + (c >> 5)) * 512 + ((kk & 7) * 32 + (c & 31)) * 2; }
__device__ __forceinline__ int v_rd_base(int lane) { return ((lane & 3) << 3) | (((lane >> 2) & 3) << 6) | (((lane >> 4) & 1) << 5) | (((lane >> 5) & 1) << 8); }
constexpr int v_rd_off(int d0, int ks, int half) { return d0 * 512 + ks * 4096 + half * 2048; }
__device__ __forceinline__ int crow(int r, int hi) { return (r & 3) + 8 * (r >> 2) + 4 * hi; }
__device__ __forceinline__ unsigned cvtpk(float lo, float hi) {
    unsigned r; asm volatile("v_cvt_pk_bf16_f32 %0, %1, %2" : "=v"(r) : "v"(lo), "v"(hi)); return r;
}
__device__ __forceinline__ bf16x8 pack8(f32x4 a, f32x4 b) {
    u32x4 w = {cvtpk(a[0], a[1]), cvtpk(a[2], a[3]), cvtpk(b[0], b[1]), cvtpk(b[2], b[3])};
    return *reinterpret_cast<bf16x8*>(&w);
}
template <class T> __device__ __forceinline__ bf16x8 load8(const T* p) {
    if constexpr (same_t<T, float>::v) { return pack8(*(const f32x4*)p, *(const f32x4*)(p + 4)); }
    else { return *reinterpret_cast<const bf16x8*>(p); }
}
__device__ __forceinline__ void mask_tile(f32x16& p0, f32x16& p1, int dq, unsigned W) {
    const float NEG = -__builtin_inff();
#pragma unroll
    for (int r = 0; r < 16; ++r) {
        const int c = (r & 3) + 8 * (r >> 2);
        if ((unsigned)(dq - c) >= W) p0[r] = NEG;
        if ((unsigned)(dq - c - 32) >= W) p1[r] = NEG;
    }
}
__device__ __forceinline__ void partialSM(f32x16& p0, f32x16& p1, float& m_reg, float& mn, float& alpha) {
    float pmax = p0[0]; for (int r = 1; r < 16; ++r) pmax = fmaxf(pmax, p0[r]); for (int r = 0; r < 16; ++r) pmax = fmaxf(pmax, p1[r]);
    { auto rr = __builtin_amdgcn_permlane32_swap(__float_as_uint(pmax), __float_as_uint(pmax), false, false);
      pmax = fmaxf(__uint_as_float(rr[0]), __uint_as_float(rr[1])); }
    constexpr float C2 = 1.4426950408889634f * SCALE;
    if (__builtin_expect(__all((pmax - m_reg) * SCALE <= THR), 1)) { mn = m_reg; alpha = 1.f; }
    else { mn = fmaxf(m_reg, pmax); alpha = __builtin_amdgcn_exp2f((m_reg - mn) * C2); m_reg = mn; }
    const float mnL = -mn * C2;
    for (int r = 0; r < 16; ++r) p0[r] = fmaf(p0[r], C2, mnL); for (int r = 0; r < 16; ++r) p1[r] = fmaf(p1[r], C2, mnL);
    for (int r = 0; r < 16; ++r) p0[r] = __builtin_amdgcn_exp2f(p0[r]);
}
__device__ __forceinline__ void finishSM(f32x16& p0, f32x16& p1, float alpha, float& l_reg, bf16x8& pa0, bf16x8& pa1, bf16x8& pa2, bf16x8& pa3) {
    for (int r = 0; r < 16; ++r) p1[r] = __builtin_amdgcn_exp2f(p1[r]);
    float ps = 0; for (int r = 0; r < 16; ++r) ps += p0[r]; for (int r = 0; r < 16; ++r) ps += p1[r];
    { auto rr = __builtin_amdgcn_permlane32_swap(__float_as_uint(ps), __float_as_uint(ps), false, false);
      ps = __uint_as_float(rr[0]) + __uint_as_float(rr[1]); }
    l_reg = l_reg * alpha + ps;
#define PK4(P, B_, OUT) do { unsigned a0 = cvtpk(P[B_+0], P[B_+1]), a1 = cvtpk(P[B_+2], P[B_+3]);                          \
        unsigned b0 = cvtpk(P[B_+4], P[B_+5]), b1 = cvtpk(P[B_+6], P[B_+7]);                                             \
        auto r0 = __builtin_amdgcn_permlane32_swap(a0, b0, false, false); auto r1 = __builtin_amdgcn_permlane32_swap(a1, b1, false, false); \
        u32x4 w = {r0[0], r1[0], r0[1], r1[1]}; OUT = *reinterpret_cast<bf16x8*>(&w); } while (0)
    PK4(p0, 0, pa0); PK4(p0, 8, pa1); PK4(p1, 0, pa2); PK4(p1, 8, pa3);
#undef PK4
}
template <int KB, bool SK>
__device__ __forceinline__ void qkt(f32x16& p0, f32x16& p1, const char* K_lds, int r32, int hi, const bf16x8* qr, bool act, const char* fbp) {
    if (SK && !act) { const float NEG = -__builtin_inff();
#pragma unroll
        for (int r = 0; r < 16; ++r) { p0[r] = NEG; p1[r] = NEG; } return; }
    p0 = f32x16{}; p1 = f32x16{};
    const char* kb[4];
#pragma unroll
    for (int dd = 0; dd < 4; ++dd) kb[dd] = K_lds + KB * SHM_K + KSWZ(r32, (dd * 16 + hi * 8) * 2);
#pragma unroll
    for (int d0 = 0; d0 < 8; ++d0) { const char* a = kb[d0 & 3] + (d0 >> 2) * 128;
        bf16x8 b0 = *reinterpret_cast<const bf16x8*>(a);
        bf16x8 b1 = *reinterpret_cast<const bf16x8*>(a + 32 * 256);
        p0 = __builtin_amdgcn_mfma_f32_32x32x16_bf16(b0, qr[d0], p0, 0, 0, 0);
        p1 = __builtin_amdgcn_mfma_f32_32x32x16_bf16(b1, qr[d0], p1, 0, 0, 0); }
#ifndef FOX_NO_BIAS
    { typedef unsigned u32x2 __attribute__((ext_vector_type(2)));
      const u32x2 f0 = *reinterpret_cast<const u32x2*>(fbp), f1 = *reinterpret_cast<const u32x2*>(fbp + 32 * 8);
      const unsigned m = hi ? 0u : 0xffffffffu;
      u32x4 a0 = {f0.x & m, f0.y & m, 0u, 0u}, a1 = {f1.x & m, f1.y & m, 0u, 0u}; u32x4 qa = {0x3f803f80u, 0x00003f80u, 0u, 0u};
      p0 = __builtin_amdgcn_mfma_f32_32x32x16_bf16(*reinterpret_cast<bf16x8*>(&a0), *reinterpret_cast<bf16x8*>(&qa), p0, 0, 0, 0);
      p1 = __builtin_amdgcn_mfma_f32_32x32x16_bf16(*reinterpret_cast<bf16x8*>(&a1), *reinterpret_cast<bf16x8*>(&qa), p1, 0, 0, 0); }
#endif
}
template <int VB, bool SK>
__device__ __forceinline__ void pv_tile(f32x16* o, int vb0, bf16x8 pa0, bf16x8 pa1, bf16x8 pa2, bf16x8 pa3, bool act) {
    if (SK && !act) return;
#define TRRD(dst, off) asm volatile("ds_read_b64_tr_b16 %0, %1 offset:%2" : "=&v"(dst) : "v"(vb0), "i"(off) : "memory")
#define PV_D0(d0) do { s16x4 l0, l1, l2, l3, h0, h1, h2, h3; constexpr int b_ = VB * SHM_V + v_rd_off(d0, 0, 0);     \
        TRRD(l0, b_); TRRD(h0, b_ + 2048); TRRD(l1, b_ + 4096); TRRD(h1, b_ + 6144); TRRD(l2, b_ + 8192); TRRD(h2, b_ + 10240); TRRD(l3, b_ + 12288); TRRD(h3, b_ + 14336); \
        asm volatile("s_waitcnt lgkmcnt(0)" ::: "memory"); SBAR();                 \
        o[d0] = __builtin_amdgcn_mfma_f32_32x32x16_bf16(pa0, (bf16x8){l0[0], l0[1], l0[2], l0[3], h0[0], h0[1], h0[2], h0[3]}, o[d0], 0, 0, 0);   \
        o[d0] = __builtin_amdgcn_mfma_f32_32x32x16_bf16(pa1, (bf16x8){l1[0], l1[1], l1[2], l1[3], h1[0], h1[1], h1[2], h1[3]}, o[d0], 0, 0, 0);   \
        o[d0] = __builtin_amdgcn_mfma_f32_32x32x16_bf16(pa2, (bf16x8){l2[0], l2[1], l2[2], l2[3], h2[0], h2[1], h2[2], h2[3]}, o[d0], 0, 0, 0);   \
        o[d0] = __builtin_amdgcn_mfma_f32_32x32x16_bf16(pa3, (bf16x8){l3[0], l3[1], l3[2], l3[3], h3[0], h3[1], h3[2], h3[3]}, o[d0], 0, 0, 0); } while (0)
    PV_D0(0); PV_D0(1); PV_D0(2); PV_D0(3);
#undef PV_D0
#undef TRRD
}

template <class TIn, class TOut> struct BlockRef { const TIn* Q; const TIn* K; const TIn* V; TOut* O; int P0; };
template <class TIn> struct Seam {
    bf16x8 qr[8];
    bf16x8 st_v0, st_v1, st_k0, st_k1; f32x4 sf0, sf1, sf2, sf3;
    f32x4 tq[16];
};
__device__ __forceinline__ int swa_jlo(int P0, int W) { const int lowk = P0 - W + 1; return lowk > 0 ? lowk / KVBLK : 0; }
#define ROW(p, k0, rr) ((p) + (size_t)((k0) + (rr)) * KVPITCH + sc)
#define VMW() asm volatile("s_waitcnt vmcnt(0)" ::: "memory")
#define VMWN(n) asm volatile("s_waitcnt vmcnt(%0)" :: "i"(n) : "memory")
#define SLOAD_H(Kp, Vp, k0) do { S.st_v0 = load8<TIn>(ROW(Vp, k0, sr)); S.st_v1 = load8<TIn>(ROW(Vp, k0, 32 + sr));              \
                         S.st_k0 = load8<TIn>(ROW(Kp, k0, sr)); S.st_k1 = load8<TIn>(ROW(Kp, k0, 32 + sr)); } while (0)
#define SWRITE_HK(bf) do { *(bf16x8*)(K_lds + (bf) * SHM_K + kws) = S.st_k0; *(bf16x8*)(K_lds + (bf) * SHM_K + kws + 32 * 256) = S.st_k1; } while (0)
#define SWRITE_HV(bf) do { *(bf16x8*)(V_lds + (bf) * SHM_V + vst0) = S.st_v0; *(bf16x8*)(V_lds + (bf) * SHM_V + vst1) = S.st_v1; } while (0)
#define SWRITE_H(bf) do { SWRITE_HV(bf); SWRITE_HK(bf); } while (0)
#define SLOAD_F(p, k0) do { S.sf0 = *(const f32x4*)ROW(p, k0, sr); S.sf1 = *(const f32x4*)(ROW(p, k0, sr) + 4);                \
                            S.sf2 = *(const f32x4*)ROW(p, k0, 32 + sr); S.sf3 = *(const f32x4*)(ROW(p, k0, 32 + sr) + 4); } while (0)
#define SWRITE_KF(bf) do { *(bf16x8*)(K_lds + (bf) * SHM_K + kws) = pack8(S.sf0, S.sf1); *(bf16x8*)(K_lds + (bf) * SHM_K + kws + 32 * 256) = pack8(S.sf2, S.sf3); } while (0)
#define SWRITE_VF(bf) do { *(bf16x8*)(V_lds + (bf) * SHM_V + vst0) = pack8(S.sf0, S.sf1); *(bf16x8*)(V_lds + (bf) * SHM_V + vst1) = pack8(S.sf2, S.sf3); } while (0)
template <class TIn, class TOut>
__device__ __forceinline__ void causal_swa_prime(const BlockRef<TIn, TOut>& cur, int W, char* lds, Seam<TIn>& S, int tid_in) {
    constexpr bool F32 = same_t<TIn, float>::v;
    const int tid_ = fresh_tid(tid_in  ); const int tid = tid_, wid = __builtin_amdgcn_readfirstlane(tid >> 6), lane = tid & 63, r32 = lane & 31, hi = lane >> 5;
    const int sr = tid >> 4, sc = (tid & 15) * 8, kws = KSWZ(sr, sc * 2); char* K_lds = lds + 2 * SHM_V;
    const int kb0 = swa_jlo(cur.P0, W) * KVBLK;
    for (int d0 = 0; d0 < 8; ++d0) S.qr[d0] = load8<TIn>(cur.Q + (size_t)(wid * QBLK + r32) * QPITCH + d0 * 16 + hi * 8);
    if constexpr (F32) { SLOAD_F((const float*)cur.K, kb0); VMW(); SWRITE_KF(0); SBAR(); SLOAD_F((const float*)cur.V, kb0); }
    else { SLOAD_H(cur.K, cur.V, kb0); VMW(); SWRITE_HK(0); }
    __syncthreads();
}
template <class TIn, class TOut>
__device__ __forceinline__ void causal_swa_block(const BlockRef<TIn, TOut>& cur, const BlockRef<TIn, TOut>& nxt, int skv, int W, char* lds, Seam<TIn>& S, int tid_in) {
    constexpr bool F32 = same_t<TIn, float>::v;
    const int tid_ = fresh_tid(tid_in  ); const int tid = tid_, wid = __builtin_amdgcn_readfirstlane(tid >> 6), lane = tid & 63, r32 = lane & 31, hi = lane >> 5;
    const int j_lo = swa_jlo(cur.P0, W);
    int j_hi = (cur.P0 + QB - 1) / KVBLK + 1; if (j_hi > skv / KVBLK) j_hi = skv / KVBLK;
    const int NT = j_hi - j_lo;
    const int kbn = swa_jlo(nxt.P0, W) * KVBLK;
    const int qlo = cur.P0 + wid * QBLK, qm = qlo + r32 - 4 * hi;
    char* V_lds = lds; char* K_lds = lds + 2 * SHM_V; const char* fbl = lds + FB_OFF + r32 * 8;
    float* ws = (float*)(lds + 2 * SHM_V + 2 * SHM_K) + wid * 64; float* li_l = ws, * al_l = ws + 32;
    float m_reg = -1e30f, l_reg = 0; f32x16 o[4] = {};
    const int sr = tid >> 4, sc = (tid & 15) * 8, vst0 = v_st(sr, sc), vst1 = v_st(32 + sr, sc), kws = KSWZ(sr, sc * 2);
    const int vb0 = (int)(uintptr_t)V_lds + v_rd_base(lane);
    const TIn* Kh = cur.K; const TIn* Vh = cur.V;
#define RESC(a) do { if (__any((a) < 1.f)) { if (hi == 0) al_l[r32] = (a); asm volatile("s_waitcnt lgkmcnt(0)" ::: "memory");              \
                     for (int d_ = 0; d_ < 4; ++d_) for (int r = 0; r < 16; ++r) o[d_][r] *= al_l[crow(r, hi)]; } } while (0)
#define KBASE(t) ((j_lo + (t)) * KVBLK)
#define ACT(t) (KBASE(t) <= qlo + QBLK - 1 && KBASE(t) + KVBLK - 1 >= qlo - W + 1)
#define MASKT(P0_, P1_, t) do { const int kb_ = KBASE(t); if ((!SK || ACT(t)) && (kb_ + KVBLK - 1 > qlo || kb_ <= qlo + QBLK - 1 - W)) mask_tile(P0_, P1_, qm - kb_, (unsigned)W); } while (0)
    constexpr int NQL = F32 ? 16 : 8;
    constexpr bool SK = WSKIP && !F32;
#define SEAM_K0() do { VMWN(NQL); if constexpr (F32) { SWRITE_KF(0); SBAR(); SLOAD_F((const float*)nxt.V, kbn); } else { SWRITE_HK(0); } SBAR(); } while (0)
    f32x16 pA0, pA1, pB0, pB1; float mnA, mnB, alA, alB; bf16x8 pa0, pa1, pa2, pa3;
    if constexpr (F32) { VMW(); SWRITE_VF(0); SBAR(); } else { SWRITE_HV(0); SBAR(); }
    if (NT > 1) { if constexpr (F32) SLOAD_F((const float*)Kh, KBASE(1)); else SLOAD_H(Kh, Vh, KBASE(1)); }
    SBAR(); qkt<0, SK>(pA0, pA1, K_lds, r32, hi, S.qr, ACT(0), fbl + KBASE(0) * 8);
    if constexpr (F32) { if (NT > 1) { VMW(); SWRITE_KF(1); SBAR(); SLOAD_F((const float*)Vh, KBASE(1)); } }
    MASKT(pA0, pA1, 0); partialSM(pA0, pA1, m_reg, mnA, alA);
    if (NT > 1) { VMW(); if constexpr (F32) { SWRITE_VF(1); SBAR(); if (NT > 2) SLOAD_F((const float*)Kh, KBASE(2)); } else SWRITE_H(1); }
    __syncthreads();
#define HALF_STEP(PX0, PX1, mnX, alX, PY0, PY1, alY, t, KB, VB, SB) do {                                                      \
        SBAR(); qkt<KB, SK>(PX0, PX1, K_lds, r32, hi, S.qr, ACT(t), fbl + KBASE(t) * 8);                                             \
        finishSM(PY0, PY1, alY, l_reg, pa0, pa1, pa2, pa3); SBAR();                                                           \
        if ((t) + 1 < NT) { if constexpr (F32) { VMW(); SWRITE_KF(SB); SBAR(); SLOAD_F((const float*)Vh, KBASE((t) + 1)); }  \
                            else { SLOAD_H(Kh, Vh, KBASE((t) + 1)); } SBAR(); }                                               \
        pv_tile<VB, SK>(o, vb0, pa0, pa1, pa2, pa3, ACT((t) - 1)); MASKT(PX0, PX1, (t)); partialSM(PX0, PX1, m_reg, mnX, alX);                                        \
        __syncthreads();                                                                                                      \
        if ((t) + 1 < NT) { VMW(); if constexpr (F32) { SWRITE_VF(SB); SBAR(); if ((t) + 2 < NT) SLOAD_F((const float*)Kh, KBASE((t) + 2)); } \
                            else { SWRITE_H(SB); } }                                                                          \
        RESC(alX); __syncthreads(); } while (0)
    for (int t = 1; t + 1 < NT; t += 2) {
        HALF_STEP(pB0, pB1, mnB, alB, pA0, pA1, alA, t, 1, 0, 0);
        HALF_STEP(pA0, pA1, mnA, alA, pB0, pB1, alB, t + 1, 0, 1, 1);
    }
    const bool even = (NT & 1) == 0;
    if (even) { SBAR(); qkt<1, SK>(pB0, pB1, K_lds, r32, hi, S.qr, ACT(NT - 1), fbl + KBASE(NT - 1) * 8); SBAR(); }
#define QROW(e) (nxt.Q + (size_t)(wid * QBLK + r32) * QPITCH + ((e) >> 1) * 16 + hi * 8 + ((e) & 1) * 4)
    if constexpr (F32) { SLOAD_F((const float*)nxt.K, kbn); SBAR();
#pragma unroll
        for (int e = 0; e < 8; ++e) S.tq[e] = *(const f32x4*)QROW(e); }
    else { SLOAD_H(nxt.K, nxt.V, kbn); SBAR();
#pragma unroll
        for (int d0 = 0; d0 < 8; ++d0) S.qr[d0] = load8<TIn>(nxt.Q + (size_t)(wid * QBLK + r32) * QPITCH + d0 * 16 + hi * 8); }
    SBAR();
    finishSM(pA0, pA1, alA, l_reg, pa0, pa1, pa2, pa3); SBAR();
    if constexpr (F32) {
#pragma unroll
        for (int e = 8; e < 16; ++e) S.tq[e] = *(const f32x4*)QROW(e); SBAR(); }
#undef QROW
    pv_tile<0, SK>(o, vb0, pa0, pa1, pa2, pa3, ACT(even ? NT - 2 : NT - 1));
    if (even) { MASKT(pB0, pB1, NT - 1); partialSM(pB0, pB1, m_reg, mnB, alB); __syncthreads(); RESC(alB);
        finishSM(pB0, pB1, alB, l_reg, pa0, pa1, pa2, pa3); SBAR(); pv_tile<1, SK>(o, vb0, pa0, pa1, pa2, pa3, ACT(NT - 1)); }
    SBAR(); SEAM_K0();
    if (hi == 0) li_l[r32] = l_reg; asm volatile("s_waitcnt lgkmcnt(0)" ::: "memory");
    float rli[16];
#pragma unroll
    for (int r = 0; r < 16; ++r) rli[r] = __builtin_amdgcn_rcpf(li_l[crow(r, hi)]);
    TOut* Ow = cur.O + (size_t)(wid * QBLK) * OPITCH;
#pragma unroll
    for (int r = 0; r < 16; ++r) { const int orow = crow(r, hi);
#pragma unroll
        for (int d0 = 0; d0 < 4; ++d0) { const float v = o[d0][r] * rli[r];
            if constexpr (same_t<TOut, float>::v) { Ow[(size_t)orow * OPITCH + d0 * 32 + r32] = v; }
            else { const float vn = shfl_xor_l(v, 1, lane);
                   if ((r32 & 1) == 0) { if (F8_HY_OUT) *(unsigned short*)((unsigned char*)cur.O + (size_t)(wid * QBLK + orow) * OPITCH + d0 * 32 + r32) = (unsigned short)__builtin_amdgcn_cvt_pk_fp8_f32(__builtin_amdgcn_fmed3f(4.0f * v, -448.f, 448.f), __builtin_amdgcn_fmed3f(4.0f * vn, -448.f, 448.f), 0, false);
                                          else *(unsigned*)(Ow + (size_t)orow * OPITCH + d0 * 32 + r32) = cvtpk(v, vn); } } } }
    if constexpr (F32) {
#pragma unroll
        for (int d0 = 0; d0 < 8; ++d0) S.qr[d0] = pack8(S.tq[2 * d0], S.tq[2 * d0 + 1]); }
    __syncthreads();
#undef RESC
#undef KBASE
#undef ACT
#undef MASKT
#undef SEAM_K0
#undef HALF_STEP
}
#undef ROW
#undef VMW
#undef VMWN
#undef SLOAD_H
#undef SWRITE_HK
#undef SWRITE_HV
#undef SWRITE_H
#undef SLOAD_F
#undef SWRITE_KF
#undef SWRITE_VF

__device__ __forceinline__ void bias_table(char* lds, const float* fl  , float bf, int nkeys, int tid) {
    asm volatile("" : "+v"(tid));
    typedef unsigned u32x2 __attribute__((ext_vector_type(2)));
    float* wsum = (float*)(lds + FB_OFF + 4096 * 8); u32x2* FB = (u32x2*)(lds + FB_OFF);
    const int lane = tid & 63, wave = tid >> 6; float lf[8];
#pragma unroll
    for (int i = 0; i < 8; ++i) { const int s = 8 * tid + i; float v = 0.f;
        if (s < nkeys) { const float x = fl[(size_t)s * 8] + bf; const float e = __expf(-x); v = -(x < -20.f ? -x : (e < 0.06f ? e * (1.0f - e * (0.5f - e * (0.33333333f - e * 0.25f))) : __logf(1.0f + e))); }
        lf[i] = v; }
#pragma unroll
    for (int i = 1; i < 8; ++i) lf[i] += lf[i - 1];
    const float tot = lf[7]; float sc = tot;
#pragma unroll
    for (int o = 1; o < 64; o <<= 1) { const float u = shfl_up_l(sc, o, lane); if (lane >= o) sc += u; }
    if (lane == 63) wsum[wave] = sc;
    __syncthreads();
    float base = sc - tot;
    for (int w = 0; w < wave; ++w) base += wsum[w];
#pragma unroll
    for (int i = 0; i < 8; ++i) { const int s = 8 * tid + i; const float G = -(base + lf[i]) * (1.0f / SCALE);
        unsigned u = __float_as_uint(G); const unsigned h16 = (u + 0x7fffu + ((u >> 16) & 1u)) >> 16; const float r1 = G - __uint_as_float(h16 << 16);
        u = __float_as_uint(r1); const unsigned m16 = (u + 0x7fffu + ((u >> 16) & 1u)) >> 16; const float r2 = r1 - __uint_as_float(m16 << 16);
        u = __float_as_uint(r2); const unsigned l16 = (u + 0x7fffu + ((u >> 16) & 1u)) >> 16;
        FB[s] = (u32x2){h16 | (m16 << 16), l16}; }
    __syncthreads();
}
__device__ __forceinline__ void attn_item(char* lds, const unsigned short* PROJ, const float* FLB, unsigned short* YMIX, const float* b_f, int item, int tid) {
    const int bh = item >> 3, x = item & 7, b = bh >> 3, h = bh & 7;
    const unsigned short* base = PROJ + (size_t)b * 4096 * KVPITCH + h * 128;
    bias_table(lds, FLB + (size_t)b * 4096 * 8 + h, b_f[h], (16 - x) * QB, tid);
    typedef BlockRef<bf16, bf16> Ref;
    Ref r0, r1;
    r0.Q = base + 2048 + (size_t)(x * QB) * QPITCH; r0.K = base + 3072; r0.V = base + 4096; r0.O = F8_HY_OUT ? (unsigned short*)((unsigned char*)YMIX + ((size_t)b * 4096 + x * QB) * OPITCH + 1024 + h * 128) : YMIX + ((size_t)b * 4096 + x * QB) * OPITCH + 1024 + h * 128; r0.P0 = x * QB;
    r1 = r0; r1.Q = base + 2048 + (size_t)((15 - x) * QB) * QPITCH; r1.O = F8_HY_OUT ? (unsigned short*)((unsigned char*)YMIX + ((size_t)b * 4096 + (15 - x) * QB) * OPITCH + 1024 + h * 128) : YMIX + ((size_t)b * 4096 + (15 - x) * QB) * OPITCH + 1024 + h * 128; r1.P0 = (15 - x) * QB;
    Seam<bf16> S; const int wv = __builtin_amdgcn_readfirstlane(tid >> 6);
    causal_swa_prime<bf16, bf16>(r0, 4096, lds, S, wv);
    Ref cur = r0;
    for (int pass = 0; pass < 2; ++pass) {
        causal_swa_block<bf16, bf16>(cur, r1, 4096, 4096, lds, S, wv);
        cur = r1;
    }
    asm volatile("s_waitcnt vmcnt(0)" ::: "memory");
    __syncthreads();
}
}
struct Ctx {
    LAS unsigned char* lds;
    volatile LAS unsigned* MISC;
    gu32* ctl;
    int tid, lane, wave, vcu, G;
    const float* in[28];
    float* out; unsigned char* ws;
};
__device__ __forceinline__ float wave_max(float v) {
#pragma unroll
    for (int o = 1; o < 64; o <<= 1) v = fmaxf(v, __shfl_xor(v, o));
    return v;
}
__device__ __forceinline__ float wave_sum_dpp(float v) {
    v += __builtin_bit_cast(float, __builtin_amdgcn_update_dpp(0, __builtin_bit_cast(int, v), 0x111, 0xf, 0xf, true));
    v += __builtin_bit_cast(float, __builtin_amdgcn_update_dpp(0, __builtin_bit_cast(int, v), 0x112, 0xf, 0xf, true));
    v += __builtin_bit_cast(float, __builtin_amdgcn_update_dpp(0, __builtin_bit_cast(int, v), 0x114, 0xf, 0xf, true));
    v += __builtin_bit_cast(float, __builtin_amdgcn_update_dpp(0, __builtin_bit_cast(int, v), 0x118, 0xf, 0xf, true));
    v += __builtin_bit_cast(float, __builtin_amdgcn_update_dpp(0, __builtin_bit_cast(int, v), 0x142, 0xa, 0xf, false));
    v += __builtin_bit_cast(float, __builtin_amdgcn_update_dpp(0, __builtin_bit_cast(int, v), 0x143, 0xc, 0xf, false));
    return __builtin_bit_cast(float, __builtin_amdgcn_readlane(__builtin_bit_cast(int, v), 63));
}
__device__ __forceinline__ float wave_sum(float v, int lane) {
#pragma unroll
    for (int o = 1; o < 64; o <<= 1) v += shfl_xor_l(v, o, lane);
    return v;
}
__device__ __forceinline__ float wave_sum(float v) {
#pragma unroll
    for (int o = 1; o < 64; o <<= 1) v += __shfl_xor(v, o);
    return v;
}
struct CvtJob { const float* W; bf16_t* WT; int K, N, mode, row_off, nblk, item, f8; };
__device__ __forceinline__ void cvt_load(const CvtJob& j, int lane, f32x4 (&v)[8]) {
    const int kb = j.item / j.nblk, nb = j.item - kb * j.nblk, k0 = 64 * kb, n0 = 32 * nb;
    const int c4 = (lane & 7) * 4, nn = n0 + c4; const bool ok = nn < j.N;
#pragma unroll
    for (int i = 0; i < 8; ++i) { const int kk = 8 * i + (lane >> 3); v[i] = ok ? __builtin_nontemporal_load((const GAS f32x4*)(j.W + (size_t)(k0 + kk) * j.N + nn)) : (f32x4){0.f, 0.f, 0.f, 0.f}; }
}
__device__ __forceinline__ void cvt_finish(const CvtJob& j, const f32x4 (&v)[8], LAS float* scr, int lane) {
    const int kb = j.item / j.nblk, nb = j.item - kb * j.nblk, k0 = 64 * kb, n0 = 32 * nb; const int c4 = (lane & 7) * 4;
#pragma unroll
    for (int i = 0; i < 8; ++i) { const int kk = 8 * i + (lane >> 3); LAS float* d = scr + kk * 33 + c4; d[0] = v[i].x; d[1] = v[i].y; d[2] = v[i].z; d[3] = v[i].w; }
    LDS_WAIT(); asm volatile("" ::: "memory");
    if (j.f8) {
        const int n = lane >> 1, hf = lane & 1; const LAS float* sp = scr + (32 * hf) * 33 + n; v4u o[2];
#pragma unroll
        for (int q = 0; q < 8; ++q) { int w = __builtin_amdgcn_cvt_pk_fp8_f32(__builtin_amdgcn_fmed3f(sp[(4 * q) * 33] * 128.0f, -448.f, 448.f), __builtin_amdgcn_fmed3f(sp[(4 * q + 1) * 33] * 128.0f, -448.f, 448.f), 0, false);
            w = __builtin_amdgcn_cvt_pk_fp8_f32(__builtin_amdgcn_fmed3f(sp[(4 * q + 2) * 33] * 128.0f, -448.f, 448.f), __builtin_amdgcn_fmed3f(sp[(4 * q + 3) * 33] * 128.0f, -448.f, 448.f), w, true);
            o[q >> 2][q & 3] = (unsigned)w; }
        const int ns = n0 + n; const int drow = j.mode == 0 ? j.row_off + ns : ((ns >> 7) * 256 + (ns & 127) + (j.mode == 2 ? 128 : 0));
        GAS v4u* dst = (GAS v4u*)((unsigned char*)j.WT + (size_t)drow * j.K + k0 + 32 * hf); dst[0] = o[0]; dst[1] = o[1];
        LDS_WAIT(); asm volatile("" ::: "memory"); return; }
    const int c = lane & 7;
#pragma unroll
    for (int q = 0; q < 4; ++q) { const int n = (lane >> 3) + 8 * q; const LAS float* sp = scr + (8 * c) * 33 + n;
        v4u o; o.x = pk2(sp[0 * 33], sp[1 * 33]); o.y = pk2(sp[2 * 33], sp[3 * 33]); o.z = pk2(sp[4 * 33], sp[5 * 33]); o.w = pk2(sp[6 * 33], sp[7 * 33]);
        const int ns = n0 + n; const int drow = j.mode == 0 ? j.row_off + ns : ((ns >> 7) * 256 + (ns & 127) + (j.mode == 2 ? 128 : 0));
        *(GAS v4u*)(j.WT + (size_t)drow * j.K + k0 + 8 * c) = o; }
    LDS_WAIT(); asm volatile("" ::: "memory");
}
__device__ __forceinline__ void cvt_item(const float* W, int K, int N, bf16_t* WT, int mode, int row_off, LAS float* scr, int item, int nblk, int lane, int f8 = 0) {
    const CvtJob j{W, WT, K, N, mode, row_off, nblk, item, f8}; f32x4 v[8]; cvt_load(j, lane, v); cvt_finish(j, v, scr, lane);
}
constexpr int MOE_CVT_ITEMS = 48 * 1024;
__device__ __forceinline__ CvtJob moe_cvt_job(Ctx& F, int layer, int it) {
    unsigned char* WGU = F.ws + ((layer & 1) ? WS_WGU_B : WS_WGU); unsigned char* WD = F.ws + ((layer & 1) ? WS_WD_B : WS_WD);
    const float* wg = F.in[25] + (size_t)layer * 16 * 2048 * 1024; const float* wu = F.in[26] + (size_t)layer * 16 * 2048 * 1024; const float* wd = F.in[27] + (size_t)layer * 16 * 1024 * 2048;
    const int mat = it >> 10, r0 = it & 1023, E = mat / 3, which = mat - 3 * E;
    const int nblk_ = which == 2 ? 64 : 32, p_ = r0 >> 1, r = (2 * (p_ / nblk_) + (r0 & 1)) * nblk_ + (p_ % nblk_);
    if (which == 0) return CvtJob{wg + (size_t)E * 2048 * 1024, (bf16_t*)(WGU + (size_t)E * 2048 * 2048), 2048, 1024, 1, 0, 32, r, 1};
    if (which == 1) return CvtJob{wu + (size_t)E * 2048 * 1024, (bf16_t*)(WGU + (size_t)E * 2048 * 2048), 2048, 1024, 2, 0, 32, r, 1};
    return CvtJob{wd + (size_t)E * 1024 * 2048, (bf16_t*)(WD + (size_t)E * 2048 * 1024), 1024, 2048, 0, 0, 64, r, 1};
}
__device__ __forceinline__ void moe_cvt_pair(Ctx& F, int layer, int itA, int itB, LAS float* scr) {
    const bool hasB = itB < MOE_CVT_ITEMS; const CvtJob ja = moe_cvt_job(F, layer, itA), jb = moe_cvt_job(F, layer, hasB ? itB : itA);
    f32x4 va[8], vb[8]; cvt_load(ja, F.lane, va); cvt_load(jb, F.lane, vb);
    cvt_finish(ja, va, scr, F.lane); if (hasB) cvt_finish(jb, vb, scr, F.lane);
}
__device__ __forceinline__ void moe_cvt_item(Ctx& F, int layer, int it, LAS float* scr) { const CvtJob j = moe_cvt_job(F, layer, it); f32x4 v[8]; cvt_load(j, F.lane, v); cvt_finish(j, v, scr, F.lane); }
__device__ __forceinline__ int moe_ntiles(Ctx& F, int layer) { int acc = 0;
#pragma unroll
    for (int e = 0; e < 16; ++e) { const unsigned c = __hip_atomic_load((unsigned*)(F.ctl + CW_CNT + layer * 16 + e), RLX_AGENT); acc += (int)((c + 255u) >> 8); }
    return __builtin_amdgcn_readfirstlane(acc); }
__device__ __forceinline__ int moe_cvt_done(Ctx& F, int layer) {
    if (layer == 0) return 0;
    const int h = (int)__hip_atomic_load((unsigned*)(F.ctl + CW_CVTHEAD + layer * 64), RLX_AGENT); return __builtin_amdgcn_readfirstlane(h < MOE_CVT_ITEMS ? h : MOE_CVT_ITEMS);
}
__device__ __forceinline__ int moe_gemm_wgs(Ctx& F, int ntiles, bool has_next) {
    const int U = 8 * ntiles; if (!has_next || U == 0) return F.G;
    const int rounds = (U + F.G - 1) / F.G; return (U + rounds - 1) / rounds; }
__device__ __forceinline__ void moe_tail_convert(Ctx& F, int next_layer, int Gg, int which) {
    const int rem = Gg; if (rem >= F.G) return;
    F.tid = fresh_tid(F.wave); F.lane = F.tid & 63;
    unsigned* done = (unsigned*)(F.ctl + CW_DONE + ((next_layer - 1) * 2 + which) * 64); unsigned* head = (unsigned*)(F.ctl + CW_CVTHEAD + next_layer * 64);
    if ((int)blockIdx.x < rem) { if (F.tid == 0) (void)__hip_atomic_fetch_add(done, 1u, RLX_AGENT); return; }
    LAS float* scr = (LAS float*)(F.lds + RING_OFF + F.wave * 16384); volatile LAS int* slot = (volatile LAS int*)(F.lds + RING_OFF + 8 * 16384);
    for (;;) {
        if (F.tid == 0) { int c = -1; if ((int)__hip_atomic_load(done, RLX_AGENT) < rem) c = (int)__hip_atomic_fetch_add(head, 16u, RLX_AGENT); *slot = c; }
        __syncthreads();
        const int c = *slot;
        if (c < 0 || c >= MOE_CVT_ITEMS) break;
        moe_cvt_pair(F, next_layer, c + 2 * F.wave, c + 2 * F.wave + 1, scr);
        __syncthreads();
    }
}
__device__ __forceinline__ void s0_convert(Ctx& F, int layer) {
    LAS float* scr = (LAS float*)(F.lds + RING_OFF + F.wave * 16384);
    const int gw = F.vcu * NWAVES + F.wave, NGW = F.G * NWAVES;
    for (int it = moe_cvt_done(F, layer) + 2 * gw; it < MOE_CVT_ITEMS; it += 2 * NGW) moe_cvt_pair(F, layer, it, it + 1, scr);
    if (layer == 0) {
        constexpr int I_HI = 32 * (HY_NP / 32), I_HO = 32 * 64, I_SI = 32 * (SS_NP / 32), I_SO = 64 * 64, I_RI = 2 * 4;
        constexpr int NIT = 2 * I_HI + 2 * I_HO + 2 * I_SI + 2 * I_SO + 32 * I_RI;
        for (int it = gw; it < NIT; it += NGW) {
            int r = it;
            if (r < 2 * I_HI) { const int j = r / I_HI; r -= j * I_HI; const bool f8 = F8_HY_IN && (r % (HY_NP / 32)) * 32 < 5120;
                cvt_item(F.in[3] + (size_t)j * 2048 * HY_N, 2048, HY_N, f8 ? (bf16_t*)(F.ws + WS_WHYIN8 + (size_t)j * 5120 * 2048) : (bf16_t*)(F.ws + WS_WHYIN) + (size_t)j * HY_NP * 2048, 0, 0, scr, r, HY_NP / 32, F.lane, f8); continue; } r -= 2 * I_HI;
            if (r < 2 * I_HO) { const int j = r / I_HO; r -= j * I_HO; cvt_item(F.in[12] + (size_t)j * 2048 * 2048, 2048, 2048, F8_HY_OUT ? (bf16_t*)(F.ws + WS_WHYOUT + (size_t)j * 2048 * 2048) : (bf16_t*)(F.ws + WS_WHYOUT) + (size_t)j * 2048 * 2048, 0, 0, scr, r, 64, F.lane, F8_HY_OUT); continue; } r -= 2 * I_HO;
            if (r < 2 * I_SI) { const int j = r / I_SI; r -= j * I_SI; const bool f8 = F8_SS_IN && (r % (SS_NP / 32)) * 32 < 10240;
                cvt_item(F.in[13] + (size_t)j * 2048 * SS_N, 2048, SS_N, f8 ? (bf16_t*)(F.ws + WS_WSSIN8 + (size_t)j * 10240 * 2048) : (bf16_t*)(F.ws + WS_WSSIN) + (size_t)j * SS_NP * 2048, 0, 0, scr, r, SS_NP / 32, F.lane, f8); continue; } r -= 2 * I_SI;
            if (r < 2 * I_SO) { const int j = r / I_SO; r -= j * I_SO; cvt_item(F.in[20] + (size_t)j * 4096 * 2048, 4096, 2048, F8_SS_OUT ? (bf16_t*)(F.ws + WS_WSSOUT + (size_t)j * 2048 * 4096) : (bf16_t*)(F.ws + WS_WSSOUT) + (size_t)j * 2048 * 4096, 0, 0, scr, r, 64, F.lane, F8_SS_OUT); continue; } r -= 2 * I_SO;
            { const int m = r / I_RI; r -= m * I_RI; const int jh = m >> 1, which = m & 1;
              cvt_item((which ? F.in[8] : F.in[6]) + (size_t)jh * 128 * 128, 128, 128, (bf16_t*)(F.ws + WS_WRI) + (size_t)jh * 256 * 128, 0, which * 128, scr, r, 4, F.lane); }
        }
        { bf16_t* WH = (bf16_t*)(F.ws + WS_WRT); bf16_t* WL = WH + 4 * 32 * 2048;
          for (int i = blockIdx.x * NTHR + F.tid; i < 4 * 32 * 2048; i += F.G * NTHR) { const int k = i & 2047, n = (i >> 11) & 31, L = i >> 16;
              const float v = n < 4 ? F.in[21][((size_t)L * 2048 + k) * 4 + n] : n < 20 ? F.in[23][(((size_t)L * 4 + ((n - 4) >> 2)) * 2048 + k) * 4 + ((n - 4) & 3)] : 0.f;
              const unsigned h = f2bf(v); WH[i] = (bf16_t)h; WL[i] = (bf16_t)f2bf(v - __uint_as_float(h << 16)); } }
        { float* LK = (float*)(F.ws + WS_TOKPOS); for (int i = blockIdx.x * NTHR + F.tid; i < 2 * 1024; i += F.G * NTHR) LK[i] = -8.0f * softplus_(-F.in[10][i]); }
        const float* x = F.in[0]; bf16_t* XB = (bf16_t*)(F.ws + WS_XB);
        for (int m = gw; m < T; m += NGW) { const GAS f32x4* xr = (const GAS f32x4*)(x + (size_t)m * D) + F.lane; GAS v2u* o = (GAS v2u*)(XB + (size_t)m * D) + F.lane;
#pragma unroll
            for (int j = 0; j < 8; ++j) { const f32x4 v = xr[64 * j]; v2u w; w.x = pk2(v.x, v.y); w.y = pk2(v.z, v.w); o[64 * j] = w;
                ((GAS int*)(F.ws + WS_XIN8 + (size_t)m * D))[F.lane + 64 * j] = pk_fp8x4(v, 4.0f); } }
    }
}
template <bool DRY = false> __device__ __forceinline__ void ln1_router(Ctx& F, int layer) {
    const int tid = fresh_tid(F.wave);
    const int lane = tid & 63, wave = __builtin_amdgcn_readfirstlane(tid >> 6), fr = lane & 15, fq = lane >> 4;
    const float* xin = F.in[0]; bf16_t* XB = (bf16_t*)(F.ws + WS_XB); bf16_t* XBO = DRY ? (bf16_t*)(F.ws + WS_ARENA + 944 * MiB) : XB;
    const float* gam = F.in[1] + (size_t)(layer * 2) * D; const float* bet = F.in[2] + (size_t)(layer * 2) * D;
    const bf16_t* MB = (const bf16_t*)(F.ws + WS_MBUF);
    LAS unsigned char* XH = F.lds + RING_OFF; LAS unsigned char* XL = F.lds + RING_OFF + 65536;
    LAS float* PART = (LAS float*)(F.lds + RING_OFF);
    LAS float* LG = (LAS float*)(F.lds + RING_OFF + 131072);
    LAS int* hist = (LAS int*)(F.lds + MISC_OFF + 256); LAS int* hbase = hist + 16; LAS int* sE = hist + 32; LAS int* sI = sE + 128; LAS float* sW = (LAS float*)(sI + 128);
    if (tid < 16) hist[tid] = 0;
    LAS f32x4* GL = (LAS f32x4*)(F.lds + RING_OFF + 135168); LAS f32x4* BL = GL + 512;
    GL[tid] = ((const GAS f32x4*)gam)[tid]; BL[tid] = ((const GAS f32x4*)bet)[tid];
    __syncthreads();
    const bf16_t* WH = (const bf16_t*)(F.ws + WS_WRT) + (size_t)layer * 32 * 2048; const bf16_t* WL = WH + 4 * 32 * 2048;
    const int rbase = blockIdx.x * 64;
    const int nb_ = tid & 31; const float lbias = nb_ < 4 ? F.in[22][layer * 4 + nb_] : nb_ < 20 ? F.in[24][layer * 16 + nb_ - 4] : 0.f;
    v2u xh[2][8], mh[2][8];
#define LN1_LOAD(bt_) do { _Pragma("unroll") for (int rr_ = 0; rr_ < 2; ++rr_) { const int row_ = rbase + (bt_) * 16 + 2 * wave + rr_; \
        const GAS v2u* xb_ = (const GAS v2u*)(XB + (size_t)row_ * D) + lane; const GAS v2u* mr_ = (const GAS v2u*)(MB + (size_t)row_ * D) + lane; \
        _Pragma("unroll") for (int j_ = 0; j_ < 8; ++j_) { xh[rr_][j_] = xb_[64 * j_]; mh[rr_][j_] = __builtin_nontemporal_load(mr_ + 64 * j_); } } } while (0)
#define LN1_BAR() do { asm volatile("s_waitcnt lgkmcnt(0)" ::: "memory"); __builtin_amdgcn_s_barrier(); asm volatile("" ::: "memory"); } while (0)
    LN1_LOAD(0);
#pragma unroll 1
    for (int bt = 0; bt < 4; ++bt) {
        f32x4 v[2][8];
#pragma unroll
        for (int rr = 0; rr < 2; ++rr) { const int row = rbase + bt * 16 + 2 * wave + rr;
            {
#pragma unroll
                for (int j = 0; j < 8; ++j) { const v2u xw = xh[rr][j]; const v2u mw = mh[rr][j];
                    v[rr][j].x = ALPHA * bflo(xw.x) + bflo(mw.x); v[rr][j].y = ALPHA * bfhi(xw.x) + bfhi(mw.x); v[rr][j].z = ALPHA * bflo(xw.y) + bflo(mw.y); v[rr][j].w = ALPHA * bfhi(xw.y) + bfhi(mw.y); }
            } (void)row; }
#pragma unroll
        for (int rr = 0; rr < 2; ++rr) { const int lr = 2 * wave + rr, row = rbase + bt * 16 + lr; float s = 0.f;
#pragma unroll
            for (int j = 0; j < 8; ++j) s += (v[rr][j].x + v[rr][j].y) + (v[rr][j].z + v[rr][j].w);
            const float mean = wave_sum_dpp(s) * (1.f / D); float s2 = 0.f;
#pragma unroll
            for (int j = 0; j < 8; ++j) { v[rr][j] = v[rr][j] - mean; s2 += (v[rr][j].x * v[rr][j].x + v[rr][j].y * v[rr][j].y) + (v[rr][j].z * v[rr][j].z + v[rr][j].w * v[rr][j].w); }
            const float rstd = 1.f / sqrtf(wave_sum_dpp(s2) * (1.f / D) + LN_EPS);
            GAS v2u* bo = (GAS v2u*)(XBO + (size_t)row * D) + lane;
#pragma unroll
            for (int j = 0; j < 8; ++j) { const f32x4 gj = GL[lane + 64 * j], bj = BL[lane + 64 * j]; const f32x4 y = v[rr][j] * rstd * gj + bj;
                const unsigned h0 = f2bf(y.x), h1 = f2bf(y.y), h2 = f2bf(y.z), h3 = f2bf(y.w); v2u hw; hw.x = h0 | (h1 << 16); hw.y = h2 | (h3 << 16); bo[64 * j] = hw;
                ((GAS int*)(F.ws + WS_XB8 + (size_t)row * D))[lane + 64 * j] = pk_fp8x4(y, 4.0f);
                v2u lw; lw.x = pk2(y.x - __uint_as_float(h0 << 16), y.y - __uint_as_float(h1 << 16)); lw.y = pk2(y.z - __uint_as_float(h2 << 16), y.w - __uint_as_float(h3 << 16));
                const int cidx = (lane >> 1) + 32 * j; const int off = lr * 4096 + ((cidx ^ lr) << 4) + (lane & 1) * 8;
                *(LAS v2u*)(XH + off) = hw; *(LAS v2u*)(XL + off) = lw; } }
        LN1_BAR();
        f32x4 acc[2] = {(f32x4){0.f, 0.f, 0.f, 0.f}, (f32x4){0.f, 0.f, 0.f, 0.f}};
        int wofs = fr * 2048 + 256 * wave + 8 * fq; asm volatile("" : "+v"(wofs));
#pragma unroll
        for (int ks = 0; ks < 8; ++ks) { const int k0 = 256 * wave + 32 * ks + 8 * fq; const int off = fr * 4096 + ((((k0 >> 3)) ^ fr) << 4);
            const bf16x8 xh = *(const LAS bf16x8*)(XH + off), xl = *(const LAS bf16x8*)(XL + off);
#pragma unroll
            for (int nt = 0; nt < 2; ++nt) { const bf16x8 wh = *(const GAS bf16x8*)(WH + wofs + nt * 16 * 2048 + 32 * ks), wl = *(const GAS bf16x8*)(WL + wofs + nt * 16 * 2048 + 32 * ks);
                acc[nt] = __builtin_amdgcn_mfma_f32_16x16x32_bf16(wh, xh, acc[nt], 0, 0, 0);
                acc[nt] = __builtin_amdgcn_mfma_f32_16x16x32_bf16(wl, xh, acc[nt], 0, 0, 0);
                acc[nt] = __builtin_amdgcn_mfma_f32_16x16x32_bf16(wh, xl, acc[nt], 0, 0, 0); } }
        if (bt < 3) LN1_LOAD(bt + 1);
        LN1_BAR();
        *(LAS f32x4*)(PART + (wave * 16 + fr) * 32 + 4 * fq) = acc[0]; *(LAS f32x4*)(PART + (wave * 16 + fr) * 32 + 16 + 4 * fq) = acc[1];
        LN1_BAR();
        {
            const int r = tid >> 5, n = tid & 31; float a = 0.f;
#pragma unroll
            for (int w = 0; w < 8; ++w) a += PART[(w * 16 + r) * 32 + n];
            a += lbias;
            LG[r * 32 + n] = a; }
        LN1_BAR();
        if (tid < 16) {
            float lg[20];
#pragma unroll
            for (int n = 0; n < 20; ++n) lg[n] = LG[tid * 32 + n];
            int gi = 0; float lm = lg[0];
#pragma unroll
            for (int k = 1; k < 4; ++k) if (lg[k] > lm) { lm = lg[k]; gi = k; }
            float den = 0.f;
#pragma unroll
            for (int k = 0; k < 4; ++k) den += __expf(lg[k] - lm);
            const float pg = 1.0f / den; float l2[4];
#pragma unroll
            for (int e = 0; e < 4; ++e) l2[e] = gi == 0 ? lg[4 + e] : gi == 1 ? lg[8 + e] : gi == 2 ? lg[12 + e] : lg[16 + e];
            int e1 = 0; float v1 = l2[0];
#pragma unroll
            for (int e = 1; e < 4; ++e) if (l2[e] > v1) { v1 = l2[e]; e1 = e; }
            int e2 = -1; float v2 = 0.f;
#pragma unroll
            for (int e = 0; e < 4; ++e) if (e != e1 && (e2 < 0 || l2[e] > v2)) { v2 = l2[e]; e2 = e; }
            const float t = __expf(v2 - v1); const float p1 = 1.0f / (1.0f + t), p2 = t / (1.0f + t);
            const int E1 = gi * 4 + e1, E2 = gi * 4 + e2, it = bt * 16 + tid;
            const int i1 = __hip_atomic_fetch_add(&hist[E1], 1, __ATOMIC_RELAXED, __HIP_MEMORY_SCOPE_WORKGROUP); const int i2 = __hip_atomic_fetch_add(&hist[E2], 1, __ATOMIC_RELAXED, __HIP_MEMORY_SCOPE_WORKGROUP);
            sE[2 * it] = E1; sI[2 * it] = i1; sW[2 * it] = pg * p1; sE[2 * it + 1] = E2; sI[2 * it + 1] = i2; sW[2 * it + 1] = pg * p2;
        }
        LN1_BAR();
    }
    if (DRY) { __syncthreads(); return; }
    if (tid < 16) hbase[tid] = (int)__hip_atomic_fetch_add((unsigned*)(F.ctl + CW_CNT + layer * 16 + tid), (unsigned)hist[tid], RLX_AGENT);
    __syncthreads();
    int* TS = (int*)(F.ws + WS_TOKSLOT);
    if (tid < 128) { const int sl = tid; const int row = rbase + (sl >> 1); const int E = sE[sl];
        const int idx = hbase[E] + sI[sl];
        GAS v4u* dst = (GAS v4u*)(TS + (size_t)(row * 2 + (sl & 1)) * 4); v4u w; w.x = (unsigned)E; w.y = (unsigned)idx; w.z = __float_as_uint(sW[sl]); w.w = 0u; *dst = w;
        ((int*)(F.ws + WS_EXPTOK))[(size_t)E * T + idx] = row; ((float*)(F.ws + WS_EXPW))[(size_t)E * T + idx] = sW[sl]; }
    __syncthreads();
}
template <bool DRY = false> __device__ __forceinline__ void ln2_phase(Ctx& F, int layer) {
    const int tid = fresh_tid(F.wave); const int lane = tid & 63, wave = F.wave;
    const bool last = layer == DEPTH - 1; float* xout = DRY ? (float*)(F.ws + WS_ARENA + 1010 * MiB) : F.out; bf16_t* XB = (bf16_t*)(F.ws + WS_XB); bf16_t* XBO = DRY ? (bf16_t*)(F.ws + WS_ARENA + 944 * MiB) : XB;
    const float* gam = F.in[1] + (size_t)(layer * 2 + 1) * D; const float* bet = F.in[2] + (size_t)(layer * 2 + 1) * D;
    const bf16_t* YG = (const bf16_t*)(F.ws + WS_YG); const int* TOKPOS = (const int*)(F.ws + WS_TOKPOS);
    const int rbase = blockIdx.x * 64;
    LAS int* tabL = (LAS int*)(F.lds + RING_OFF); LAS f32x4* GL = (LAS f32x4*)(F.lds + RING_OFF + 256); LAS f32x4* BL = GL + 512;
    GL[tid] = ((const GAS f32x4*)gam)[tid]; BL[tid] = ((const GAS f32x4*)bet)[tid];
    if (tid == 0) { int acc = 0; for (int e = 0; e < 16; ++e) { const unsigned c = __hip_atomic_load((unsigned*)(F.ctl + CW_CNT + layer * 16 + e), RLX_AGENT); tabL[e] = acc; acc += (int)((c + 255u) >> 8); } }
    __syncthreads();
    int pos = 0; if (lane < 16) { const int* ts = (const int*)(F.ws + WS_TOKSLOT) + (size_t)((rbase + (lane >> 1) * 8 + wave) * 2 + (lane & 1)) * 4; pos = tabL[ts[0]] * 256 + ts[1]; }
#define LN2_LOAD(it_, XR, YA, YB) do { const int row_ = rbase + (it_) * 8 + wave; \
        const int p0_ = __builtin_amdgcn_readfirstlane(__builtin_amdgcn_ds_bpermute((2 * (it_)) << 2, pos)), p1_ = __builtin_amdgcn_readfirstlane(__builtin_amdgcn_ds_bpermute((2 * (it_) + 1) << 2, pos)); \
        const GAS v2u* xr_ = (const GAS v2u*)(XB + (size_t)row_ * D) + lane; const GAS v2u* y0_ = (const GAS v2u*)(YG + (size_t)p0_ * D) + lane; const GAS v2u* y1_ = (const GAS v2u*)(YG + (size_t)p1_ * D) + lane; \
        _Pragma("unroll") for (int j_ = 0; j_ < 8; ++j_) { XR[j_] = xr_[64 * j_]; YA[j_] = __builtin_nontemporal_load(y0_ + 64 * j_); YB[j_] = __builtin_nontemporal_load(y1_ + 64 * j_); } } while (0)
    v2u xa[8], ya[8], yb[8];
    LN2_LOAD(0, xa, ya, yb);
#pragma unroll 1
    for (int it = 0; it < 8; ++it) {
        v2u xn[8], yna[8], ynb[8];
        if (it < 7) LN2_LOAD(it + 1, xn, yna, ynb);
        const int row = rbase + it * 8 + wave; f32x4 v[8]; float s = 0.f;
#pragma unroll
        for (int j = 0; j < 8; ++j) { const v2u xw = xa[j]; const v2u a = ya[j], b = yb[j];
            v[j].x = ALPHA * bflo(xw.x) + (bflo(a.x) + bflo(b.x)); v[j].y = ALPHA * bfhi(xw.x) + (bfhi(a.x) + bfhi(b.x)); v[j].z = ALPHA * bflo(xw.y) + (bflo(a.y) + bflo(b.y)); v[j].w = ALPHA * bfhi(xw.y) + (bfhi(a.y) + bfhi(b.y));
            s += (v[j].x + v[j].y) + (v[j].z + v[j].w); }
        const float mean = wave_sum_dpp(s) * (1.f / D); float s2 = 0.f;
#pragma unroll
        for (int j = 0; j < 8; ++j) { v[j] = v[j] - mean; s2 += (v[j].x * v[j].x + v[j].y * v[j].y) + (v[j].z * v[j].z + v[j].w * v[j].w); }
        const float rstd = 1.f / sqrtf(wave_sum_dpp(s2) * (1.f / D) + LN_EPS);
        GAS f32x4* xo = (GAS f32x4*)(xout + (size_t)row * D) + lane; GAS v2u* bo = (GAS v2u*)(XBO + (size_t)row * D) + lane;
#pragma unroll
        for (int j = 0; j < 8; ++j) { const f32x4 gj = GL[lane + 64 * j], bj = BL[lane + 64 * j]; const f32x4 y = v[j] * rstd * gj + bj;
            if (last) xo[64 * j] = y; else { v2u w; w.x = pk2(y.x, y.y); w.y = pk2(y.z, y.w); bo[64 * j] = w; if (F8_HY_IN && (layer & 1)) ((GAS int*)(F.ws + WS_XIN8 + (size_t)row * D))[lane + 64 * j] = pk_fp8x4(y, 4.0f); } }
#pragma unroll
        for (int j = 0; j < 8; ++j) { xa[j] = xn[j]; ya[j] = yna[j]; yb[j] = ynb[j]; }
    }
#undef LN2_LOAD
}
__device__ __forceinline__ void moe_tables(Ctx& F, int layer, int (&tab)[17]) {
    int acc = 0;
#pragma unroll
    for (int e = 0; e < 16; ++e) { const unsigned c = __hip_atomic_load((unsigned*)(F.ctl + CW_CNT + layer * 16 + e), RLX_AGENT); tab[e] = __builtin_amdgcn_readfirstlane(acc); acc += (int)((c + 255u) >> 8); }
    tab[16] = __builtin_amdgcn_readfirstlane(acc);
}
typedef float f32x4_t __attribute__((ext_vector_type(4)));
__device__ __forceinline__ float gelu_tanh_fast(float x) { const float u = 1.5957691216057308f * (x + 0.044715f * x * x * x); return x * __builtin_amdgcn_rcpf(1.0f + __expf(-u)); }
__device__ __forceinline__ void lru_local_item(Ctx& F, int jl, int item, int& hd_lds) {
    const int tid = fresh_tid(F.wave);
    const int lane = tid & 63, wave = __builtin_amdgcn_readfirstlane(tid >> 6);
    const int hd = item & 7, c = (item >> 3) & 63, b = item >> 9; const int r0 = b * SEQ + c * 64;
    const bf16_t* PROJ = (const bf16_t*)(F.ws + WS_PROJ);
    LAS float* XCF = (LAS float*)(F.lds + RING_OFF); LAS float* AF = (LAS float*)(F.lds + RING_OFF + 32768);
    LAS unsigned char* XCB = F.lds + RING_OFF + 65536;
    LAS float* QS = (LAS float*)(F.lds + RING_OFF + 65536 + 17408);
    LAS unsigned char* WL = F.lds + RING_OFF + 87040;
    LAS float* PT = (LAS float*)(F.lds + RING_OFF + 87040 + 65536);
    if (hd != hd_lds) { const bf16_t* W = (const bf16_t*)(F.ws + WS_WRI) + (size_t)(jl * 8 + hd) * 256 * 128; const int row = tid >> 1, hf = tid & 1;
        const GAS v4u* src = (const GAS v4u*)(W + (size_t)row * 128 + hf * 64);
#pragma unroll
        for (int i = 0; i < 8; ++i) *(LAS v4u*)(WL + row * 256 + (((hf * 8 + i) ^ (row & 15)) << 4)) = src[i];
        for (int i = tid; i < 8 * 128; i += NTHR) { const int k = i >> 7, jj = i & 127, ch = hd * 128 + jj;
            PT[i] = k < 4 ? F.in[4][(size_t)jl * 4 * 1024 + k * 1024 + ch] : k == 4 ? F.in[5][(size_t)jl * 1024 + ch] : k == 5 ? F.in[7][(size_t)jl * 1024 + ch] : k == 6 ? F.in[9][(size_t)jl * 1024 + ch] : ((const float*)(F.ws + WS_TOKPOS))[(size_t)jl * 1024 + ch]; }
        hd_lds = hd; __syncthreads(); }
    { const int tok = tid >> 3, cg = (tid & 7) * 16, ch0 = hd * 128 + cg; const int s = c * 64 + tok;
      float acc[16];
#pragma unroll
      for (int i = 0; i < 4; ++i) { const f32x4_t v = *(const LAS f32x4_t*)(PT + 4 * 128 + cg + 4 * i); acc[4 * i] = v.x; acc[4 * i + 1] = v.y; acc[4 * i + 2] = v.z; acc[4 * i + 3] = v.w; }
      v4u xq0[4], xq1[4];
#pragma unroll
      for (int k = 0; k < 4; ++k) { const bool ok = s - 3 + k >= 0; const GAS v4u* xr = (const GAS v4u*)(PROJ + (size_t)(r0 + tok - 3 + (ok ? k : 3)) * HY_NP + ch0); xq0[k] = xr[0]; xq1[k] = xr[1]; }
#pragma unroll
      for (int k = 0; k < 4; ++k) { const unsigned m = (s - 3 + k >= 0) ? 0xffffffffu : 0u; const v4u x0 = xq0[k], x1 = xq1[k];
              const unsigned xw[8] = {x0.x & m, x0.y & m, x0.z & m, x0.w & m, x1.x & m, x1.y & m, x1.z & m, x1.w & m};
#pragma unroll
              for (int i = 0; i < 4; ++i) { const f32x4_t w = *(const LAS f32x4_t*)(PT + k * 128 + cg + 4 * i);
                  acc[4 * i] += bflo(xw[2 * i]) * w.x; acc[4 * i + 1] += bfhi(xw[2 * i]) * w.y; acc[4 * i + 2] += bflo(xw[2 * i + 1]) * w.z; acc[4 * i + 3] += bfhi(xw[2 * i + 1]) * w.w; } }
#pragma unroll
      for (int i = 0; i < 4; ++i) *(LAS f32x4_t*)(XCF + tok * 128 + cg + 4 * i) = (f32x4_t){acc[4 * i], acc[4 * i + 1], acc[4 * i + 2], acc[4 * i + 3]};
      v4u o0, o1; o0.x = pk2(acc[0], acc[1]); o0.y = pk2(acc[2], acc[3]); o0.z = pk2(acc[4], acc[5]); o0.w = pk2(acc[6], acc[7]);
      o1.x = pk2(acc[8], acc[9]); o1.y = pk2(acc[10], acc[11]); o1.z = pk2(acc[12], acc[13]); o1.w = pk2(acc[14], acc[15]);
      *(LAS v4u*)(XCB + tok * 272 + cg * 2) = o0; *(LAS v4u*)(XCB + tok * 272 + cg * 2 + 16) = o1; }
    asm volatile("s_waitcnt lgkmcnt(0)" ::: "memory"); __builtin_amdgcn_s_barrier(); asm volatile("" ::: "memory");
    { const int rt = wave & 3, chalf = wave >> 2, fr = lane & 15, fq = lane >> 4;
      f32x4_t ar[4], ai[4];
#pragma unroll
      for (int nt = 0; nt < 4; ++nt) { ar[nt] = (f32x4_t){0.f, 0.f, 0.f, 0.f}; ai[nt] = (f32x4_t){0.f, 0.f, 0.f, 0.f}; }
#pragma unroll
      for (int ks = 0; ks < 4; ++ks) {
          bf16x8 xa = *(const LAS bf16x8*)(XCB + (16 * rt + fr) * 272 + (32 * ks + 8 * fq) * 2), wr[4], wi[4];
#pragma unroll
          for (int nt = 0; nt < 4; ++nt) {
              wr[nt] = *(const LAS bf16x8*)(WL + (64 * chalf + 16 * nt + fr) * 256 + (((4 * ks + fq) ^ fr) << 4));
              wi[nt] = *(const LAS bf16x8*)(WL + (128 + 64 * chalf + 16 * nt + fr) * 256 + (((4 * ks + fq) ^ fr) << 4)); }
          asm volatile("s_waitcnt lgkmcnt(0)" : "+v"(xa), "+v"(wr[0]), "+v"(wr[1]), "+v"(wr[2]), "+v"(wr[3]), "+v"(wi[0]), "+v"(wi[1]), "+v"(wi[2]), "+v"(wi[3]));
#pragma unroll
          for (int nt = 0; nt < 4; ++nt) { ar[nt] = __builtin_amdgcn_mfma_f32_16x16x32_bf16(wr[nt], xa, ar[nt], 0, 0, 0); ai[nt] = __builtin_amdgcn_mfma_f32_16x16x32_bf16(wi[nt], xa, ai[nt], 0, 0, 0); } }
      const int tok = 16 * rt + fr;
#pragma unroll
      for (int nt = 0; nt < 4; ++nt) { const int cl = 64 * chalf + 16 * nt + 4 * fq, chg = hd * 128 + cl;
          const f32x4_t br = *(const LAS f32x4_t*)(PT + 5 * 128 + cl), bi = *(const LAS f32x4_t*)(PT + 6 * 128 + cl), lm = *(const LAS f32x4_t*)(PT + 7 * 128 + cl);
          const f32x4_t xc = *(LAS f32x4_t*)(XCF + tok * 128 + cl); f32x4_t av, uv;
#pragma unroll
          for (int e = 0; e < 4; ++e) { const float r = sigmoid_(ar[nt][e] + br[e]), ig = sigmoid_(ai[nt][e] + bi[e]);
              const float la = r * lm[e]; const float a = __expf(la); const float x2 = 2.0f * la;
              const float om = x2 > -0.1f ? -x2 * (1.0f + x2 * (0.5f + x2 * (0.16666667f + x2 * 0.041666667f))) : 1.0f - a * a;
              av[e] = a; uv[e] = sqrtf(om) * (ig * xc[e]); }
          *(LAS f32x4_t*)(AF + tok * 128 + cl) = av; *(LAS f32x4_t*)(XCF + tok * 128 + cl) = uv; } }
    asm volatile("s_waitcnt lgkmcnt(0)" ::: "memory"); __builtin_amdgcn_s_barrier(); asm volatile("" ::: "memory");
    { const int ch = tid & 127, q = tid >> 7; float hl[16], pl[16]; float h = 0.f, p = 1.f;
#pragma unroll
      for (int i = 0; i < 16; ++i) { const float a = AF[(16 * q + i) * 128 + ch], u = XCF[(16 * q + i) * 128 + ch]; h = a * h + u; p *= a; hl[i] = h; pl[i] = p; }
      QS[(q * 128 + ch) * 2] = p; QS[(q * 128 + ch) * 2 + 1] = h;
      asm volatile("s_waitcnt lgkmcnt(0)" ::: "memory"); __builtin_amdgcn_s_barrier(); asm volatile("" ::: "memory");
      float carry = 0.f, cump = 1.f;
      for (int q2 = 0; q2 < q; ++q2) { const float pq = QS[(q2 * 128 + ch) * 2], hq = QS[(q2 * 128 + ch) * 2 + 1]; carry = pq * carry + hq; cump *= pq; }
      bf16_t* HL = (bf16_t*)(F.ws + WS_HLOC) + (size_t)(r0 + 16 * q) * 1024 + hd * 128 + ch; bf16_t* CA = (bf16_t*)(F.ws + WS_CUMA) + (size_t)(r0 + 16 * q) * 1024 + hd * 128 + ch;
#pragma unroll
      for (int i = 0; i < 16; ++i) { hl[i] += pl[i] * carry; pl[i] *= cump; HL[(size_t)i * 1024] = (bf16_t)f2bf(hl[i]); CA[(size_t)i * 1024] = (bf16_t)f2bf(pl[i]); }
      if (q == 3) { float* LS = (float*)(F.ws + WS_LSUM) + ((size_t)(b * 64 + c) * 1024 + hd * 128 + ch) * 2; LS[0] = pl[15]; LS[1] = hl[15]; } }
    asm volatile("s_waitcnt lgkmcnt(0)" ::: "memory"); __builtin_amdgcn_s_barrier(); asm volatile("" ::: "memory");
}
__device__ __forceinline__ void lru_fix_item(Ctx& F, int item) {
    const int tid = fresh_tid(F.wave);
    const int c = item & 63, b = item >> 6; const int ch = 2 * tid;
    const float* LS = (const float*)(F.ws + WS_LSUM) + ((size_t)(b * 64) * 1024 + ch) * 2;
    float c0 = 0.f, c1 = 0.f;
    { int c2 = 0;
      for (; c2 + 8 <= c; c2 += 8) { f32x4_t v[8];
#pragma unroll
          for (int i = 0; i < 8; ++i) v[i] = *(const GAS f32x4_t*)(LS + (size_t)(c2 + i) * 2048);
#pragma unroll
          for (int i = 0; i < 8; ++i) { c0 = v[i].x * c0 + v[i].y; c1 = v[i].z * c1 + v[i].w; } }
      for (; c2 < c; ++c2) { const f32x4_t v = *(const GAS f32x4_t*)(LS + (size_t)c2 * 2048); c0 = v.x * c0 + v.y; c1 = v.z * c1 + v.w; } }
    const int r0 = b * SEQ + c * 64;
    const bf16_t* HL = (const bf16_t*)(F.ws + WS_HLOC) + (size_t)r0 * 1024 + ch; const bf16_t* CA = (const bf16_t*)(F.ws + WS_CUMA) + (size_t)r0 * 1024 + ch;
    const bf16_t* G = (const bf16_t*)(F.ws + WS_PROJ) + (size_t)r0 * HY_NP + 1024 + ch; bf16_t* Y = (bf16_t*)(F.ws + WS_YMIX) + (size_t)r0 * 2048 + ch;
#pragma unroll 1
    for (int i0 = 0; i0 < 64; i0 += 8) {
        unsigned hv[8], cv[8], gw[8];
#pragma unroll
        for (int k = 0; k < 8; ++k) { hv[k] = __builtin_nontemporal_load((const GAS unsigned*)(HL + (size_t)(i0 + k) * 1024)); cv[k] = __builtin_nontemporal_load((const GAS unsigned*)(CA + (size_t)(i0 + k) * 1024)); gw[k] = *(const GAS unsigned*)(G + (size_t)(i0 + k) * HY_NP); }
#pragma unroll
        for (int k = 0; k < 8; ++k) { const float h0 = bflo(hv[k]) + bflo(cv[k]) * c0, h1 = bfhi(hv[k]) + bfhi(cv[k]) * c1;
            const float o0 = h0 * gelu_tanh_fast(bflo(gw[k])), o1 = h1 * gelu_tanh_fast(bfhi(gw[k]));
            if (F8_HY_OUT) *(GAS unsigned short*)(F.ws + WS_YMIX8 + (size_t)(r0 + i0 + k) * 2048 + ch) = (unsigned short)__builtin_amdgcn_cvt_pk_fp8_f32(__builtin_amdgcn_fmed3f(4.0f * o0, -448.f, 448.f), __builtin_amdgcn_fmed3f(4.0f * o1, -448.f, 448.f), 0, false);
            else *(GAS unsigned*)(Y + (size_t)(i0 + k) * 2048) = pk2(o0, o1); } }
}
constexpr int SSD_LP = 136;
template <int NT> __device__ __forceinline__ void ssd_conv_load(const bf16_t* P, int row0, int s0, unsigned (&xw)[NT + 3][8]) {
#pragma unroll
    for (int r = 0; r < NT + 3; ++r) { const bool ok = s0 - 3 + r >= 0;
        const GAS v4u* xr = (const GAS v4u*)(P + (size_t)(ok ? row0 - 3 + r : row0) * SS_NP); const v4u a = xr[0], b = xr[1]; const unsigned m = ok ? 0xffffffffu : 0u;
        xw[r][0] = a.x & m; xw[r][1] = a.y & m; xw[r][2] = a.z & m; xw[r][3] = a.w & m; xw[r][4] = b.x & m; xw[r][5] = b.y & m; xw[r][6] = b.z & m; xw[r][7] = b.w & m; }
}
template <int NT, int WS = 768> __device__ __forceinline__ void ssd_conv_math(const unsigned (&xw)[NT + 3][8], const LAS float* wl, float (&o)[NT][16]) {
#pragma unroll
    for (int i4 = 0; i4 < 4; ++i4) { const f32x4_t bv = *(const LAS f32x4_t*)(wl + 4 * WS + 4 * i4);
        f32x4_t w[4];
#pragma unroll
        for (int k = 0; k < 4; ++k) w[k] = *(const LAS f32x4_t*)(wl + k * WS + 4 * i4);
#pragma unroll
        for (int t = 0; t < NT; ++t) { float a0 = bv.x, a1 = bv.y, a2 = bv.z, a3 = bv.w;
#pragma unroll
            for (int k = 0; k < 4; ++k) { a0 += bflo(xw[t + k][2 * i4]) * w[k].x; a1 += bfhi(xw[t + k][2 * i4]) * w[k].y; a2 += bflo(xw[t + k][2 * i4 + 1]) * w[k].z; a3 += bfhi(xw[t + k][2 * i4 + 1]) * w[k].w; }
            o[t][4 * i4] = silu_fast2(a0); o[t][4 * i4 + 1] = silu_fast2(a1); o[t][4 * i4 + 2] = silu_fast2(a2); o[t][4 * i4 + 3] = silu_fast2(a3); } }
}
template <int NT, int WS = 768> __device__ __forceinline__ void ssd_conv_tok(const bf16_t* P, int row0, int s0, const LAS float* wl, float (&o)[NT][16]) {
    unsigned xw[NT + 3][8]; ssd_conv_load<NT>(P, row0, s0, xw); ssd_conv_math<NT, WS>(xw, wl, o);
}
__device__ __forceinline__ void ssd_load_convw(Ctx& F, int jl, int g, LAS float* WL, int tid) {
    const float* cw = F.in[14] + (size_t)jl * 4 * SSD_CONV; const float* cb = F.in[15] + (size_t)jl * SSD_CONV;
    for (int i = tid; i < 5 * 768; i += NTHR) { const int k = i / 768, jj = i - k * 768; const int ch = jj < 512 ? g * 512 + jj : jj < 640 ? 4096 + g * 128 + (jj - 512) : 5120 + g * 128 + (jj - 640);
        WL[i] = k < 4 ? cw[(size_t)k * SSD_CONV + ch] : cb[ch]; }
}
__device__ __forceinline__ void ssd_states_item(Ctx& F, int jl, int item, int& g_lds) {
    const int tid = fresh_tid(F.wave);
    const int lane = tid & 63, wave = __builtin_amdgcn_readfirstlane(tid >> 6), fr = lane & 15, fq = lane >> 4;
    const int g = item & 7, c = (item >> 3) & 31, b = item >> 8, bc = b * 32 + c, r0 = bc * 128, s0 = c * 128;
    const bf16_t* PROJ = (const bf16_t*)(F.ws + WS_PROJ);
    const float* cw = F.in[14] + (size_t)jl * 4 * SSD_CONV; const float* cb = F.in[15] + (size_t)jl * SSD_CONV;
    LAS unsigned char* BT = F.lds + RING_OFF; LAS unsigned char* XT0 = F.lds + RING_OFF + 34816; LAS float* DTL = (LAS float*)(F.lds + RING_OFF + 104448); LAS float* ACSL = DTL + 1024;
    LAS float* WL = (LAS float*)(F.lds + RING_OFF + 112640);
    if (g != g_lds) { ssd_load_convw(F, jl, g, WL, tid); g_lds = g; __syncthreads(); }
    {
        const int h = 8 * g + wave; const float A = -__expf(F.in[17][jl * 64 + h]), dtb = F.in[16][jl * 64 + h];
        const int l0 = 2 * lane;
        const float* DTR = (const float*)(F.ws + WS_DTB);
        const float d0 = softplus_(DTR[(size_t)(r0 + l0) * 64 + h] + dtb), d1 = softplus_(DTR[(size_t)(r0 + l0 + 1) * 64 + h] + dtb);
        float sc = (d0 + d1) * A;
#pragma unroll
        for (int o = 1; o < 64; o <<= 1) { const float u = shfl_up_l(sc, o, lane); if (lane >= o) sc += u; }
        const float a1 = sc, a0 = sc - d1 * A;
        DTL[l0 * 8 + wave] = d0; DTL[(l0 + 1) * 8 + wave] = d1; ACSL[l0 * 8 + wave] = a0; ACSL[(l0 + 1) * 8 + wave] = a1;
        float* DTB = (float*)(F.ws + WS_DTB); float* ACSB = (float*)(F.ws + WS_ACSB);
        DTB[(size_t)(r0 + l0) * 64 + h] = d0; DTB[(size_t)(r0 + l0 + 1) * 64 + h] = d1; ACSB[(size_t)(r0 + l0) * 64 + h] = a0; ACSB[(size_t)(r0 + l0 + 1) * 64 + h] = a1;
    }
    {
        const int lp = tid >> 3, cg = (tid & 7) * 16; float o[2][16];
        ssd_conv_tok<2>(PROJ + 8192 + g * 128 + cg, r0 + 2 * lp, s0 + 2 * lp, WL + 512 + cg, o);
#pragma unroll
        for (int i = 0; i < 16; ++i) *(LAS unsigned*)(BT + ((cg + i) * SSD_LP + 2 * lp) * 2) = pk2(o[0][i], o[1][i]);
#pragma unroll
        for (int t = 0; t < 2; ++t) { v4u w0, w1; w0.x = pk2(o[t][0], o[t][1]); w0.y = pk2(o[t][2], o[t][3]); w0.z = pk2(o[t][4], o[t][5]); w0.w = pk2(o[t][6], o[t][7]); w1.x = pk2(o[t][8], o[t][9]); w1.y = pk2(o[t][10], o[t][11]); w1.z = pk2(o[t][12], o[t][13]); w1.w = pk2(o[t][14], o[t][15]);
            GAS v4u* d = (GAS v4u*)((bf16_t*)(F.ws + WS_BS) + (size_t)(r0 + 2 * lp + t) * 1024 + g * 128 + cg); d[0] = w0; d[1] = w1; }
    }
    __syncthreads();
    unsigned xwc[5][8];
    { const int hh = tid >> 8, t2 = tid & 255, lp = t2 >> 2, pg = (t2 & 3) * 16; ssd_conv_load<2>(PROJ + 4096 + (8 * g + hh) * 64 + pg, r0 + 2 * lp, s0 + 2 * lp, xwc); }
#pragma unroll 1
    for (int hp = 0; hp < 4; ++hp) {
        LAS unsigned char* XT = XT0 + (hp & 1) * 34816;
        {
            int tq = tid; asm volatile("" : "+v"(tq));
            const int hh = tq >> 8, t2 = tq & 255, lp = t2 >> 2, pg = (t2 & 3) * 16, e = 2 * hp + hh, h = 8 * g + e; float o[2][16];
            ssd_conv_math<2>(xwc, WL + e * 64 + pg, o);
            if (hp < 3) ssd_conv_load<2>(PROJ + 4096 + (h + 2) * 64 + pg, r0 + 2 * lp, s0 + 2 * lp, xwc);
            const float al = ACSL[127 * 8 + e]; const float f0 = DTL[(2 * lp) * 8 + e] * __expf(al - ACSL[(2 * lp) * 8 + e]), f1 = DTL[(2 * lp + 1) * 8 + e] * __expf(al - ACSL[(2 * lp + 1) * 8 + e]);
#pragma unroll
            for (int i = 0; i < 16; ++i) *(LAS unsigned*)(XT + hh * 17408 + ((pg + i) * SSD_LP + 2 * lp) * 2) = pk2(o[0][i] * f0, o[1][i] * f1);
#pragma unroll
            for (int t = 0; t < 2; ++t) { v4u w0, w1; w0.x = pk2(o[t][0], o[t][1]); w0.y = pk2(o[t][2], o[t][3]); w0.z = pk2(o[t][4], o[t][5]); w0.w = pk2(o[t][6], o[t][7]); w1.x = pk2(o[t][8], o[t][9]); w1.y = pk2(o[t][10], o[t][11]); w1.z = pk2(o[t][12], o[t][13]); w1.w = pk2(o[t][14], o[t][15]);
                GAS v4u* d = (GAS v4u*)((bf16_t*)(F.ws + WS_XS) + (size_t)(r0 + 2 * lp + t) * 4096 + h * 64 + pg); d[0] = w0; d[1] = w1; }
        }
        asm volatile("s_waitcnt lgkmcnt(0)" ::: "memory"); __builtin_amdgcn_s_barrier(); asm volatile("" ::: "memory");
        {
            int lq = lane; asm volatile("" : "+v"(lq)); const int fr = lq & 15, fq = lq >> 4;
            const int hh = wave >> 2, pt = wave & 3, h = 8 * g + 2 * hp + hh;
            f32x4_t acc[8];
#pragma unroll
            for (int nt = 0; nt < 8; ++nt) acc[nt] = (f32x4_t){0.f, 0.f, 0.f, 0.f};
#pragma unroll
            for (int ks = 0; ks < 4; ++ks) { bf16x8 xa = *(const LAS bf16x8*)(XT + hh * 17408 + ((16 * pt + fr) * SSD_LP + 32 * ks + 8 * fq) * 2), bb[8];
#pragma unroll
                for (int nt = 0; nt < 8; ++nt) bb[nt] = *(const LAS bf16x8*)(BT + ((16 * nt + fr) * SSD_LP + 32 * ks + 8 * fq) * 2);
                asm volatile("s_waitcnt lgkmcnt(0)" : "+v"(xa), "+v"(bb[0]), "+v"(bb[1]), "+v"(bb[2]), "+v"(bb[3]), "+v"(bb[4]), "+v"(bb[5]), "+v"(bb[6]), "+v"(bb[7]));
#pragma unroll
                for (int nt = 0; nt < 8; ++nt) acc[nt] = __builtin_amdgcn_mfma_f32_16x16x32_bf16(bb[nt], xa, acc[nt], 0, 0, 0); }
            bf16_t* ST = (bf16_t*)(F.ws + WS_STATES) + (((size_t)bc * 64 + h) * 64 + 16 * pt + fr) * 128 + 4 * fq;
#pragma unroll
            for (int nt = 0; nt < 8; ++nt) { v2u w; w.x = pk2(acc[nt][0], acc[nt][1]); w.y = pk2(acc[nt][2], acc[nt][3]); *(GAS v2u*)(ST + 16 * nt) = w; }
        }
    }
    __syncthreads();
}
__device__ __forceinline__ void ssd_scan_item(Ctx& F, int item) {
    const int tid = fresh_tid(F.wave);
    const int b = item >> 6, h = item & 63;
    bf16_t* ST = (bf16_t*)(F.ws + WS_STATES) + ((size_t)(b * 32) * 64 + h) * 8192 + 16 * tid; const float* ACSB = (const float*)(F.ws + WS_ACSB) + (size_t)(b * 32) * 128 * 64 + 127 * 64 + h;
    float s[16];
#pragma unroll
    for (int i = 0; i < 16; ++i) s[i] = 0.f;
#pragma unroll 1
    for (int c0 = 0; c0 < 32; c0 += 8) {
        v4u la[8], lb[8]; float dec[8];
#pragma unroll
        for (int k = 0; k < 8; ++k) { const GAS v4u* p = (const GAS v4u*)(ST + (size_t)(c0 + k) * 64 * 8192); la[k] = __builtin_nontemporal_load(p); lb[k] = __builtin_nontemporal_load(p + 1); dec[k] = ACSB[(size_t)(c0 + k) * 128 * 64]; }
#pragma unroll
        for (int k = 0; k < 8; ++k) { GAS v4u* p = (GAS v4u*)(ST + (size_t)(c0 + k) * 64 * 8192); const float d = __expf(dec[k]);
            const unsigned w[8] = {la[k].x, la[k].y, la[k].z, la[k].w, lb[k].x, lb[k].y, lb[k].z, lb[k].w}; v4u o0, o1;
            o0.x = pk2(s[0], s[1]); o0.y = pk2(s[2], s[3]); o0.z = pk2(s[4], s[5]); o0.w = pk2(s[6], s[7]); o1.x = pk2(s[8], s[9]); o1.y = pk2(s[10], s[11]); o1.z = pk2(s[12], s[13]); o1.w = pk2(s[14], s[15]);
            p[0] = o0; p[1] = o1;
#pragma unroll
            for (int i = 0; i < 8; ++i) { s[2 * i] = s[2 * i] * d + bflo(w[i]); s[2 * i + 1] = s[2 * i + 1] * d + bfhi(w[i]); } }
    }
}
__device__ __forceinline__ void ssd_y_item(Ctx& F, int jl, int item, int& g_lds) {
    const int tid = fresh_tid(F.wave);
    const int lane = tid & 63, wave = F.wave, fr = lane & 15, fq = lane >> 4;
    const int g = item & 7, c = (item >> 3) & 31, b = item >> 8, bc = b * 32 + c, r0 = bc * 128, s0 = c * 128;
    const bf16_t* PROJ = (const bf16_t*)(F.ws + WS_PROJ);
    const float* cw = F.in[14] + (size_t)jl * 4 * SSD_CONV; const float* cb = F.in[15] + (size_t)jl * SSD_CONV;
    LAS unsigned char* CT = F.lds + RING_OFF; LAS unsigned char* BN = F.lds + RING_OFF + 34816; LAS unsigned char* MT = BN;
    LAS unsigned char* XT = F.lds + RING_OFF + 69632;
    LAS unsigned char* PV = F.lds + RING_OFF + 104448;
    LAS float* DTL = (LAS float*)(F.lds + RING_OFF + 139264); LAS float* ACSL = DTL + 1024; LAS float* WL = (LAS float*)(F.lds + RING_OFF + 147456); LAS float* NG = WL + 5 * 128;
    LAS float* DPL = NG + 512;
    if (g != g_lds) { const float* cwg = F.in[14] + (size_t)jl * 4 * SSD_CONV + 5120 + g * 128; const float* cbg = F.in[15] + (size_t)jl * SSD_CONV + 5120 + g * 128;
        for (int i = tid; i < 5 * 128; i += NTHR) { const int k = i >> 7, jj = i & 127; WL[i] = k < 4 ? cwg[(size_t)k * SSD_CONV + jj] : cbg[jj]; }
        NG[tid] = F.in[19][(size_t)jl * 4096 + g * 512 + tid];
        g_lds = g; }
    __syncthreads();
    {
        const float* DTB = (const float*)(F.ws + WS_DTB); const float* ACSB = (const float*)(F.ws + WS_ACSB);
#pragma unroll
        for (int i = 0; i < 2; ++i) { const int idx = tid + 512 * i, l = idx >> 3, e = idx & 7; DTL[e * 128 + l] = DTB[(size_t)(r0 + l) * 64 + 8 * g + e]; ACSL[e * 128 + l] = 1.4426950408889634f * ACSB[(size_t)(r0 + l) * 64 + 8 * g + e]; }
        if (tid < 8) DPL[tid] = F.in[18][jl * 64 + 8 * g + tid];
    }
    {
        const int l = tid >> 2, cg = (tid & 3) * 32;
#pragma unroll
        for (int hf = 0; hf < 2; ++hf) { float o[1][16];
            ssd_conv_tok<1, 128>(PROJ + 9216 + g * 128 + cg + 16 * hf, r0 + l, s0 + l, WL + cg + 16 * hf, o);
            v4u w0, w1; w0.x = pk2(o[0][0], o[0][1]); w0.y = pk2(o[0][2], o[0][3]); w0.z = pk2(o[0][4], o[0][5]); w0.w = pk2(o[0][6], o[0][7]); w1.x = pk2(o[0][8], o[0][9]); w1.y = pk2(o[0][10], o[0][11]); w1.z = pk2(o[0][12], o[0][13]); w1.w = pk2(o[0][14], o[0][15]);
            *(LAS v4u*)(CT + (l * SSD_LP + cg + 16 * hf) * 2) = w0; *(LAS v4u*)(CT + (l * SSD_LP + cg + 16 * hf) * 2 + 16) = w1;
            const GAS v4u* bs = (const GAS v4u*)((const bf16_t*)(F.ws + WS_BS) + (size_t)(r0 + l) * 1024 + g * 128 + cg + 16 * hf);
            *(LAS v4u*)(BN + (l * SSD_LP + cg + 16 * hf) * 2) = bs[0]; *(LAS v4u*)(BN + (l * SSD_LP + cg + 16 * hf) * 2 + 16) = bs[1]; }
    }
    const int lp = tid >> 3, pg = (tid & 7) * 8, l0 = 2 * lp; const int l = 16 * wave + fr, row = r0 + l;
    const bf16_t* xsrc = (const bf16_t*)(F.ws + WS_XS) + (size_t)(r0 + l0) * 4096 + (8 * g) * 64 + pg;
    const bf16_t* psrc = (const bf16_t*)(F.ws + WS_STATES) + (((size_t)bc * 64 + 8 * g) * 64 + (tid >> 3)) * 128 + (tid & 7) * 16;
    const bf16_t* zsrc = PROJ + (size_t)row * SS_NP + (8 * g) * 64 + 4 * fq;
    v4u xraw[2], pvr[2]; v2u zc[4];
#define SSD_PREFETCH(e_) do { xraw[0] = *(const GAS v4u*)(xsrc + (e_) * 64); xraw[1] = *(const GAS v4u*)(xsrc + 4096 + (e_) * 64); \
        pvr[0] = *(const GAS v4u*)(psrc + (size_t)(e_) * 8192); pvr[1] = *(const GAS v4u*)(psrc + (size_t)(e_) * 8192 + 8); } while (0)
#define SSD_PREFETCH_Z(e_) do { _Pragma("unroll") for (int pt_ = 0; pt_ < 4; ++pt_) zc[pt_] = *(const GAS v2u*)(zsrc + (e_) * 64 + 16 * pt_); } while (0)
    SSD_PREFETCH(0); SSD_PREFETCH_Z(0);
    __syncthreads();
    f32x4_t cbt[8];
#pragma unroll
    for (int st = 0; st < 8; ++st) cbt[st] = (f32x4_t){0.f, 0.f, 0.f, 0.f};
#pragma unroll
    for (int ks = 0; ks < 4; ++ks) { bf16x8 cf = *(const LAS bf16x8*)(CT + ((16 * wave + fr) * SSD_LP + 32 * ks + 8 * fq) * 2), bf[8];
#pragma unroll
        for (int st = 0; st < 8; ++st) bf[st] = *(const LAS bf16x8*)(BN + ((16 * st + fr) * SSD_LP + 32 * ks + 8 * fq) * 2);
        asm volatile("s_waitcnt lgkmcnt(0)" : "+v"(cf), "+v"(bf[0]), "+v"(bf[1]), "+v"(bf[2]), "+v"(bf[3]), "+v"(bf[4]), "+v"(bf[5]), "+v"(bf[6]), "+v"(bf[7]));
#pragma unroll
        for (int st = 0; st < 8; ++st) if (st <= wave) cbt[st] = __builtin_amdgcn_mfma_f32_16x16x32_bf16(bf[st], cf, cbt[st], 0, 0, 0); }
    __syncthreads();
    float ssq = 0.f; bf16_t* YN = (bf16_t*)(F.ws + WS_YN) + (size_t)row * 4096;
    v2u ykeep[8][4];
#pragma unroll
    for (int i = 0; i < 8; ++i)
#pragma unroll
        for (int pt = 0; pt < 4; ++pt) ykeep[i][pt] = (v2u){0u, 0u};
#pragma unroll 1
    for (int e = 0; e < 8; ++e) {
        const int h = 8 * g + e; LAS unsigned char* XTe = XT + (e & 1) * 17408; LAS unsigned char* PVe = PV + (e & 1) * 17408;
        float sz[16];
#pragma unroll
        for (int pt = 0; pt < 4; ++pt) { const v2u zw = zc[pt]; sz[4 * pt] = silu_fast2(bflo(zw.x)); sz[4 * pt + 1] = silu_fast2(bfhi(zw.x)); sz[4 * pt + 2] = silu_fast2(bflo(zw.y)); sz[4 * pt + 3] = silu_fast2(bfhi(zw.y)); }
        int wv = wave; asm volatile("" : "+s"(wv));
        {
            const float f0 = DTL[e * 128 + l0], f1 = DTL[e * 128 + l0 + 1];
            const unsigned xa[4] = {xraw[0].x, xraw[0].y, xraw[0].z, xraw[0].w}, xb[4] = {xraw[1].x, xraw[1].y, xraw[1].z, xraw[1].w};
#pragma unroll
            for (int i = 0; i < 4; ++i) { *(LAS unsigned*)(XTe + ((pg + 2 * i) * SSD_LP + l0) * 2) = pk2(bflo(xa[i]) * f0, bflo(xb[i]) * f1); *(LAS unsigned*)(XTe + ((pg + 2 * i + 1) * SSD_LP + l0) * 2) = pk2(bfhi(xa[i]) * f0, bfhi(xb[i]) * f1); }
            *(LAS v4u*)(PVe + ((tid >> 3) * SSD_LP + (tid & 7) * 16) * 2) = pvr[0]; *(LAS v4u*)(PVe + ((tid >> 3) * SSD_LP + (tid & 7) * 16) * 2 + 16) = pvr[1];
        }
        if (e < 7) { SSD_PREFETCH(e + 1); SSD_PREFETCH_Z(e + 1); }
        {
            const float al = ACSL[e * 128 + l]; const float dsk = DPL[e] * __builtin_amdgcn_rcpf(DTL[e * 128 + l]);
            f32x4_t asv[8];
#pragma unroll
            for (int st = 0; st < 8; ++st) asv[st] = *(const LAS f32x4_t*)(ACSL + e * 128 + 16 * st + 4 * fq);
            asm volatile("s_waitcnt lgkmcnt(0)" : "+v"(asv[0]), "+v"(asv[1]), "+v"(asv[2]), "+v"(asv[3]), "+v"(asv[4]), "+v"(asv[5]), "+v"(asv[6]), "+v"(asv[7]));
#pragma unroll
            for (int st = 0; st < 8; ++st) if (st <= (wv | 1)) { float m[4];
                const f32x4_t as4 = asv[st];
                if (st < wv) {
#pragma unroll
                    for (int i = 0; i < 4; ++i) m[i] = cbt[st][i] * __builtin_amdgcn_exp2f(al - as4[i]);
                } else {
#pragma unroll
                    for (int i = 0; i < 4; ++i) { const int s = 16 * st + 4 * fq + i; float v = s <= l ? cbt[st][i] * __builtin_amdgcn_exp2f(al - as4[i]) : 0.f; if (s == l) v += dsk; m[i] = v; } }
                v2u w; w.x = pk2(m[0], m[1]); w.y = pk2(m[2], m[3]); *(LAS v2u*)(MT + (l * SSD_LP + 16 * st + 4 * fq) * 2) = w; }
        }
        asm volatile("s_waitcnt lgkmcnt(0)" ::: "memory"); __builtin_amdgcn_s_barrier(); asm volatile("" ::: "memory");
        f32x4_t yd[4], yo[4];
#pragma unroll
        for (int pt = 0; pt < 4; ++pt) { yd[pt] = (f32x4_t){0.f, 0.f, 0.f, 0.f}; yo[pt] = (f32x4_t){0.f, 0.f, 0.f, 0.f}; }
        LAS unsigned char* pvl = PVe + (fr * SSD_LP + 8 * fq) * 2; LAS unsigned char* xtl = XTe + (fr * SSD_LP + 8 * fq) * 2; LAS unsigned char* ctl = CT + (l * SSD_LP + 8 * fq) * 2; LAS unsigned char* mtl = MT + (l * SSD_LP + 8 * fq) * 2;
        asm volatile("" : "+v"(pvl), "+v"(xtl), "+v"(ctl), "+v"(mtl));
#pragma unroll
        for (int ks = 0; ks < 4; ++ks) {
            const bool dk = 2 * ks <= wv;
            bf16x8 cf = *(const LAS bf16x8*)(ctl + 64 * ks), mf = *(const LAS bf16x8*)(mtl + 64 * ks), pf[4], xf[4];
#pragma unroll
            for (int pt = 0; pt < 4; ++pt) { pf[pt] = *(const LAS bf16x8*)(pvl + (16 * pt * SSD_LP + 32 * ks) * 2); xf[pt] = *(const LAS bf16x8*)(xtl + (16 * pt * SSD_LP + 32 * ks) * 2); }
            asm volatile("s_waitcnt lgkmcnt(0)" : "+v"(cf), "+v"(mf), "+v"(pf[0]), "+v"(pf[1]), "+v"(pf[2]), "+v"(pf[3]), "+v"(xf[0]), "+v"(xf[1]), "+v"(xf[2]), "+v"(xf[3]));
#pragma unroll
            for (int pt = 0; pt < 4; ++pt) yo[pt] = __builtin_amdgcn_mfma_f32_16x16x32_bf16(pf[pt], cf, yo[pt], 0, 0, 0);
            if (dk) {
#pragma unroll
                for (int pt = 0; pt < 4; ++pt) yd[pt] = __builtin_amdgcn_mfma_f32_16x16x32_bf16(xf[pt], mf, yd[pt], 0, 0, 0); }
        }
        {
            const float ea = __builtin_amdgcn_exp2f(ACSL[e * 128 + l]); v2u ynew[4];
#pragma unroll
            for (int pt = 0; pt < 4; ++pt) {
                const float y0 = (yd[pt][0] + ea * yo[pt][0]) * sz[4 * pt], y1 = (yd[pt][1] + ea * yo[pt][1]) * sz[4 * pt + 1];
                const float y2 = (yd[pt][2] + ea * yo[pt][2]) * sz[4 * pt + 2], y3 = (yd[pt][3] + ea * yo[pt][3]) * sz[4 * pt + 3];
                ssq += (y0 * y0 + y1 * y1) + (y2 * y2 + y3 * y3); v2u w; w.x = pk2(y0, y1); w.y = pk2(y2, y3); ynew[pt] = w; }
#pragma unroll
            for (int i = 0; i < 7; ++i)
#pragma unroll
                for (int pt = 0; pt < 4; ++pt) ykeep[i][pt] = ykeep[i + 1][pt];
#pragma unroll
            for (int pt = 0; pt < 4; ++pt) ykeep[7][pt] = ynew[pt];
        }

    }
#undef SSD_PREFETCH
#undef SSD_PREFETCH_Z
    ssq += shfl_xor_l(ssq, 16, lane); ssq += shfl_xor_l(ssq, 32, lane);
    const float rstd = 1.0f / sqrtf(ssq * (1.0f / 512.0f) + RMS_EPS);
    const float* ng = F.in[19] + (size_t)jl * 4096;
#pragma unroll
    for (int e = 0; e < 8; ++e)
#pragma unroll
        for (int pt = 0; pt < 4; ++pt) { const int ch = (8 * g + e) * 64 + 16 * pt + 4 * fq; const f32x4_t gv = *(const LAS f32x4_t*)(NG + e * 64 + 16 * pt + 4 * fq); const v2u yk = ykeep[e][pt];
            if (F8_SS_OUT) { const f32x4_t yv = {bflo(yk.x) * rstd * gv.x, bfhi(yk.x) * rstd * gv.y, bflo(yk.y) * rstd * gv.z, bfhi(yk.y) * rstd * gv.w}; *(GAS int*)(F.ws + WS_YN8 + (size_t)row * 4096 + ch) = pk_fp8x4(yv, 4.0f); }
            else { v2u w; w.x = pk2(bflo(yk.x) * rstd * gv.x, bfhi(yk.x) * rstd * gv.y); w.y = pk2(bflo(yk.y) * rstd * gv.z, bfhi(yk.y) * rstd * gv.w);
            *(GAS v2u*)(YN + ch) = w; } }
    __syncthreads();
}
template <int NT> __device__ __forceinline__ void skinny_proj(Ctx& F, const bf16_t* Wt, float* OUT, int NOUT) {
    const int tid = fresh_tid(F.wave); const int lane = tid & 63, fr = lane & 15, fq = lane >> 4, wave = F.wave;
    const bf16_t* XB = (const bf16_t*)(F.ws + WS_XB); LAS float* PART = (LAS float*)(F.lds + RING_OFF);
    const bf16_t* bp = Wt + (size_t)fr * D + 256 * wave + 8 * fq;
    bf16x8 wb[NT][8];
#pragma unroll
    for (int n = 0; n < NT; ++n)
#pragma unroll
        for (int ks = 0; ks < 8; ++ks) wb[n][ks] = *(const GAS bf16x8*)(bp + (size_t)n * 16 * D + 32 * ks);
    for (int rt = blockIdx.x; rt < T / 16; rt += F.G) {
        const bf16_t* ap = XB + (size_t)(rt * 16 + fr) * D + 256 * wave + 8 * fq;
        bf16x8 xa[8];
#pragma unroll
        for (int ks = 0; ks < 8; ++ks) xa[ks] = *(const GAS bf16x8*)(ap + 32 * ks);
#pragma unroll
        for (int n = 0; n < NT; ++n) {
            f32x4 acc = (f32x4){0.f, 0.f, 0.f, 0.f};
#pragma unroll
            for (int ks = 0; ks < 8; ++ks) acc = __builtin_amdgcn_mfma_f32_16x16x32_bf16(wb[n][ks], xa[ks], acc, 0, 0, 0);
            *(LAS f32x4*)(PART + (wave * 16 + fr) * (16 * NT) + 16 * n + 4 * fq) = acc; }
        __syncthreads();
        for (int o = tid; o < 16 * 16 * NT; o += NTHR) { const int r = o / (16 * NT), cidx = o - r * (16 * NT); float a = 0.f;
#pragma unroll
            for (int w = 0; w < 8; ++w) a += PART[(w * 16 + r) * (16 * NT) + cidx];
            if (cidx < NOUT) OUT[(size_t)(rt * 16 + r) * NOUT + cidx] = a; }
        __syncthreads();
    }
}
struct Params { const float* in[28]; float* out; unsigned char* ws; int layer_lo, layer_hi, st_lo, st_hi, bar_region, pad; };
constexpr int N_STEPS = 13;
#ifndef MK_ONE_LAUNCH
#define MK_ONE_LAUNCH 1
#endif
__host__ __device__ constexpr bool step_active(int layer, int k) {
    if (k == 5 || k == 6 || k == 9) return false;
    return (layer & 1) ? true : k != 4;
}
#define VB_LOOP(n) for (size_t vb = blockIdx.x; vb < (size_t)(n); vb += gridDim.x)
#ifndef PROBE_REP_MASK
#define PROBE_REP_MASK 0
#endif
#define REPS(k) _Pragma("unroll 1") for (int rep_ = 0; rep_ < (((PROBE_REP_MASK >> (k)) & 1) ? 2 : 1); ++rep_)
__global__ void __launch_bounds__(NTHR, 2) mk_fwd(Params args) {
    extern __shared__ __attribute__((aligned(16))) unsigned char lds_raw[];
    Ctx F;
    F.lds = (LAS unsigned char*)lds_raw; F.MISC = (volatile LAS unsigned*)(F.lds + MISC_OFF);
    F.wave = __builtin_amdgcn_readfirstlane((int)threadIdx.x >> 6); F.tid = fresh_tid(F.wave); F.lane = F.tid & 63;
    F.G = gridDim.x; { const int bx = blockIdx.x; F.vcu = (F.G % 8 == 0) ? (bx % 8) * (F.G / 8) + bx / 8 : bx; }
#pragma unroll
    for (int i = 0; i < 28; ++i) F.in[i] = args.in[i];
    F.out = args.out; F.ws = args.ws; F.ctl = (gu32*)(args.ws + WS_CTL);
    for (int u = F.tid; u < (LDS_BYTES - LDSCTL_OFF) / 4; u += NTHR) ((LAS unsigned*)(F.lds + LDSCTL_OFF))[u] = 0u;
    __syncthreads();
    XcdBarrier bar; bar.bar = (unsigned*)(F.ctl + CW_BAR); bar.x = 0; bar.st = nullptr;
    const bool has_bar = args.bar_region >= 0;
    if (has_bar) bar = xcd_barrier_post((unsigned*)(F.ctl + CW_BAR) + args.bar_region * XCD_BAR_WORDS, F.MISC + 8, F.tid);
    const int lo = args.st_lo, hi = args.st_hi;
#ifdef STEP_MASK
#define IN(k) (((STEP_MASK >> (k)) & 1) && lo <= (k) && (k) < hi && step_active(layer, (k)))
#else
#define IN(k) (lo <= (k) && (k) < hi && step_active(layer, (k)))
#endif
#define SEAM(k) do { bool more_ = layer + 1 < args.layer_hi; for (int k2 = (k) + 1; k2 < hi; ++k2) more_ = more_ || step_active(layer, k2); if (has_bar && more_) { const int bt_ = fresh_tid(F.wave); xcd_barrier(bar, bt_); if ((PROBE_REP_MASK >> 13) & 1) xcd_barrier(bar, bt_); } } while (0)
#define FRESH() do { F.tid = fresh_tid(F.wave); F.lane = F.tid & 63; } while (0)
    for (int layer = args.layer_lo; layer < args.layer_hi; ++layer) {
        const int j = layer >> 1; const bool even = (layer & 1) == 0;
        if (IN(0)) { FRESH(); REPS(0) s0_convert(F, layer); if (layer == 0 || hi <= 1) SEAM(0); else __syncthreads(); }
        if (IN(1)) {
            if (even ? F8_HY_IN : F8_SS_IN) {
                pg8::Gemm g{(const pg8::bf16_t*)(F.ws + WS_XIN8), even ? (const pg8::bf16_t*)(F.ws + WS_WHYIN8 + (size_t)j * 5120 * 2048) : (const pg8::bf16_t*)(F.ws + WS_WSSIN8 + (size_t)j * 10240 * 2048), T, even ? 5120 : 10240, D / 2};
                pg8::StaticOrder S; S.init(T, g.N, F.G, (int)blockIdx.x);
                pg8::EpiBf16P8 E{(pg8::bf16_t*)(F.ws + WS_PROJ), even ? HY_NP : SS_NP, 1.0f / 512.0f};
                REPS(1) pg8::gemm_phase<pg8::EpiBf16P8, pg8::StaticOrder, PG8_ALIGN, PG8_SP2>(F.lds + RING_OFF, g, S, E, F.wave);
            } else {
                pg8::Gemm g{(const pg8::bf16_t*)(F.ws + WS_XB), even ? (const pg8::bf16_t*)(F.ws + WS_WHYIN) + (size_t)j * HY_NP * 2048 : (const pg8::bf16_t*)(F.ws + WS_WSSIN) + (size_t)j * SS_NP * 2048, T, even ? 5120 : 10240, D};
                pg8::StaticOrder S; S.init(T, g.N, F.G, (int)blockIdx.x);
                pg8::EpiBf16P E{(pg8::bf16_t*)(F.ws + WS_PROJ), even ? HY_NP : SS_NP, 1.0f};
                REPS(1) pg8::gemm_phase<pg8::EpiBf16P, pg8::StaticOrder, PG8_ALIGN, PG8_SP2>(F.lds + RING_OFF, g, S, E, F.wave);
            }
            if (even) skinny_proj<1>(F, (const bf16_t*)(F.ws + WS_WHYIN) + ((size_t)j * HY_NP + 5120) * 2048, (float*)(F.ws + WS_FCUM), 8);
            else skinny_proj<4>(F, (const bf16_t*)(F.ws + WS_WSSIN) + ((size_t)j * SS_NP + 10240) * 2048, (float*)(F.ws + WS_DTB), 64);
            SEAM(1);
        }
        if (IN(2)) { FRESH();
            if (even) { const bf16_t* PROJ = (const bf16_t*)(F.ws + WS_PROJ); bf16_t* YMIX = (bf16_t*)(F.ws + WS_YMIX);
                REPS(2) for (int item = F.vcu; item < 256; item += F.G) fox::attn_item((char*)lds_raw, PROJ, (const float*)(F.ws + WS_FCUM), YMIX, F.in[11] + (size_t)j * 8, item, fresh_tid(F.wave));
                { int hd_lds = -1; REPS(3) for (int item = F.vcu; item < 2048; item += F.G) lru_local_item(F, j, item, hd_lds); }
            } else { int g_lds = -1; for (int item = F.vcu; item < 1024; item += F.G) ssd_states_item(F, j, item, g_lds); }
            SEAM(2); }
        if (IN(3)) { FRESH();
            if (even) { REPS(4) for (int item = F.vcu; item < 256; item += F.G) lru_fix_item(F, item); }
            else { for (int item = F.vcu; item < 256; item += F.G) ssd_scan_item(F, item); }
            SEAM(3); }
        if (IN(4)) { FRESH();
            { int g_lds = -1; REPS(6) for (int item = F.vcu; item < 1024; item += F.G) ssd_y_item(F, j, item, g_lds); }
            SEAM(4); }
        if (IN(7)) {
            pg8::StaticOrder S; S.init(T, D, F.G, (int)blockIdx.x);
            if (even ? F8_HY_OUT : F8_SS_OUT) {
                pg8::Gemm g{even ? (const pg8::bf16_t*)(F.ws + WS_YMIX8) : (const pg8::bf16_t*)(F.ws + WS_YN8), even ? (const pg8::bf16_t*)(F.ws + WS_WHYOUT + (size_t)j * 2048 * 2048) : (const pg8::bf16_t*)(F.ws + WS_WSSOUT + (size_t)j * 2048 * 4096), T, D, even ? 1024 : 2048};
                pg8::EpiBf16P8 E{(pg8::bf16_t*)(F.ws + WS_MBUF), D, 1.0f / 512.0f};
                REPS(7) pg8::gemm_phase<pg8::EpiBf16P8, pg8::StaticOrder, PG8_ALIGN, PG8_SP2>(F.lds + RING_OFF, g, S, E, F.wave);
            } else {
                pg8::Gemm g{even ? (const pg8::bf16_t*)(F.ws + WS_YMIX) : (const pg8::bf16_t*)(F.ws + WS_YN), even ? (const pg8::bf16_t*)(F.ws + WS_WHYOUT) + (size_t)j * 2048 * 2048 : (const pg8::bf16_t*)(F.ws + WS_WSSOUT) + (size_t)j * 2048 * 4096, T, D, even ? 2048 : 4096};
                pg8::EpiBf16P E{(pg8::bf16_t*)(F.ws + WS_MBUF), D, 1.0f};
                REPS(7) pg8::gemm_phase<pg8::EpiBf16P, pg8::StaticOrder, PG8_ALIGN, PG8_SP2>(F.lds + RING_OFF, g, S, E, F.wave);
            }
            SEAM(7);
        }
        if (IN(8)) { FRESH(); if ((PROBE_REP_MASK >> 8) & 1) ln1_router<true>(F, layer); ln1_router<false>(F, layer); SEAM(8); }
        if (IN(10)) {
            pg8::MoeGatherOrder S; moe_tables(F, layer, S.tab); const int Gg = moe_gemm_wgs(F, S.tab[16], layer + 1 < DEPTH); S.G = Gg; S.c = (int)blockIdx.x < Gg ? (int)blockIdx.x : 8 * S.tab[16]; S.exptok = (const int*)(F.ws + WS_EXPTOK); S.cnt = (const unsigned*)(F.ctl + CW_CNT + layer * 16); S.cap = T;
            pg8::Gemm g{(const pg8::bf16_t*)(F.ws + WS_XB8), (const pg8::bf16_t*)(F.ws + ((layer & 1) ? WS_WGU_B : WS_WGU)), T, 2048, D / 2};
            pg8::EpiSwiglu E{F.ws + WS_HID, (const float*)(F.ws + WS_EXPW), S.cnt, T, MOE_FF};
            REPS(10) pg8::gemm_phase<pg8::EpiSwiglu, pg8::MoeGatherOrder, PG8_ALIGN, PG8_SP2>(F.lds + RING_OFF, g, S, E, F.wave);
            if (layer + 1 < DEPTH) moe_tail_convert(F, layer + 1, Gg, 0);
            SEAM(10);
        }
        if (IN(11)) {
            pg8::MoeOrder S; moe_tables(F, layer, S.tab); const int Gg = moe_gemm_wgs(F, S.tab[16], layer + 1 < DEPTH); S.G = Gg; S.c = (int)blockIdx.x < Gg ? (int)blockIdx.x : 8 * S.tab[16];
            pg8::Gemm g{(const pg8::bf16_t*)(F.ws + WS_HID), (const pg8::bf16_t*)(F.ws + ((layer & 1) ? WS_WD_B : WS_WD)), MOE_ROWS, 2048, MOE_FF / 2};
            pg8::EpiBf16P8 E{(pg8::bf16_t*)(F.ws + WS_YG), D, 1.0f / 512.0f};
            REPS(11) pg8::gemm_phase<pg8::EpiBf16P8, pg8::MoeOrder, PG8_ALIGN, PG8_SP2>(F.lds + RING_OFF, g, S, E, F.wave);
            if (layer + 1 < DEPTH) moe_tail_convert(F, layer + 1, Gg, 1);
            SEAM(11);
        }
        if (IN(12)) { FRESH(); if ((PROBE_REP_MASK >> 12) & 1) { ln2_phase<true>(F, layer); __syncthreads(); } ln2_phase<false>(F, layer); SEAM(12); }
    }
#undef IN
#undef SEAM
}
extern "C" void kernel_launch(void* const* d_in, const int* in_sizes, int n_in, void* d_out, int out_size, void* d_ws, size_t ws_size, hipStream_t stream) {
    static int grid = 0;
    if (grid == 0) {
        if (n_in != 28 || out_size != T * D || ws_size < WS_END) { fprintf(stderr, "kernel_launch: unexpected shapes (n_in %d out %d ws %zu need %zu)\n", n_in, out_size, ws_size, (size_t)WS_END); grid = -1; return; }
        int dev = 0, cus = 0; (void)hipGetDevice(&dev); (void)hipDeviceGetAttribute(&cus, hipDeviceAttributeMultiprocessorCount, dev);
        if (hipFuncSetAttribute((const void*)mk_fwd, hipFuncAttributeMaxDynamicSharedMemorySize, LDS_BYTES) != hipSuccess) { fprintf(stderr, "kernel_launch: hipFuncSetAttribute failed\n"); grid = -1; return; }
        int per_cu = 0; (void)hipOccupancyMaxActiveBlocksPerMultiprocessor(&per_cu, (const void*)mk_fwd, NTHR, LDS_BYTES); (void)hipGetLastError();
        grid = 256; if (cus != 256 || per_cu < 1) fprintf(stderr, "kernel_launch: built for 256 CUs x 1 workgroup (144 KiB LDS each); device has %d CUs, occupancy query says %d\n", cus, per_cu);
    }
    if (grid < 0) return;
    (void)hipMemsetAsync((char*)d_ws + WS_CTL, 0, CTL_ZERO_BYTES, stream);
    Params a{};
    for (int i = 0; i < 28; ++i) a.in[i] = (const float*)d_in[i];
    a.out = (float*)d_out; a.ws = (unsigned char*)d_ws;
#if MK_ONE_LAUNCH
    a.layer_lo = 0; a.layer_hi = DEPTH; a.st_lo = 0; a.st_hi = N_STEPS; a.bar_region = 0;
    hipLaunchKernelGGL(mk_fwd, dim3(grid), dim3(NTHR), LDS_BYTES, stream, a);
#else
    for (int layer = 0; layer < DEPTH; ++layer)
        for (int s = 0; s < N_STEPS; ++s) if (step_active(layer, s)) {
            a.layer_lo = layer; a.layer_hi = layer + 1; a.st_lo = s; a.st_hi = s + 1; a.bar_region = -1;
            hipLaunchKernelGGL(mk_fwd, dim3(grid), dim3(NTHR), LDS_BYTES, stream, a);
        }
#endif
}
```

```cpp
#include <hip/hip_runtime.h>
#include <cstdio>
#include <cstdint>
__device__ __forceinline__ float shfl_xor_l(float v, int o, int lane) { return __int_as_float(__builtin_amdgcn_ds_bpermute((lane ^ o) << 2, __float_as_int(v))); }
__device__ __forceinline__ float shfl_up_l(float v, int o, int lane) { return __int_as_float(__builtin_amdgcn_ds_bpermute((lane - o) << 2, __float_as_int(v))); }
__device__ __forceinline__ int lane_id() { return (int)__builtin_amdgcn_mbcnt_hi(~0u, __builtin_amdgcn_mbcnt_lo(~0u, 0u)); }
__device__ __forceinline__ int fresh_tid(int wave) { int t; asm volatile("v_mbcnt_lo_u32_b32 %0, -1, 0\n\tv_mbcnt_hi_u32_b32 %0, -1, %0\n\tv_lshl_add_u32 %0, %1, 6, %0" : "=&v"(t) : "s"(wave)); return t; }
namespace pg8 {
#define PG8_LAS __attribute__((address_space(3)))
typedef unsigned short bf16_t;
typedef short bf16x8 __attribute__((ext_vector_type(8)));
typedef float f32x4 __attribute__((ext_vector_type(4)));
typedef unsigned u32x4 __attribute__((ext_vector_type(4)));
typedef int v8i __attribute__((ext_vector_type(8)));
constexpr int BM = 256, BK = 64, HALF = 128, HTB = HALF * BK * 2  , STAGE_BYTES = 8 * HTB, NXCD = 8, WGM = 8;

__host__ __device__ __forceinline__ int lds_byte(int r, int c) { const int st = (r >> 4) * 2 + (c >> 5), rr = r & 15, cc = c & 31, ob = rr * 64 + cc * 2; return st * 1024 + (ob ^ (((ob >> 9) & 1) << 5)); }
__host__ __device__ __forceinline__ void stage_rc(int b, int& R, int& C) { const int st = b / 1024, sb = b % 1024, swz = sb ^ (((sb >> 9) & 1) << 5); R = (st >> 1) * 16 + swz / 64; C = (st & 1) * 32 + (swz % 64) / 2; }
__host__ __device__ __forceinline__ int perm32(int rho) { const int n = rho >> 4, i = rho & 15; return 8 * (i >> 2) + 4 * n + (i & 3); }

struct Unit { int pm, pn, pb, e, lt; };
struct Gemm { const bf16_t* A; const bf16_t* Bt; int M, N, K; };

struct StaticOrder {
    static constexpr bool GATHER = false;
    int nM, nN, nwg, G, c;
    __host__ __device__ void init(int M, int N, int G_, int c_) { nM = M / BM; nN = N / BM; nwg = nM * nN; G = G_; c = c_; }
    __host__ __device__ bool next(int i, Unit& u) const {
        const long L = (long)i * G + c; if (L >= nwg) return false;
        int wgid = (int)L; { const int q = nwg / NXCD, r = nwg % NXCD, xcd = wgid % NXCD, off = wgid / NXCD; wgid = (xcd < r ? xcd * (q + 1) : r * (q + 1) + (xcd - r) * q) + off; }
        const int nig = WGM * nN, gid = wgid / nig, fm = gid * WGM, gsz = (nM - fm) < WGM ? (nM - fm) : WGM;
        u.pm = fm + ((wgid % nig) % gsz); u.pn = (wgid % nig) / gsz; u.pb = u.pn; u.e = 0; u.lt = 0; return true;
    }
    __device__ __forceinline__ void a_ready(const Unit&) const {}
    __device__ __forceinline__ void done(const Unit&) const {}
};
struct MoeOrder {
    static constexpr bool GATHER = false;
    int tab[17]; int G, c;
    __device__ bool next(int i, Unit& u) const {
        const int nt = tab[16]; const int L = i * G + c; if (L >= nt * 8) return false;
        const int wgid = (L & 7) * nt + (L >> 3); const int t = wgid >> 3, pn = wgid & 7;
        int E = 0;
#pragma unroll
        for (int e = 1; e < 16; ++e) E += (t >= tab[e]) ? 1 : 0;
        int t0 = 0;
#pragma unroll
        for (int e = 1; e < 16; ++e) t0 = (E == e) ? tab[e] : t0;
        u.pm = t; u.pn = pn; u.pb = E * 8 + pn; u.e = E; u.lt = t - t0; return true;
    }
    __device__ __forceinline__ void a_ready(const Unit&) const {}
    __device__ __forceinline__ void done(const Unit&) const {}
};
struct MoeGatherOrder : MoeOrder {
    static constexpr bool GATHER = true;
    const int* exptok; const unsigned* cnt; int cap;
    __device__ __forceinline__ int row_of(const Unit& u, int r) const { const int i = u.lt * 256 + r; const int n = (int)__hip_atomic_load(cnt + u.e, __ATOMIC_RELAXED, __HIP_MEMORY_SCOPE_AGENT);
        return i < n ? exptok[(size_t)u.e * cap + i] : 0; }
};
__device__ __forceinline__ unsigned cvt_pk_bf16(float lo, float hi) { unsigned r; asm volatile("v_cvt_pk_bf16_f32 %0, %1, %2" : "=v"(r) : "v"(lo), "v"(hi)); return r; }

template <bool F8> struct EpiBf16PT {
    static constexpr bool PERM = true, AFTER_DRAIN = false, FP8 = F8;
    bf16_t* O; int ldc; float oscale;
    __device__ __forceinline__ void operator()(const f32x4 (&acc)[2][2][4][2], const Unit& u, int wr, int wc, int fr, int fq) const {
        const int row0 = u.pm * BM + wr * 64 + fr, col0 = u.pn * BM + wc * 32 + 8 * fq;
#pragma unroll
        for (int ai = 0; ai < 2; ++ai)
#pragma unroll
            for (int m = 0; m < 4; ++m) { bf16_t* rowp = O + (size_t)(row0 + ai * HALF + m * 16) * ldc + col0;
#pragma unroll
                for (int bj = 0; bj < 2; ++bj) { f32x4 v0 = acc[ai][bj][m][0], v1 = acc[ai][bj][m][1]; if (F8) { v0 = v0 * oscale; v1 = v1 * oscale; }
                    u32x4 w; w.x = cvt_pk_bf16(v0[0], v0[1]); w.y = cvt_pk_bf16(v0[2], v0[3]); w.z = cvt_pk_bf16(v1[0], v1[1]); w.w = cvt_pk_bf16(v1[2], v1[3]);
                    *(u32x4*)(rowp + bj * HALF) = w; } }
    }
};
typedef EpiBf16PT<false> EpiBf16P;
typedef EpiBf16PT<true> EpiBf16P8;
__device__ __forceinline__ float silu_fast(float x) { return x * __builtin_amdgcn_rcpf(1.0f + __expf(-x)); }
struct EpiSwiglu {
    static constexpr bool PERM = true, AFTER_DRAIN = false, FP8 = true;
    unsigned char* H; const float* expw; const unsigned* cnt; int cap, ldc;
    __device__ __forceinline__ void operator()(const f32x4 (&acc)[2][2][4][2], const Unit& u, int wr, int wc, int fr, int fq) const {
        const int row0 = u.pm * BM + wr * 64 + fr, col0 = u.pn * HALF + wc * 32 + 8 * fq; const int nvalid = (int)__hip_atomic_load(cnt + u.e, __ATOMIC_RELAXED, __HIP_MEMORY_SCOPE_AGENT);
        float gtv[8];
#pragma unroll
        for (int k = 0; k < 8; ++k) { const int li = wr * 64 + fr + (k >> 2) * HALF + (k & 3) * 16 + u.lt * BM; gtv[k] = expw[(size_t)u.e * cap + li]; }
        asm volatile("" : "+v"(gtv[0]), "+v"(gtv[1]), "+v"(gtv[2]), "+v"(gtv[3]), "+v"(gtv[4]), "+v"(gtv[5]), "+v"(gtv[6]), "+v"(gtv[7]));
#pragma unroll
        for (int ai = 0; ai < 2; ++ai)
#pragma unroll
            for (int m = 0; m < 4; ++m) { const int row = row0 + ai * HALF + m * 16; const int li = row - u.pm * BM + u.lt * BM; const float gt = li < nvalid ? gtv[ai * 4 + m] : 0.f;
                const f32x4 g0 = acc[ai][0][m][0], g1 = acc[ai][0][m][1], u0 = acc[ai][1][m][0], u1 = acc[ai][1][m][1];
                float h[8]; const float ds = 1.0f / 512.0f, gs = gt * (4.0f / 512.0f);
#pragma unroll
                for (int i = 0; i < 4; ++i) { h[i] = __builtin_amdgcn_fmed3f(silu_fast(g0[i] * ds) * u0[i] * gs, -448.f, 448.f); h[4 + i] = __builtin_amdgcn_fmed3f(silu_fast(g1[i] * ds) * u1[i] * gs, -448.f, 448.f); }
                int w0 = __builtin_amdgcn_cvt_pk_fp8_f32(h[0], h[1], 0, false); w0 = __builtin_amdgcn_cvt_pk_fp8_f32(h[2], h[3], w0, true);
                int w1 = __builtin_amdgcn_cvt_pk_fp8_f32(h[4], h[5], 0, false); w1 = __builtin_amdgcn_cvt_pk_fp8_f32(h[6], h[7], w1, true);
                typedef int i32x2 __attribute__((ext_vector_type(2)));
                *(i32x2*)(H + (size_t)row * ldc + col0) = (i32x2){w0, w1}; }
    }
};
template <class Epi, class Sched, bool ALIGN_EPI = false, bool SP2 = true>
__device__ __forceinline__ void gemm_phase(PG8_LAS unsigned char* lds, const Gemm g, const Sched& S, const Epi& E, int wave_in) {
    static_assert(SP2, "only the two-super-phase K-loop is kept in this file");
    const int tid_ = fresh_tid(wave_in);
    const int tid = tid_, wid = __builtin_amdgcn_readfirstlane(tid >> 6), lane = tid & 63, wr = wid >> 2, wc = wid & 3, fr = lane & 15, fq = lane >> 4;
    const int K = g.K, nt = K / BK;
    constexpr bool GATHER = Sched::GATHER;
    unsigned voffB[2]; int RA[2], CA[2];
#pragma unroll
    for (int i = 0; i < 2; ++i) { int R, C; stage_rc(tid * 16 + i * 8192, R, C); const int Rb = Epi::PERM ? ((R & ~31) + perm32(R & 31)) : R; RA[i] = R; CA[i] = C; voffB[i] = (unsigned)(Rb * K + C) * 2u; }
    const size_t kstep = (size_t)(BK * 2);
    const size_t hstep = (size_t)HALF * K * 2;
    const size_t tstep = 2 * hstep;
    const unsigned ldsw = (unsigned)wid * 1024u;
    PG8_LAS int* IDX = (PG8_LAS int*)(lds + STAGE_BYTES);
    unsigned vc[2][2], vn[2][2];
#pragma unroll
    for (int h = 0; h < 2; ++h)
#pragma unroll
        for (int i = 0; i < 2; ++i) { vc[h][i] = (unsigned)((h * HALF + RA[i]) * K + CA[i]) * 2u; vn[h][i] = vc[h][i]; }
    const int aoff = lds_byte(wr * 64 + fr, fq * 8), boff = lds_byte(wc * 32 + fr, fq * 8);
#define PG8_SA(b, h) (((b) * 2 + (h)) * HTB)
#define PG8_SB(b, h) ((4 + (b) * 2 + (h)) * HTB)
#define PG8_STAGE(bufoff, gbase, voff) do { _Pragma("unroll") for (int _i = 0; _i < 2; ++_i) \
        __builtin_amdgcn_global_load_lds((const unsigned*)((const char*)(gbase) + (voff)[_i]), (PG8_LAS unsigned*)(lds + (bufoff) + ldsw + _i * 8192), 16, 0, 0); } while (0)
#define PG8_LDA(dst, b, h) do { _Pragma("unroll") for (int m = 0; m < 4; ++m) _Pragma("unroll") for (int k = 0; k < 2; ++k) dst[m][k] = *(const PG8_LAS bf16x8*)(lds + PG8_SA(b, h) + aoff + m * 2048 + k * 1024); } while (0)
#define PG8_LDB(dst, b, h) do { _Pragma("unroll") for (int n = 0; n < 2; ++n) _Pragma("unroll") for (int k = 0; k < 2; ++k) dst[n][k] = *(const PG8_LAS bf16x8*)(lds + PG8_SB(b, h) + boff + n * 2048 + k * 1024); } while (0)
#define PG8_MMA(ai, bj, At, Bt) do { __builtin_amdgcn_s_setprio(1); _Pragma("unroll") for (int m = 0; m < 4; ++m) _Pragma("unroll") for (int n = 0; n < 2; ++n) { \
        if constexpr (Epi::FP8) { v8i a8_, b8_; { const u32x4 x0_ = __builtin_bit_cast(u32x4, At[m][0]), x1_ = __builtin_bit_cast(u32x4, At[m][1]), y0_ = __builtin_bit_cast(u32x4, Bt[n][0]), y1_ = __builtin_bit_cast(u32x4, Bt[n][1]); \
                a8_ = (v8i){(int)x0_.x, (int)x0_.y, (int)x0_.z, (int)x0_.w, (int)x1_.x, (int)x1_.y, (int)x1_.z, (int)x1_.w}; b8_ = (v8i){(int)y0_.x, (int)y0_.y, (int)y0_.z, (int)y0_.w, (int)y1_.x, (int)y1_.y, (int)y1_.z, (int)y1_.w}; } \
            acc[ai][bj][m][n] = __builtin_amdgcn_mfma_scale_f32_16x16x128_f8f6f4(b8_, a8_, acc[ai][bj][m][n], 0, 0, 0, 0x7f7f7f7f, 0, 0x7f7f7f7f); asm volatile("" : "+v"(acc[ai][bj][m][n])); } \
        else { _Pragma("unroll") for (int k = 0; k < 2; ++k) acc[ai][bj][m][n] = __builtin_amdgcn_mfma_f32_16x16x32_bf16(Bt[n][k], At[m][k], acc[ai][bj][m][n], 0, 0, 0); } } \
        __builtin_amdgcn_s_setprio(0); } while (0)
#define PG8_WAIT_V(n) asm volatile("s_waitcnt vmcnt(" #n ")" ::: "memory")
#define PG8_WAIT_L(n) asm volatile("s_waitcnt lgkmcnt(" #n ")" ::: "memory")
#define PG8_BAR __builtin_amdgcn_s_barrier()
#define PG8_SCHED __builtin_amdgcn_sched_barrier(0)
#define PG8_FETCH_ROWS(u_, slot_) do { if (wid == 7) { int r4_[4]; _Pragma("unroll") for (int q_ = 0; q_ < 4; ++q_) r4_[q_] = S.row_of((u_), lane + 64 * q_); \
        asm volatile("s_waitcnt vmcnt(0)" ::: "memory"); _Pragma("unroll") for (int q_ = 0; q_ < 4; ++q_) IDX[(slot_) * 256 + lane + 64 * q_] = r4_[q_]; } } while (0)
#define PG8_ROW_OFFS(dst_, slot_) do { _Pragma("unroll") for (int h_ = 0; h_ < 2; ++h_) _Pragma("unroll") for (int i_ = 0; i_ < 2; ++i_) \
        dst_[h_][i_] = (unsigned)(IDX[(slot_) * 256 + h_ * HALF + RA[i_]] * K + CA[i_]) * 2u; } while (0)
    Unit cur, nxt; int ui = 0;
    if (!S.next(0, cur)) return;
    f32x4 acc[2][2][4][2];
#pragma unroll
    for (int a = 0; a < 2; ++a)
#pragma unroll
        for (int b = 0; b < 2; ++b)
#pragma unroll
            for (int m = 0; m < 4; ++m)
#pragma unroll
                for (int n = 0; n < 2; ++n) acc[a][b][m][n] = (f32x4){0.f, 0.f, 0.f, 0.f};
    bf16x8 At[4][2], B0[2][2], B1[2][2];
    const char* cA = GATHER ? (const char*)g.A : (const char*)g.A + (size_t)cur.pm * tstep; const char* cB = (const char*)g.Bt + (size_t)cur.pb * tstep;
    S.a_ready(cur);
    if constexpr (GATHER) { PG8_FETCH_ROWS(cur, 0); PG8_WAIT_L(0); PG8_BAR; asm volatile("" ::: "memory"); PG8_ROW_OFFS(vc, 0); }
    PG8_STAGE(PG8_SB(0, 0), cB, voffB); PG8_STAGE(PG8_SB(0, 1), cB + hstep, voffB); PG8_STAGE(PG8_SA(0, 0), cA, vc[0]); PG8_STAGE(PG8_SA(0, 1), cA, vc[1]);
    if (wr == 1) PG8_BAR;
    PG8_WAIT_V(2); PG8_BAR;
    PG8_STAGE(PG8_SB(1, 0), cB + kstep, voffB); PG8_STAGE(PG8_SA(1, 0), cA + kstep, vc[0]); PG8_STAGE(PG8_SB(1, 1), cB + hstep + kstep, voffB);
    PG8_WAIT_V(6); PG8_BAR;
    for (;;) {
        const bool has_next = S.next(ui + 1, nxt);
        const char* nA = GATHER ? (const char*)g.A : (has_next ? (const char*)g.A + (size_t)nxt.pm * tstep : cA); const char* nB = has_next ? (const char*)g.Bt + (size_t)nxt.pb * tstep : cB;
        if constexpr (GATHER) { if (has_next) PG8_FETCH_ROWS(nxt, (ui + 1) & 1); }
        for (int t = 0; t < nt; t += 2) {
            const bool last = (t == nt - 2);
            const char* a1 = cA + (size_t)(t + 1) * kstep;
            const char* a2 = last ? nA : cA + (size_t)(t + 2) * kstep; const char* b2 = last ? nB : cB + (size_t)(t + 2) * kstep;
            const char* a3 = a2 + kstep; const char* b3 = b2 + kstep;
            if (last && has_next) { S.a_ready(nxt); if constexpr (GATHER) { PG8_ROW_OFFS(vn, (ui + 1) & 1); } }
            unsigned v2[2][2];
#pragma unroll
            for (int h = 0; h < 2; ++h)
#pragma unroll
                for (int i = 0; i < 2; ++i) v2[h][i] = (GATHER && last && has_next) ? vn[h][i] : vc[h][i];
            PG8_LDB(B0, 0, 0); PG8_LDB(B1, 0, 1); PG8_SCHED; PG8_LDA(At, 0, 0); PG8_STAGE(PG8_SA(1, 1), a1, vc[1]);
            PG8_WAIT_V(8); PG8_WAIT_L(0); PG8_BAR; PG8_MMA(0, 0, At, B0); PG8_MMA(0, 1, At, B1); PG8_BAR; PG8_SCHED;
            PG8_LDA(At, 0, 1); PG8_STAGE(PG8_SB(0, 0), b2, voffB); PG8_STAGE(PG8_SB(0, 1), b2 + hstep, voffB); PG8_STAGE(PG8_SA(0, 0), a2, v2[0]);
            PG8_WAIT_V(8); PG8_WAIT_L(0); PG8_BAR; PG8_MMA(1, 0, At, B0); PG8_MMA(1, 1, At, B1); PG8_BAR; PG8_SCHED;
            PG8_LDB(B0, 1, 0); PG8_LDB(B1, 1, 1); PG8_SCHED; PG8_LDA(At, 1, 0); PG8_STAGE(PG8_SA(0, 1), a2, v2[1]);
            PG8_WAIT_V(8); PG8_WAIT_L(0); PG8_BAR; PG8_MMA(0, 0, At, B0); PG8_MMA(0, 1, At, B1); PG8_BAR; PG8_SCHED;
            PG8_LDA(At, 1, 1); PG8_STAGE(PG8_SB(1, 0), b3, voffB); PG8_STAGE(PG8_SB(1, 1), b3 + hstep, voffB); PG8_STAGE(PG8_SA(1, 0), a3, v2[0]);
            PG8_WAIT_V(8); PG8_WAIT_L(0); PG8_BAR; PG8_MMA(1, 0, At, B0); PG8_MMA(1, 1, At, B1); PG8_BAR; PG8_SCHED;
        }
        if constexpr (ALIGN_EPI) { if (wr == 0) PG8_BAR; }
        if constexpr (!Epi::AFTER_DRAIN) { E(acc, cur, wr, wc, fr, fq); S.done(cur); }
        if (!has_next) break;
#pragma unroll
        for (int a = 0; a < 2; ++a)
#pragma unroll
            for (int b = 0; b < 2; ++b)
#pragma unroll
                for (int m = 0; m < 4; ++m)
#pragma unroll
                    for (int n = 0; n < 2; ++n) acc[a][b][m][n] = (f32x4){0.f, 0.f, 0.f, 0.f};
        cur = nxt; cA = nA; cB = nB; ++ui;
        if constexpr (GATHER) {
#pragma unroll
            for (int h = 0; h < 2; ++h)
#pragma unroll
                for (int i = 0; i < 2; ++i) vc[h][i] = vn[h][i]; }
        if constexpr (ALIGN_EPI) { if (wr == 1) PG8_BAR; }
    }
    PG8_WAIT_V(0);
    if constexpr (!ALIGN_EPI) { if (wr == 0) PG8_BAR; }
    PG8_BAR;
    if constexpr (Epi::AFTER_DRAIN) { E.fused(acc, cur, wr, wc, fr, fq, lds, wid, lane); S.done(cur); }
#undef PG8_SA
#undef PG8_SB
#undef PG8_STAGE
#undef PG8_LDA
#undef PG8_LDB
#undef PG8_MMA
#undef PG8_WAIT_V
#undef PG8_WAIT_L
#undef PG8_BAR
#undef PG8_SCHED
#undef PG8_FETCH_ROWS
#undef PG8_ROW_OFFS
}
}
#ifndef PG8_SP2
#define PG8_SP2 true
#endif
#ifndef PG8_ALIGN
#define PG8_ALIGN true
#endif
constexpr int BATCH = 4, SEQ = 4096, T = BATCH * SEQ, D = 2048, DEPTH = 4;
constexpr int HY_N = 5128, HY_NP = 5376;
constexpr int SS_N = 10304, SS_NP = 10496;
constexpr int LRU_W = 1024;
constexpr int SSD_INNER = 4096, SSD_CONV = 6144, SSD_H = 64, SSD_P = 64, SSD_G = 8, SSD_NS = 128, SSD_L = 128, SSD_NC = SEQ / SSD_L;
constexpr int MOE_FF = 1024, MOE_E = 16, MOE_ROWS = 2 * T + MOE_E * 256;
constexpr float ALPHA = 1.6817928305074290f;
constexpr float LN_EPS = 1e-5f, RMS_EPS = 1e-5f;
constexpr int NWAVES = 8, NTHR = 512;
constexpr size_t MiB = 1u << 20;
constexpr size_t WS_CTL = 0, CTL_ZERO_BYTES = 1 * MiB;
constexpr size_t WS_TOKSLOT = 1 * MiB;
constexpr size_t WS_TOKPOS = WS_TOKSLOT + 512 * 1024;
constexpr size_t WS_ROWGATE = WS_TOKPOS + 128 * 1024;
constexpr size_t WS_WRT = 2 * MiB;
constexpr size_t WS_WRI = 3 * MiB;
constexpr size_t WS_WHYIN = 4 * MiB;
constexpr size_t WS_WHYOUT = 46 * MiB;
constexpr size_t WS_WSSIN = 62 * MiB;
constexpr size_t WS_WSSOUT = 144 * MiB;
constexpr size_t WS_WGU = 176 * MiB;
constexpr size_t WS_WD = 304 * MiB;
constexpr size_t WS_X = 368 * MiB;
#ifndef F8_HY_IN
#define F8_HY_IN 1
#endif
#ifndef F8_SS_IN
#define F8_SS_IN 0
#endif
#ifndef F8_HY_OUT
#define F8_HY_OUT 1
#endif
#ifndef F8_SS_OUT
#define F8_SS_OUT 0
#endif
constexpr size_t WS_YN8 = 420 * MiB;
constexpr size_t WS_XIN8 = 368 * MiB;
constexpr size_t WS_WHYIN8 = 400 * MiB;
constexpr size_t WS_WSSIN8 = 420 * MiB;
constexpr size_t WS_XB = 496 * MiB;
constexpr size_t WS_MBUF = 560 * MiB;
constexpr size_t WS_ARENA = 624 * MiB;
constexpr size_t WS_PROJ = WS_ARENA;
constexpr size_t WS_HLOC = WS_ARENA + 168 * MiB;
constexpr size_t WS_CUMA = WS_ARENA + 232 * MiB;
constexpr size_t WS_LSUM = WS_ARENA + 296 * MiB;
constexpr size_t WS_YMIX = WS_ARENA + 298 * MiB;
constexpr size_t WS_FCUM = WS_ARENA + 362 * MiB;
constexpr size_t WS_STATES = WS_ARENA + 328 * MiB;
constexpr size_t WS_YN = WS_ARENA + 456 * MiB;
constexpr size_t WS_YMIX8 = WS_ARENA + 298 * MiB;
constexpr size_t WS_DTB = WS_ARENA + 584 * MiB;
constexpr size_t WS_ACSB = WS_ARENA + 588 * MiB;
constexpr size_t WS_XS = WS_ARENA + 592 * MiB;
constexpr size_t WS_BS = WS_ARENA + 720 * MiB;
constexpr size_t WS_WGU_B = WS_ARENA + 752 * MiB;
constexpr size_t WS_WD_B = WS_ARENA + 880 * MiB;
constexpr size_t WS_EXPTOK = WS_ARENA;
constexpr size_t WS_EXPW = WS_ARENA + 1 * MiB;
constexpr size_t WS_XB8 = WS_ARENA + 4 * MiB;
constexpr size_t WS_XG = WS_ARENA;
constexpr size_t WS_HID = WS_ARENA + 144 * MiB;
constexpr size_t WS_YG = WS_ARENA + 216 * MiB;
constexpr size_t WS_NAIVE = WS_ARENA + 600 * MiB;
constexpr size_t WS_END = WS_ARENA + 1060 * MiB;
constexpr int CW_TMO = 0, CW_CODE = 1, CW_CNT = 64  , CW_CVTHEAD = 256  , CW_DONE = 512  , CW_BAR = 4096;
constexpr int N_BAR_REGIONS = 8;
constexpr int RING_OFF = 0, RING_BYTES = 159744, LDSCTL_OFF = RING_BYTES, MISC_OFF = LDSCTL_OFF + 320, LDS_BYTES = 163840;
constexpr int TAB_OFF = LDSCTL_OFF;

#define GAS __attribute__((address_space(1)))
#define LAS __attribute__((address_space(3)))
typedef unsigned short bf16_t;
typedef unsigned v4u __attribute__((ext_vector_type(4)));
typedef unsigned v2u __attribute__((ext_vector_type(2)));
typedef float f32x4 __attribute__((ext_vector_type(4)));
typedef short bf16x8 __attribute__((ext_vector_type(8)));
typedef GAS unsigned gu32;
#define RLX_AGENT __ATOMIC_RELAXED, __HIP_MEMORY_SCOPE_AGENT
#define LDS_WAIT() asm volatile("s_waitcnt lgkmcnt(0)" ::: "memory")
#define VM_WAIT() asm volatile("s_waitcnt vmcnt(0)" ::: "memory")
__device__ __forceinline__ unsigned f2bf(float f) { unsigned u = __builtin_bit_cast(unsigned, f); return (u + 0x7fffu + ((u >> 16) & 1u)) >> 16; }
typedef float f32x2_t __attribute__((ext_vector_type(2))); typedef __bf16 bf16x2_t __attribute__((ext_vector_type(2)));
__device__ __forceinline__ unsigned pk2(float lo, float hi) { f32x2_t v = {lo, hi}; bf16x2_t b = __builtin_convertvector(v, bf16x2_t); return __builtin_bit_cast(unsigned, b); }
__device__ __forceinline__ float bf2f(unsigned short v) { return __uint_as_float(((unsigned)v) << 16); }
__device__ __forceinline__ float bflo(unsigned w) { return __uint_as_float(w << 16); }
__device__ __forceinline__ float bfhi(unsigned w) { return __uint_as_float(w & 0xffff0000u); }
__device__ __forceinline__ float sigmoid_(float x) { return __builtin_amdgcn_rcpf(1.0f + __expf(-x)); }
__device__ __forceinline__ float silu_(float x) { return x / (1.0f + __expf(-x)); }
__device__ __forceinline__ int pk_fp8x4(f32x4 v, float sc) { v = v * sc;
    const float a = __builtin_amdgcn_fmed3f(v.x, -448.f, 448.f), b = __builtin_amdgcn_fmed3f(v.y, -448.f, 448.f), c = __builtin_amdgcn_fmed3f(v.z, -448.f, 448.f), d = __builtin_amdgcn_fmed3f(v.w, -448.f, 448.f);
    int w = __builtin_amdgcn_cvt_pk_fp8_f32(a, b, 0, false); return __builtin_amdgcn_cvt_pk_fp8_f32(c, d, w, true); }
__device__ __forceinline__ float silu_fast2(float x) { return x * __builtin_amdgcn_rcpf(1.0f + __expf(-x)); }
__device__ __forceinline__ float log1p_fast(float e) { return e < 0.06f ? e * (1.0f - e * (0.5f - e * (0.33333333f - e * 0.25f))) : __logf(1.0f + e); }
__device__ __forceinline__ float softplus_(float x) { return fmaxf(x, 0.f) + log1p_fast(__expf(-fabsf(x))); }
__device__ __forceinline__ float gelu_tanh_(float x) { const float u = 0.7978845608028654f * (x + 0.044715f * x * x * x); return 0.5f * x * (1.0f + tanhf(u)); }
#define XB_TMO      128
#define XB_XCNT(j)  (256  + 64 * (j))
#define XB_XSUB(j)  (1280 + 64 * (j))
#define XB_XGEN(j)  (2304 + 64 * (j))
#define XB_TOP      3328
#define XB_TOPGEN   3392
#define XCD_BAR_WORDS 3456
#define XB_SPIN_CAP (1u << 18)

__device__ __forceinline__ unsigned xb_ld(unsigned* p)              { return __hip_atomic_load(p, __ATOMIC_RELAXED, __HIP_MEMORY_SCOPE_AGENT); }
__device__ __forceinline__ unsigned xb_add(unsigned* p, unsigned v) { return __hip_atomic_fetch_add(p, v, __ATOMIC_RELAXED, __HIP_MEMORY_SCOPE_AGENT); }
__device__ __forceinline__ unsigned xb_xcc_id() { return (unsigned)__builtin_amdgcn_s_getreg((3 << 11) | 20) & 0xFu; }
#define XB_SPIN(cond, bar) do { unsigned _sp = 0; while (cond) { __builtin_amdgcn_s_sleep(1); \
    if ((++_sp & 255u) == 0u) { if (xb_ld(&(bar)[XB_TMO])) break; if (_sp > XB_SPIN_CAP) { atomicAdd(&(bar)[XB_TMO], 1u); break; } } } } while (0)

struct XcdBarrier {
    unsigned* bar; unsigned x;
    volatile LAS unsigned* st;
};

__device__ __forceinline__ XcdBarrier xcd_barrier_post(unsigned* bar, volatile LAS unsigned* st, int tid) {
    XcdBarrier b; b.bar = bar; b.x = xb_xcc_id(); b.st = st;
    if (tid == 0) (void)xb_add(&bar[XB_XCNT(b.x)], 1u);
    return b;
}
__device__ __forceinline__ void xcd_barrier_complete(unsigned* bar, unsigned x, unsigned& nloc, unsigned& nx) {
    const unsigned G = gridDim.x * gridDim.y * gridDim.z;
    unsigned sum, cnt, mine, sp = 0u;
    for (;;) {
        sum = 0u; cnt = 0u; mine = 0u;
#pragma unroll
        for (unsigned j = 0; j < 16; ++j) { const unsigned c = xb_ld(&bar[XB_XCNT(j)]); sum += c; cnt += (c > 0u) ? 1u : 0u; mine = (j == x) ? c : mine; }
        if (sum == G) break;
        __builtin_amdgcn_s_sleep(1);
        if ((++sp & 255u) == 0u) { if (xb_ld(&bar[XB_TMO])) break; if (sp > XB_SPIN_CAP) { atomicAdd(&bar[XB_TMO], 1u); break; } }
    }
    nloc = mine > 0u ? mine : 1u; nx = cnt > 0u ? cnt : 1u;
}

__device__ __forceinline__ void xcd_barrier(const XcdBarrier& b, int tid) {
    asm volatile("s_waitcnt vmcnt(0)" ::: "memory");
    __syncthreads();
    if (tid == 0) {
        unsigned* bar = b.bar;
        __builtin_amdgcn_s_waitcnt(0);
        unsigned nloc = b.st[0], nx = b.st[1];
        if (nloc == 0u) { xcd_barrier_complete(bar, b.x, nloc, nx); b.st[0] = nloc; b.st[1] = nx; }
        const unsigned old = xb_add(&bar[XB_XSUB(b.x)], 1u);
        const unsigned gen = old / nloc;
        if (old + 1u == (gen + 1u) * nloc) {
            __builtin_amdgcn_fence(__ATOMIC_RELEASE, "agent");
            asm volatile("s_waitcnt vmcnt(0)" ::: "memory");
            const unsigned og = xb_add(&bar[XB_TOP], 1u);
            const unsigned tg = og / nx;
            if (og + 1u == (tg + 1u) * nx) xb_add(&bar[XB_TOPGEN], 1u);
            else XB_SPIN(xb_ld(&bar[XB_TOPGEN]) == tg, bar);
            __builtin_amdgcn_fence(__ATOMIC_ACQUIRE, "agent");
            xb_add(&bar[XB_XGEN(b.x)], 1u);
            asm volatile("s_waitcnt vmcnt(0)" ::: "memory");
        } else {
            XB_SPIN(xb_ld(&bar[XB_XGEN(b.x)]) == gen, bar);
            __builtin_amdgcn_fence(__ATOMIC_ACQUIRE, "agent");
            asm volatile("s_waitcnt vmcnt(0)" ::: "memory");
        }
    }
    __syncthreads();
}
namespace fox {
using bf16 = unsigned short;
constexpr int D = 128, QPITCH = 5376, KVPITCH = 5376, OPITCH = 2048;
constexpr bool WSKIP = false;
constexpr float THR = 8.f;
constexpr float SCALE = 0.08838834764831845f;
constexpr int NW = 8, QBLK = 32, KVBLK = 64, QB = NW * QBLK;
constexpr int SHM_V = KVBLK * D * 2, SHM_K = KVBLK * D * 2;
constexpr int ATT_LDS = 2 * SHM_V + 2 * SHM_K + NW * 64 * 4;
constexpr int FB_OFF = ATT_LDS;
constexpr int ATT_LDS_TOTAL = FB_OFF + 4096 * 8;
typedef short bf16x8 __attribute__((ext_vector_type(8)));
typedef short s16x4 __attribute__((ext_vector_type(4)));
typedef float f32x16 __attribute__((ext_vector_type(16)));
typedef float f32x4 __attribute__((ext_vector_type(4)));
typedef unsigned u32x4 __attribute__((ext_vector_type(4)));
template <class A, class Bt> struct same_t { static constexpr bool v = false; };
template <class A> struct same_t<A, A> { static constexpr bool v = true; };

#define KSWZ(row, colB) ((row) * 256 + ((colB) ^ (((row) & 7) << 4)))
#define SBAR() __builtin_amdgcn_sched_barrier(0)
__device__ __forceinline__ int v_st(int k, int c) { const int kk = (k & ~0xC) | ((k & 4) << 1) | ((k & 8) >> 1); return ((kk >> 3) * 4 + (c >> 5)) * 512 + ((kk & 7) * 32 + (c & 31)) * 2; }
__device__ __forceinline__ int v_rd_base(int lane) { return ((lane & 3) << 3) | (((lane >> 2) & 3) << 6) | (((lane >> 4) & 1) << 5) | (((lane >> 5) & 1) << 8); }
constexpr int v_rd_off(int d0, int ks, int half) { return d0 * 512 + ks * 4096 + half * 2048; }
__device__ __forceinline__ int crow(int r, int hi) { return (r & 3) + 8 * (r >> 2) + 4 * hi; }
__device__ __forceinline__ unsigned cvtpk(float lo, float hi) {
    unsigned r; asm volatile("v_cvt_pk_bf16_f32 %0, %1, %2" : "=v"(r) : "v"(lo), "v"(hi)); return r;
}
__device__ __forceinline__ bf16x8 pack8(f32x4 a, f32x4 b) {
    u32x4 w = {cvtpk(a[0], a[1]), cvtpk(a[2], a[3]), cvtpk(b[0], b[1]), cvtpk(b[2], b[3])};
    return *reinterpret_cast<bf16x8*>(&w);
}
template <class T> __device__ __forceinline__ bf16x8 load8(const T* p) {
    if constexpr (same_t<T, float>::v) { return pack8(*(const f32x4*)p, *(const f32x4*)(p + 4)); }
    else { return *reinterpret_cast<const bf16x8*>(p); }
}
__device__ __forceinline__ void mask_tile(f32x16& p0, f32x16& p1, int dq, unsigned W) {
    const float NEG = -__builtin_inff();
#pragma unroll
    for (int r = 0; r < 16; ++r) {
        const int c = (r & 3) + 8 * (r >> 2);
        if ((unsigned)(dq - c) >= W) p0[r] = NEG;
        if ((unsigned)(dq - c - 32) >= W) p1[r] = NEG;
    }
}
__device__ __forceinline__ void partialSM(f32x16& p0, f32x16& p1, float& m_reg, float& mn, float& alpha) {
    float pmax = p0[0]; for (int r = 1; r < 16; ++r) pmax = fmaxf(pmax, p0[r]); for (int r = 0; r < 16; ++r) pmax = fmaxf(pmax, p1[r]);
    { auto rr = __builtin_amdgcn_permlane32_swap(__float_as_uint(pmax), __float_as_uint(pmax), false, false);
      pmax = fmaxf(__uint_as_float(rr[0]), __uint_as_float(rr[1])); }
    constexpr float C2 = 1.4426950408889634f * SCALE;
    if (__builtin_expect(__all((pmax - m_reg) * SCALE <= THR), 1)) { mn = m_reg; alpha = 1.f; }
    else { mn = fmaxf(m_reg, pmax); alpha = __builtin_amdgcn_exp2f((m_reg - mn) * C2); m_reg = mn; }
    const float mnL = -mn * C2;
    for (int r = 0; r < 16; ++r) p0[r] = fmaf(p0[r], C2, mnL); for (int r = 0; r < 16; ++r) p1[r] = fmaf(p1[r], C2, mnL);
    for (int r = 0; r < 16; ++r) p0[r] = __builtin_amdgcn_exp2f(p0[r]);
}
__device__ __forceinline__ void finishSM(f32x16& p0, f32x16& p1, float alpha, float& l_reg, bf16x8& pa0, bf16x8& pa1, bf16x8& pa2, bf16x8& pa3) {
    for (int r = 0; r < 16; ++r) p1[r] = __builtin_amdgcn_exp2f(p1[r]);
    float ps = 0; for (int r = 0; r < 16; ++r) ps += p0[r]; for (int r = 0; r < 16; ++r) ps += p1[r];
    { auto rr = __builtin_amdgcn_permlane32_swap(__float_as_uint(ps), __float_as_uint(ps), false, false);
      ps = __uint_as_float(rr[0]) + __uint_as_float(rr[1]); }
    l_reg = l_reg * alpha + ps;
#define PK4(P, B_, OUT) do { unsigned a0 = cvtpk(P[B_+0], P[B_+1]), a1 = cvtpk(P[B_+2], P[B_+3]);                          \
        unsigned b0 = cvtpk(P[B_+4], P[B_+5]), b1 = cvtpk(P[B_+6], P[B_+7]);                                             \
        auto r0 = __builtin_amdgcn_permlane32_swap(a0, b0, false, false); auto r1 = __builtin_amdgcn_permlane32_swap(a1, b1, false, false); \
        u32x4 w = {r0[0], r1[0], r0[1], r1[1]}; OUT = *reinterpret_cast<bf16x8*>(&w); } while (0)
    PK4(p0, 0, pa0); PK4(p0, 8, pa1); PK4(p1, 0, pa2); PK4(p1, 8, pa3);
#undef PK4
}
template <int KB, bool SK>
__device__ __forceinline__ void qkt(f32x16& p0, f32x16& p1, const char* K_lds, int r32, int hi, const bf16x8* qr, bool act, const char* fbp) {
    if (SK && !act) { const float NEG = -__builtin_inff();
#pragma unroll
        for (int r = 0; r < 16; ++r) { p0[r] = NEG; p1[r] = NEG; } return; }
    p0 = f32x16{}; p1 = f32x16{};
    const char* kb[4];
#pragma unroll
    for (int dd = 0; dd < 4; ++dd) kb[dd] = K_lds + KB * SHM_K + KSWZ(r32, (dd * 16 + hi * 8) * 2);
#pragma unroll
    for (int d0 = 0; d0 < 8; ++d0) { const char* a = kb[d0 & 3] + (d0 >> 2) * 128;
        bf16x8 b0 = *reinterpret_cast<const bf16x8*>(a);
        bf16x8 b1 = *reinterpret_cast<const bf16x8*>(a + 32 * 256);
        p0 = __builtin_amdgcn_mfma_f32_32x32x16_bf16(b0, qr[d0], p0, 0, 0, 0);
        p1 = __builtin_amdgcn_mfma_f32_32x32x16_bf16(b1, qr[d0], p1, 0, 0, 0); }
#ifndef FOX_NO_BIAS
    { typedef unsigned u32x2 __attribute__((ext_vector_type(2)));
      const u32x2 f0 = *reinterpret_cast<const u32x2*>(fbp), f1 = *reinterpret_cast<const u32x2*>(fbp + 32 * 8);
      const unsigned m = hi ? 0u : 0xffffffffu;
      u32x4 a0 = {f0.x & m, f0.y & m, 0u, 0u}, a1 = {f1.x & m, f1.y & m, 0u, 0u}; u32x4 qa = {0x3f803f80u, 0x00003f80u, 0u, 0u};
      p0 = __builtin_amdgcn_mfma_f32_32x32x16_bf16(*reinterpret_cast<bf16x8*>(&a0), *reinterpret_cast<bf16x8*>(&qa), p0, 0, 0, 0);
      p1 = __builtin_amdgcn_mfma_f32_32x32x16_bf16(*reinterpret_cast<bf16x8*>(&a1), *reinterpret_cast<bf16x8*>(&qa), p1, 0, 0, 0); }
#endif
}
template <int VB, bool SK>
__device__ __forceinline__ void pv_tile(f32x16* o, int vb0, bf16x8 pa0, bf16x8 pa1, bf16x8 pa2, bf16x8 pa3, bool act) {
    if (SK && !act) return;
#define TRRD(dst, off) asm volatile("ds_read_b64_tr_b16 %0, %1 offset:%2" : "=&v"(dst) : "v"(vb0), "i"(off) : "memory")
#define PV_D0(d0) do { s16x4 l0, l1, l2, l3, h0, h1, h2, h3; constexpr int b_ = VB * SHM_V + v_rd_off(d0, 0, 0);     \
        TRRD(l0, b_); TRRD(h0, b_ + 2048); TRRD(l1, b_ + 4096); TRRD(h1, b_ + 6144); TRRD(l2, b_ + 8192); TRRD(h2, b_ + 10240); TRRD(l3, b_ + 12288); TRRD(h3, b_ + 14336); \
        asm volatile("s_waitcnt lgkmcnt(0)" ::: "memory"); SBAR();                 \
        o[d0] = __builtin_amdgcn_mfma_f32_32x32x16_bf16(pa0, (bf16x8){l0[0], l0[1], l0[2], l0[3], h0[0], h0[1], h0[2], h0[3]}, o[d0], 0, 0, 0);   \
        o[d0] = __builtin_amdgcn_mfma_f32_32x32x16_bf16(pa1, (bf16x8){l1[0], l1[1], l1[2], l1[3], h1[0], h1[1], h1[2], h1[3]}, o[d0], 0, 0, 0);   \
        o[d0] = __builtin_amdgcn_mfma_f32_32x32x16_bf16(pa2, (bf16x8){l2[0], l2[1], l2[2], l2[3], h2[0], h2[1], h2[2], h2[3]}, o[d0], 0, 0, 0);   \
        o[d0] = __builtin_amdgcn_mfma_f32_32x32x16_bf16(pa3, (bf16x8){l3[0], l3[1], l3[2], l3[3], h3[0], h3[1], h3[2], h3[3]}, o[d0], 0, 0, 0); } while (0)
    PV_D0(0); PV_D0(1); PV_D0(2); PV_D0(3);
#undef PV_D0
#undef TRRD
}

template <class TIn, class TOut> struct BlockRef { const TIn* Q; const TIn* K; const TIn* V; TOut* O; int P0; };
template <class TIn> struct Seam {
    bf16x8 qr[8];
    bf16x8 st_v0, st_v1, st_k0, st_k1; f32x4 sf0, sf1, sf2, sf3;
    f32x4 tq[16];
};
__device__ __forceinline__ int swa_jlo(int P0, int W) { const int lowk = P0 - W + 1; return lowk > 0 ? lowk / KVBLK : 0; }
#define ROW(p, k0, rr) ((p) + (size_t)((k0) + (rr)) * KVPITCH + sc)
#define VMW() asm volatile("s_waitcnt vmcnt(0)" ::: "memory")
#define VMWN(n) asm volatile("s_waitcnt vmcnt(%0)" :: "i"(n) : "memory")
#define SLOAD_H(Kp, Vp, k0) do { S.st_v0 = load8<TIn>(ROW(Vp, k0, sr)); S.st_v1 = load8<TIn>(ROW(Vp, k0, 32 + sr));              \
                         S.st_k0 = load8<TIn>(ROW(Kp, k0, sr)); S.st_k1 = load8<TIn>(ROW(Kp, k0, 32 + sr)); } while (0)
#define SWRITE_HK(bf) do { *(bf16x8*)(K_lds + (bf) * SHM_K + kws) = S.st_k0; *(bf16x8*)(K_lds + (bf) * SHM_K + kws + 32 * 256) = S.st_k1; } while (0)
#define SWRITE_HV(bf) do { *(bf16x8*)(V_lds + (bf) * SHM_V + vst0) = S.st_v0; *(bf16x8*)(V_lds + (bf) * SHM_V + vst1) = S.st_v1; } while (0)
#define SWRITE_H(bf) do { SWRITE_HV(bf); SWRITE_HK(bf); } while (0)
#define SLOAD_F(p, k0) do { S.sf0 = *(const f32x4*)ROW(p, k0, sr); S.sf1 = *(const f32x4*)(ROW(p, k0, sr) + 4);                \
                            S.sf2 = *(const f32x4*)ROW(p, k0, 32 + sr); S.sf3 = *(const f32x4*)(ROW(p, k0, 32 + sr) + 4); } while (0)
#define SWRITE_KF(bf) do { *(bf16x8*)(K_lds + (bf) * SHM_K + kws) = pack8(S.sf0, S.sf1); *(bf16x8*)(K_lds + (bf) * SHM_K + kws + 32 * 256) = pack8(S.sf2, S.sf3); } while (0)
#define SWRITE_VF(bf) do { *(bf16x8*)(V_lds + (bf) * SHM_V + vst0) = pack8(S.sf0, S.sf1); *(bf16x8*)(V_lds + (bf) * SHM_V + vst1) = pack8(S.sf2, S.sf3); } while (0)
template <class TIn, class TOut>
__device__ __forceinline__ void causal_swa_prime(const BlockRef<TIn, TOut>& cur, int W, char* lds, Seam<TIn>& S, int tid_in) {
    constexpr bool F32 = same_t<TIn, float>::v;
    const int tid_ = fresh_tid(tid_in  ); const int tid = tid_, wid = __builtin_amdgcn_readfirstlane(tid >> 6), lane = tid & 63, r32 = lane & 31, hi = lane >> 5;
    const int sr = tid >> 4, sc = (tid & 15) * 8, kws = KSWZ(sr, sc * 2); char* K_lds = lds + 2 * SHM_V;
    const int kb0 = swa_jlo(cur.P0, W) * KVBLK;
    for (int d0 = 0; d0 < 8; ++d0) S.qr[d0] = load8<TIn>(cur.Q + (size_t)(wid * QBLK + r32) * QPITCH + d0 * 16 + hi * 8);
    if constexpr (F32) { SLOAD_F((const float*)cur.K, kb0); VMW(); SWRITE_KF(0); SBAR(); SLOAD_F((const float*)cur.V, kb0); }
    else { SLOAD_H(cur.K, cur.V, kb0); VMW(); SWRITE_HK(0); }
    __syncthreads();
}
template <class TIn, class TOut>
__device__ __forceinline__ void causal_swa_block(const BlockRef<TIn, TOut>& cur, const BlockRef<TIn, TOut>& nxt, int skv, int W, char* lds, Seam<TIn>& S, int tid_in) {
    constexpr bool F32 = same_t<TIn, float>::v;
    const int tid_ = fresh_tid(tid_in  ); const int tid = tid_, wid = __builtin_amdgcn_readfirstlane(tid >> 6), lane = tid & 63, r32 = lane & 31, hi = lane >> 5;
    const int j_lo = swa_jlo(cur.P0, W);
    int j_hi = (cur.P0 + QB - 1) / KVBLK + 1; if (j_hi > skv / KVBLK) j_hi = skv / KVBLK;
    const int NT = j_hi - j_lo;
    const int kbn = swa_jlo(nxt.P0, W) * KVBLK;
    const int qlo = cur.P0 + wid * QBLK, qm = qlo + r32 - 4 * hi;
    char* V_lds = lds; char* K_lds = lds + 2 * SHM_V; const char* fbl = lds + FB_OFF + r32 * 8;
    float* ws = (float*)(lds + 2 * SHM_V + 2 * SHM_K) + wid * 64; float* li_l = ws, * al_l = ws + 32;
    float m_reg = -1e30f, l_reg = 0; f32x16 o[4] = {};
    const int sr = tid >> 4, sc = (tid & 15) * 8, vst0 = v_st(sr, sc), vst1 = v_st(32 + sr, sc), kws = KSWZ(sr, sc * 2);
    const int vb0 = (int)(uintptr_t)V_lds + v_rd_base(lane);
    const TIn* Kh = cur.K; const TIn* Vh = cur.V;
#define RESC(a) do { if (__any((a) < 1.f)) { if (hi == 0) al_l[r32] = (a); asm volatile("s_waitcnt lgkmcnt(0)" ::: "memory");              \
                     for (int d_ = 0; d_ < 4; ++d_) for (int r = 0; r < 16; ++r) o[d_][r] *= al_l[crow(r, hi)]; } } while (0)
#define KBASE(t) ((j_lo + (t)) * KVBLK)
#define ACT(t) (KBASE(t) <= qlo + QBLK - 1 && KBASE(t) + KVBLK - 1 >= qlo - W + 1)
#define MASKT(P0_, P1_, t) do { const int kb_ = KBASE(t); if ((!SK || ACT(t)) && (kb_ + KVBLK - 1 > qlo || kb_ <= qlo + QBLK - 1 - W)) mask_tile(P0_, P1_, qm - kb_, (unsigned)W); } while (0)
    constexpr int NQL = F32 ? 16 : 8;
    constexpr bool SK = WSKIP && !F32;
#define SEAM_K0() do { VMWN(NQL); if constexpr (F32) { SWRITE_KF(0); SBAR(); SLOAD_F((const float*)nxt.V, kbn); } else { SWRITE_HK(0); } SBAR(); } while (0)
    f32x16 pA0, pA1, pB0, pB1; float mnA, mnB, alA, alB; bf16x8 pa0, pa1, pa2, pa3;
    if constexpr (F32) { VMW(); SWRITE_VF(0); SBAR(); } else { SWRITE_HV(0); SBAR(); }
    if (NT > 1) { if constexpr (F32) SLOAD_F((const float*)Kh, KBASE(1)); else SLOAD_H(Kh, Vh, KBASE(1)); }
    SBAR(); qkt<0, SK>(pA0, pA1, K_lds, r32, hi, S.qr, ACT(0), fbl + KBASE(0) * 8);
    if constexpr (F32) { if (NT > 1) { VMW(); SWRITE_KF(1); SBAR(); SLOAD_F((const float*)Vh, KBASE(1)); } }
    MASKT(pA0, pA1, 0); partialSM(pA0, pA1, m_reg, mnA, alA);
    if (NT > 1) { VMW(); if constexpr (F32) { SWRITE_VF(1); SBAR(); if (NT > 2) SLOAD_F((const float*)Kh, KBASE(2)); } else SWRITE_H(1); }
    __syncthreads();
#define HALF_STEP(PX0, PX1, mnX, alX, PY0, PY1, alY, t, KB, VB, SB) do {                                                      \
        SBAR(); qkt<KB, SK>(PX0, PX1, K_lds, r32, hi, S.qr, ACT(t), fbl + KBASE(t) * 8);                                             \
        finishSM(PY0, PY1, alY, l_reg, pa0, pa1, pa2, pa3); SBAR();                                                           \
        if ((t) + 1 < NT) { if constexpr (F32) { VMW(); SWRITE_KF(SB); SBAR(); SLOAD_F((const float*)Vh, KBASE((t) + 1)); }  \
                            else { SLOAD_H(Kh, Vh, KBASE((t) + 1)); } SBAR(); }                                               \
        pv_tile<VB, SK>(o, vb0, pa0, pa1, pa2, pa3, ACT((t) - 1)); MASKT(PX0, PX1, (t)); partialSM(PX0, PX1, m_reg, mnX, alX);                                        \
        __syncthreads();                                                                                                      \
        if ((t) + 1 < NT) { VMW(); if constexpr (F32) { SWRITE_VF(SB); SBAR(); if ((t) + 2 < NT) SLOAD_F((const float*)Kh, KBASE((t) + 2)); } \
                            else { SWRITE_H(SB); } }                                                                          \
        RESC(alX); __syncthreads(); } while (0)
    for (int t = 1; t + 1 < NT; t += 2) {
        HALF_STEP(pB0, pB1, mnB, alB, pA0, pA1, alA, t, 1, 0, 0);
        HALF_STEP(pA0, pA1, mnA, alA, pB0, pB1, alB, t + 1, 0, 1, 1);
    }
    const bool even = (NT & 1) == 0;
    if (even) { SBAR(); qkt<1, SK>(pB0, pB1, K_lds, r32, hi, S.qr, ACT(NT - 1), fbl + KBASE(NT - 1) * 8); SBAR(); }
#define QROW(e) (nxt.Q + (size_t)(wid * QBLK + r32) * QPITCH + ((e) >> 1) * 16 + hi * 8 + ((e) & 1) * 4)
    if constexpr (F32) { SLOAD_F((const float*)nxt.K, kbn); SBAR();
#pragma unroll
        for (int e = 0; e < 8; ++e) S.tq[e] = *(const f32x4*)QROW(e); }
    else { SLOAD_H(nxt.K, nxt.V, kbn); SBAR();
#pragma unroll
        for (int d0 = 0; d0 < 8; ++d0) S.qr[d0] = load8<TIn>(nxt.Q + (size_t)(wid * QBLK + r32) * QPITCH + d0 * 16 + hi * 8); }
    SBAR();
    finishSM(pA0, pA1, alA, l_reg, pa0, pa1, pa2, pa3); SBAR();
    if constexpr (F32) {
#pragma unroll
        for (int e = 8; e < 16; ++e) S.tq[e] = *(const f32x4*)QROW(e); SBAR(); }
#undef QROW
    pv_tile<0, SK>(o, vb0, pa0, pa1, pa2, pa3, ACT(even ? NT - 2 : NT - 1));
    if (even) { MASKT(pB0, pB1, NT - 1); partialSM(pB0, pB1, m_reg, mnB, alB); __syncthreads(); RESC(alB);
        finishSM(pB0, pB1, alB, l_reg, pa0, pa1, pa2, pa3); SBAR(); pv_tile<1, SK>(o, vb0, pa0, pa1, pa2, pa3, ACT(NT - 1)); }
    SBAR(); SEAM_K0();
    if (hi == 0) li_l[r32] = l_reg; asm volatile("s_waitcnt lgkmcnt(0)" ::: "memory");
    float rli[16];
#pragma unroll
    for (int r = 0; r < 16; ++r) rli[r] = __builtin_amdgcn_rcpf(li_l[crow(r, hi)]);
    TOut* Ow = cur.O + (size_t)(wid * QBLK) * OPITCH;
#pragma unroll
    for (int r = 0; r < 16; ++r) { const int orow = crow(r, hi);
#pragma unroll
        for (int d0 = 0; d0 < 4; ++d0) { const float v = o[d0][r] * rli[r];
            if constexpr (same_t<TOut, float>::v) { Ow[(size_t)orow * OPITCH + d0 * 32 + r32] = v; }
            else { const float vn = shfl_xor_l(v, 1, lane);
                   if ((r32 & 1) == 0) { if (F8_HY_OUT) *(unsigned short*)((unsigned char*)cur.O + (size_t)(wid * QBLK + orow) * OPITCH + d0 * 32 + r32) = (unsigned short)__builtin_amdgcn_cvt_pk_fp8_f32(__builtin_amdgcn_fmed3f(4.0f * v, -448.f, 448.f), __builtin_amdgcn_fmed3f(4.0f * vn, -448.f, 448.f), 0, false);
                                          else *(unsigned*)(Ow + (size_t)orow * OPITCH + d0 * 32 + r32) = cvtpk(v, vn); } } } }
    if constexpr (F32) {
#pragma unroll
        for (int d0 = 0; d0 < 8; ++d0) S.qr[d0] = pack8(S.tq[2 * d0], S.tq[2 * d0 + 1]); }
    __syncthreads();
#undef RESC
#undef KBASE
#undef ACT
#undef MASKT
#undef SEAM_K0
#undef HALF_STEP
}
#undef ROW
#undef VMW
#undef VMWN
#undef SLOAD_H
#undef SWRITE_HK
#undef SWRITE_HV
#undef SWRITE_H
#undef SLOAD_F
#undef SWRITE_KF
#undef SWRITE_VF

__device__ __forceinline__ void bias_table(char* lds, const float* fl  , float bf, int nkeys, int tid) {
    asm volatile("" : "+v"(tid));
    typedef unsigned u32x2 __attribute__((ext_vector_type(2)));
    float* wsum = (float*)(lds + FB_OFF + 4096 * 8); u32x2* FB = (u32x2*)(lds + FB_OFF);
    const int lane = tid & 63, wave = tid >> 6; float lf[8];
#pragma unroll
    for (int i = 0; i < 8; ++i) { const int s = 8 * tid + i; float v = 0.f;
        if (s < nkeys) { const float x = fl[(size_t)s * 8] + bf; const float e = __expf(-x); v = -(x < -20.f ? -x : (e < 0.06f ? e * (1.0f - e * (0.5f - e * (0.33333333f - e * 0.25f))) : __logf(1.0f + e))); }
        lf[i] = v; }
#pragma unroll
    for (int i = 1; i < 8; ++i) lf[i] += lf[i - 1];
    const float tot = lf[7]; float sc = tot;
#pragma unroll
    for (int o = 1; o < 64; o <<= 1) { const float u = shfl_up_l(sc, o, lane); if (lane >= o) sc += u; }
    if (lane == 63) wsum[wave] = sc;
    __syncthreads();
    float base = sc - tot;
    for (int w = 0; w < wave; ++w) base += wsum[w];
#pragma unroll
    for (int i = 0; i < 8; ++i) { const int s = 8 * tid + i; const float G = -(base + lf[i]) * (1.0f / SCALE);
        unsigned u = __float_as_uint(G); const unsigned h16 = (u + 0x7fffu + ((u >> 16) & 1u)) >> 16; const float r1 = G - __uint_as_float(h16 << 16);
        u = __float_as_uint(r1); const unsigned m16 = (u + 0x7fffu + ((u >> 16) & 1u)) >> 16; const float r2 = r1 - __uint_as_float(m16 << 16);
        u = __float_as_uint(r2); const unsigned l16 = (u + 0x7fffu + ((u >> 16) & 1u)) >> 16;
        FB[s] = (u32x2){h16 | (m16 << 16), l16}; }
    __syncthreads();
}
__device__ __forceinline__ void attn_item(char* lds, const unsigned short* PROJ, const float* FLB, unsigned short* YMIX, const float* b_f, int item, int tid) {
    const int bh = item >> 3, x = item & 7, b = bh >> 3, h = bh & 7;
    const unsigned short* base = PROJ + (size_t)b * 4096 * KVPITCH + h * 128;
    bias_table(lds, FLB + (size_t)b * 4096 * 8 + h, b_f[h], (16 - x) * QB, tid);
    typedef BlockRef<bf16, bf16> Ref;
    Ref r0, r1;
    r0.Q = base + 2048 + (size_t)(x * QB) * QPITCH; r0.K = base + 3072; r0.V = base + 4096; r0.O = F8_HY_OUT ? (unsigned short*)((unsigned char*)YMIX + ((size_t)b * 4096 + x * QB) * OPITCH + 1024 + h * 128) : YMIX + ((size_t)b * 4096 + x * QB) * OPITCH + 1024 + h * 128; r0.P0 = x * QB;
    r1 = r0; r1.Q = base + 2048 + (size_t)((15 - x) * QB) * QPITCH; r1.O = F8_HY_OUT ? (unsigned short*)((unsigned char*)YMIX + ((size_t)b * 4096 + (15 - x) * QB) * OPITCH + 1024 + h * 128) : YMIX + ((size_t)b * 4096 + (15 - x) * QB) * OPITCH + 1024 + h * 128; r1.P0 = (15 - x) * QB;
    Seam<bf16> S; const int wv = __builtin_amdgcn_readfirstlane(tid >> 6);
    causal_swa_prime<bf16, bf16>(r0, 4096, lds, S, wv);
    Ref cur = r0;
    for (int pass = 0; pass < 2; ++pass) {
        causal_swa_block<bf16, bf16>(cur, r1, 4096, 4096, lds, S, wv);
        cur = r1;
    }
    asm volatile("s_waitcnt vmcnt(0)" ::: "memory");
    __syncthreads();
}
}
struct Ctx {
    LAS unsigned char* lds;
    volatile LAS unsigned* MISC;
    gu32* ctl;
    int tid, lane, wave, vcu, G;
    const float* in[28];
    float* out; unsigned char* ws;
};
__device__ __forceinline__ float wave_max(float v) {
#pragma unroll
    for (int o = 1; o < 64; o <<= 1) v = fmaxf(v, __shfl_xor(v, o));
    return v;
}
__device__ __forceinline__ float wave_sum_dpp(float v) {
    v += __builtin_bit_cast(float, __builtin_amdgcn_update_dpp(0, __builtin_bit_cast(int, v), 0x111, 0xf, 0xf, true));
    v += __builtin_bit_cast(float, __builtin_amdgcn_update_dpp(0, __builtin_bit_cast(int, v), 0x112, 0xf, 0xf, true));
    v += __builtin_bit_cast(float, __builtin_amdgcn_update_dpp(0, __builtin_bit_cast(int, v), 0x114, 0xf, 0xf, true));
    v += __builtin_bit_cast(float, __builtin_amdgcn_update_dpp(0, __builtin_bit_cast(int, v), 0x118, 0xf, 0xf, true));
    v += __builtin_bit_cast(float, __builtin_amdgcn_update_dpp(0, __builtin_bit_cast(int, v), 0x142, 0xa, 0xf, false));
    v += __builtin_bit_cast(float, __builtin_amdgcn_update_dpp(0, __builtin_bit_cast(int, v), 0x143, 0xc, 0xf, false));
    return __builtin_bit_cast(float, __builtin_amdgcn_readlane(__builtin_bit_cast(int, v), 63));
}
__device__ __forceinline__ float wave_sum(float v, int lane) {
#pragma unroll
    for (int o = 1; o < 64; o <<= 1) v += shfl_xor_l(v, o, lane);
    return v;
}
__device__ __forceinline__ float wave_sum(float v) {
#pragma unroll
    for (int o = 1; o < 64; o <<= 1) v += __shfl_xor(v, o);
    return v;
}
struct CvtJob { const float* W; bf16_t* WT; int K, N, mode, row_off, nblk, item, f8; };
__device__ __forceinline__ void cvt_load(const CvtJob& j, int lane, f32x4 (&v)[8]) {
    const int kb = j.item / j.nblk, nb = j.item - kb * j.nblk, k0 = 64 * kb, n0 = 32 * nb;
    const int c4 = (lane & 7) * 4, nn = n0 + c4; const bool ok = nn < j.N;
#pragma unroll
    for (int i = 0; i < 8; ++i) { const int kk = 8 * i + (lane >> 3); v[i] = ok ? __builtin_nontemporal_load((const GAS f32x4*)(j.W + (size_t)(k0 + kk) * j.N + nn)) : (f32x4){0.f, 0.f, 0.f, 0.f}; }
}
__device__ __forceinline__ void cvt_finish(const CvtJob& j, const f32x4 (&v)[8], LAS float* scr, int lane) {
    const int kb = j.item / j.nblk, nb = j.item - kb * j.nblk, k0 = 64 * kb, n0 = 32 * nb; const int c4 = (lane & 7) * 4;
#pragma unroll
    for (int i = 0; i < 8; ++i) { const int kk = 8 * i + (lane >> 3); LAS float* d = scr + kk * 33 + c4; d[0] = v[i].x; d[1] = v[i].y; d[2] = v[i].z; d[3] = v[i].w; }
    LDS_WAIT(); asm volatile("" ::: "memory");
    if (j.f8) {
        const int n = lane >> 1, hf = lane & 1; const LAS float* sp = scr + (32 * hf) * 33 + n; v4u o[2];
#pragma unroll
        for (int q = 0; q < 8; ++q) { int w = __builtin_amdgcn_cvt_pk_fp8_f32(__builtin_amdgcn_fmed3f(sp[(4 * q) * 33] * 128.0f, -448.f, 448.f), __builtin_amdgcn_fmed3f(sp[(4 * q + 1) * 33] * 128.0f, -448.f, 448.f), 0, false);
            w = __builtin_amdgcn_cvt_pk_fp8_f32(__builtin_amdgcn_fmed3f(sp[(4 * q + 2) * 33] * 128.0f, -448.f, 448.f), __builtin_amdgcn_fmed3f(sp[(4 * q + 3) * 33] * 128.0f, -448.f, 448.f), w, true);
            o[q >> 2][q & 3] = (unsigned)w; }
        const int ns = n0 + n; const int drow = j.mode == 0 ? j.row_off + ns : ((ns >> 7) * 256 + (ns & 127) + (j.mode == 2 ? 128 : 0));
        GAS v4u* dst = (GAS v4u*)((unsigned char*)j.WT + (size_t)drow * j.K + k0 + 32 * hf); dst[0] = o[0]; dst[1] = o[1];
        LDS_WAIT(); asm volatile("" ::: "memory"); return; }
    const int c = lane & 7;
#pragma unroll
    for (int q = 0; q < 4; ++q) { const int n = (lane >> 3) + 8 * q; const LAS float* sp = scr + (8 * c) * 33 + n;
        v4u o; o.x = pk2(sp[0 * 33], sp[1 * 33]); o.y = pk2(sp[2 * 33], sp[3 * 33]); o.z = pk2(sp[4 * 33], sp[5 * 33]); o.w = pk2(sp[6 * 33], sp[7 * 33]);
        const int ns = n0 + n; const int drow = j.mode == 0 ? j.row_off + ns : ((ns >> 7) * 256 + (ns & 127) + (j.mode == 2 ? 128 : 0));
        *(GAS v4u*)(j.WT + (size_t)drow * j.K + k0 + 8 * c) = o; }
    LDS_WAIT(); asm volatile("" ::: "memory");
}
__device__ __forceinline__ void cvt_item(const float* W, int K, int N, bf16_t* WT, int mode, int row_off, LAS float* scr, int item, int nblk, int lane, int f8 = 0) {
    const CvtJob j{W, WT, K, N, mode, row_off, nblk, item, f8}; f32x4 v[8]; cvt_load(j, lane, v); cvt_finish(j, v, scr, lane);
}
constexpr int MOE_CVT_ITEMS = 48 * 1024;
__device__ __forceinline__ CvtJob moe_cvt_job(Ctx& F, int layer, int it) {
    unsigned char* WGU = F.ws + ((layer & 1) ? WS_WGU_B : WS_WGU); unsigned char* WD = F.ws + ((layer & 1) ? WS_WD_B : WS_WD);
    const float* wg = F.in[25] + (size_t)layer * 16 * 2048 * 1024; const float* wu = F.in[26] + (size_t)layer * 16 * 2048 * 1024; const float* wd = F.in[27] + (size_t)layer * 16 * 1024 * 2048;
    const int mat = it >> 10, r0 = it & 1023, E = mat / 3, which = mat - 3 * E;
    const int nblk_ = which == 2 ? 64 : 32, p_ = r0 >> 1, r = (2 * (p_ / nblk_) + (r0 & 1)) * nblk_ + (p_ % nblk_);
    if (which == 0) return CvtJob{wg + (size_t)E * 2048 * 1024, (bf16_t*)(WGU + (size_t)E * 2048 * 2048), 2048, 1024, 1, 0, 32, r, 1};
    if (which == 1) return CvtJob{wu + (size_t)E * 2048 * 1024, (bf16_t*)(WGU + (size_t)E * 2048 * 2048), 2048, 1024, 2, 0, 32, r, 1};
    return CvtJob{wd + (size_t)E * 1024 * 2048, (bf16_t*)(WD + (size_t)E * 2048 * 1024), 1024, 2048, 0, 0, 64, r, 1};
}
__device__ __forceinline__ void moe_cvt_pair(Ctx& F, int layer, int itA, int itB, LAS float* scr) {
    const bool hasB = itB < MOE_CVT_ITEMS; const CvtJob ja = moe_cvt_job(F, layer, itA), jb = moe_cvt_job(F, layer, hasB ? itB : itA);
    f32x4 va[8], vb[8]; cvt_load(ja, F.lane, va); cvt_load(jb, F.lane, vb);
    cvt_finish(ja, va, scr, F.lane); if (hasB) cvt_finish(jb, vb, scr, F.lane);
}
__device__ __forceinline__ void moe_cvt_item(Ctx& F, int layer, int it, LAS float* scr) { const CvtJob j = moe_cvt_job(F, layer, it); f32x4 v[8]; cvt_load(j, F.lane, v); cvt_finish(j, v, scr, F.lane); }
__device__ __forceinline__ int moe_ntiles(Ctx& F, int layer) { int acc = 0;
#pragma unroll
    for (int e = 0; e < 16; ++e) { const unsigned c = __hip_atomic_load((unsigned*)(F.ctl + CW_CNT + layer * 16 + e), RLX_AGENT); acc += (int)((c + 255u) >> 8); }
    return __builtin_amdgcn_readfirstlane(acc); }
__device__ __forceinline__ int moe_cvt_done(Ctx& F, int layer) {
    if (layer == 0) return 0;
    const int h = (int)__hip_atomic_load((unsigned*)(F.ctl + CW_CVTHEAD + layer * 64), RLX_AGENT); return __builtin_amdgcn_readfirstlane(h < MOE_CVT_ITEMS ? h : MOE_CVT_ITEMS);
}
__device__ __forceinline__ int moe_gemm_wgs(Ctx& F, int ntiles, bool has_next) {
    const int U = 8 * ntiles; if (!has_next || U == 0) return F.G;
    const int rounds = (U + F.G - 1) / F.G; return (U + rounds - 1) / rounds; }
__device__ __forceinline__ void moe_tail_convert(Ctx& F, int next_layer, int Gg, int which) {
    const int rem = Gg; if (rem >= F.G) return;
    F.tid = fresh_tid(F.wave); F.lane = F.tid & 63;
    unsigned* done = (unsigned*)(F.ctl + CW_DONE + ((next_layer - 1) * 2 + which) * 64); unsigned* head = (unsigned*)(F.ctl + CW_CVTHEAD + next_layer * 64);
    if ((int)blockIdx.x < rem) { if (F.tid == 0) (void)__hip_atomic_fetch_add(done, 1u, RLX_AGENT); return; }
    LAS float* scr = (LAS float*)(F.lds + RING_OFF + F.wave * 16384); volatile LAS int* slot = (volatile LAS int*)(F.lds + RING_OFF + 8 * 16384);
    for (;;) {
        if (F.tid == 0) { int c = -1; if ((int)__hip_atomic_load(done, RLX_AGENT) < rem) c = (int)__hip_atomic_fetch_add(head, 16u, RLX_AGENT); *slot = c; }
        __syncthreads();
        const int c = *slot;
        if (c < 0 || c >= MOE_CVT_ITEMS) break;
        moe_cvt_pair(F, next_layer, c + 2 * F.wave, c + 2 * F.wave + 1, scr);
        __syncthreads();
    }
}
__device__ __forceinline__ void s0_convert(Ctx& F, int layer) {
    LAS float* scr = (LAS float*)(F.lds + RING_OFF + F.wave * 16384);
    const int gw = F.vcu * NWAVES + F.wave, NGW = F.G * NWAVES;
    for (int it = moe_cvt_done(F, layer) + 2 * gw; it < MOE_CVT_ITEMS; it += 2 * NGW) moe_cvt_pair(F, layer, it, it + 1, scr);
    if (layer == 0) {
        constexpr int I_HI = 32 * (HY_NP / 32), I_HO = 32 * 64, I_SI = 32 * (SS_NP / 32), I_SO = 64 * 64, I_RI = 2 * 4;
        constexpr int NIT = 2 * I_HI + 2 * I_HO + 2 * I_SI + 2 * I_SO + 32 * I_RI;
        for (int it = gw; it < NIT; it += NGW) {
            int r = it;
            if (r < 2 * I_HI) { const int j = r / I_HI; r -= j * I_HI; const bool f8 = F8_HY_IN && (r % (HY_NP / 32)) * 32 < 5120;
                cvt_item(F.in[3] + (size_t)j * 2048 * HY_N, 2048, HY_N, f8 ? (bf16_t*)(F.ws + WS_WHYIN8 + (size_t)j * 5120 * 2048) : (bf16_t*)(F.ws + WS_WHYIN) + (size_t)j * HY_NP * 2048, 0, 0, scr, r, HY_NP / 32, F.lane, f8); continue; } r -= 2 * I_HI;
            if (r < 2 * I_HO) { const int j = r / I_HO; r -= j * I_HO; cvt_item(F.in[12] + (size_t)j * 2048 * 2048, 2048, 2048, F8_HY_OUT ? (bf16_t*)(F.ws + WS_WHYOUT + (size_t)j * 2048 * 2048) : (bf16_t*)(F.ws + WS_WHYOUT) + (size_t)j * 2048 * 2048, 0, 0, scr, r, 64, F.lane, F8_HY_OUT); continue; } r -= 2 * I_HO;
            if (r < 2 * I_SI) { const int j = r / I_SI; r -= j * I_SI; const bool f8 = F8_SS_IN && (r % (SS_NP / 32)) * 32 < 10240;
                cvt_item(F.in[13] + (size_t)j * 2048 * SS_N, 2048, SS_N, f8 ? (bf16_t*)(F.ws + WS_WSSIN8 + (size_t)j * 10240 * 2048) : (bf16_t*)(F.ws + WS_WSSIN) + (size_t)j * SS_NP * 2048, 0, 0, scr, r, SS_NP / 32, F.lane, f8); continue; } r -= 2 * I_SI;
            if (r < 2 * I_SO) { const int j = r / I_SO; r -= j * I_SO; cvt_item(F.in[20] + (size_t)j * 4096 * 2048, 4096, 2048, F8_SS_OUT ? (bf16_t*)(F.ws + WS_WSSOUT + (size_t)j * 2048 * 4096) : (bf16_t*)(F.ws + WS_WSSOUT) + (size_t)j * 2048 * 4096, 0, 0, scr, r, 64, F.lane, F8_SS_OUT); continue; } r -= 2 * I_SO;
            { const int m = r / I_RI; r -= m * I_RI; const int jh = m >> 1, which = m & 1;
              cvt_item((which ? F.in[8] : F.in[6]) + (size_t)jh * 128 * 128, 128, 128, (bf16_t*)(F.ws + WS_WRI) + (size_t)jh * 256 * 128, 0, which * 128, scr, r, 4, F.lane); }
        }
        { bf16_t* WH = (bf16_t*)(F.ws + WS_WRT); bf16_t* WL = WH + 4 * 32 * 2048;
          for (int i = blockIdx.x * NTHR + F.tid; i < 4 * 32 * 2048; i += F.G * NTHR) { const int k = i & 2047, n = (i >> 11) & 31, L = i >> 16;
              const float v = n < 4 ? F.in[21][((size_t)L * 2048 + k) * 4 + n] : n < 20 ? F.in[23][(((size_t)L * 4 + ((n - 4) >> 2)) * 2048 + k) * 4 + ((n - 4) & 3)] : 0.f;
              const unsigned h = f2bf(v); WH[i] = (bf16_t)h; WL[i] = (bf16_t)f2bf(v - __uint_as_float(h << 16)); } }
        { float* LK = (float*)(F.ws + WS_TOKPOS); for (int i = blockIdx.x * NTHR + F.tid; i < 2 * 1024; i += F.G * NTHR) LK[i] = -8.0f * softplus_(-F.in[10][i]); }
        const float* x = F.in[0]; bf16_t* XB = (bf16_t*)(F.ws + WS_XB);
        for (int m = gw; m < T; m += NGW) { const GAS f32x4* xr = (const GAS f32x4*)(x + (size_t)m * D) + F.lane; GAS v2u* o = (GAS v2u*)(XB + (size_t)m * D) + F.lane;
#pragma unroll
            for (int j = 0; j < 8; ++j) { const f32x4 v = xr[64 * j]; v2u w; w.x = pk2(v.x, v.y); w.y = pk2(v.z, v.w); o[64 * j] = w;
                ((GAS int*)(F.ws + WS_XIN8 + (size_t)m * D))[F.lane + 64 * j] = pk_fp8x4(v, 4.0f); } }
    }
}
template <bool DRY = false> __device__ __forceinline__ void ln1_router(Ctx& F, int layer) {
    const int tid = fresh_tid(F.wave);
    const int lane = tid & 63, wave = __builtin_amdgcn_readfirstlane(tid >> 6), fr = lane & 15, fq = lane >> 4;
    const float* xin = F.in[0]; bf16_t* XB = (bf16_t*)(F.ws + WS_XB); bf16_t* XBO = DRY ? (bf16_t*)(F.ws + WS_ARENA + 944 * MiB) : XB;
    const float* gam = F.in[1] + (size_t)(layer * 2) * D; const float* bet = F.in[2] + (size_t)(layer * 2) * D;
    const bf16_t* MB = (const bf16_t*)(F.ws + WS_MBUF);
    LAS unsigned char* XH = F.lds + RING_OFF; LAS unsigned char* XL = F.lds + RING_OFF + 65536;
    LAS float* PART = (LAS float*)(F.lds + RING_OFF);
    LAS float* LG = (LAS float*)(F.lds + RING_OFF + 131072);
    LAS int* hist = (LAS int*)(F.lds + MISC_OFF + 256); LAS int* hbase = hist + 16; LAS int* sE = hist + 32; LAS int* sI = sE + 128; LAS float* sW = (LAS float*)(sI + 128);
    if (tid < 16) hist[tid] = 0;
    LAS f32x4* GL = (LAS f32x4*)(F.lds + RING_OFF + 135168); LAS f32x4* BL = GL + 512;
    GL[tid] = ((const GAS f32x4*)gam)[tid]; BL[tid] = ((const GAS f32x4*)bet)[tid];
    __syncthreads();
    const bf16_t* WH = (const bf16_t*)(F.ws + WS_WRT) + (size_t)layer * 32 * 2048; const bf16_t* WL = WH + 4 * 32 * 2048;
    const int rbase = blockIdx.x * 64;
    const int nb_ = tid & 31; const float lbias = nb_ < 4 ? F.in[22][layer * 4 + nb_] : nb_ < 20 ? F.in[24][layer * 16 + nb_ - 4] : 0.f;
    v2u xh[2][8], mh[2][8];
#define LN1_LOAD(bt_) do { _Pragma("unroll") for (int rr_ = 0; rr_ < 2; ++rr_) { const int row_ = rbase + (bt_) * 16 + 2 * wave + rr_; \
        const GAS v2u* xb_ = (const GAS v2u*)(XB + (size_t)row_ * D) + lane; const GAS v2u* mr_ = (const GAS v2u*)(MB + (size_t)row_ * D) + lane; \
        _Pragma("unroll") for (int j_ = 0; j_ < 8; ++j_) { xh[rr_][j_] = xb_[64 * j_]; mh[rr_][j_] = __builtin_nontemporal_load(mr_ + 64 * j_); } } } while (0)
#define LN1_BAR() do { asm volatile("s_waitcnt lgkmcnt(0)" ::: "memory"); __builtin_amdgcn_s_barrier(); asm volatile("" ::: "memory"); } while (0)
    LN1_LOAD(0);
#pragma unroll 1
    for (int bt = 0; bt < 4; ++bt) {
        f32x4 v[2][8];
#pragma unroll
        for (int rr = 0; rr < 2; ++rr) { const int row = rbase + bt * 16 + 2 * wave + rr;
            {
#pragma unroll
                for (int j = 0; j < 8; ++j) { const v2u xw = xh[rr][j]; const v2u mw = mh[rr][j];
                    v[rr][j].x = ALPHA * bflo(xw.x) + bflo(mw.x); v[rr][j].y = ALPHA * bfhi(xw.x) + bfhi(mw.x); v[rr][j].z = ALPHA * bflo(xw.y) + bflo(mw.y); v[rr][j].w = ALPHA * bfhi(xw.y) + bfhi(mw.y); }
            } (void)row; }
#pragma unroll
        for (int rr = 0; rr < 2; ++rr) { const int lr = 2 * wave + rr, row = rbase + bt * 16 + lr; float s = 0.f;
#pragma unroll
            for (int j = 0; j < 8; ++j) s += (v[rr][j].x + v[rr][j].y) + (v[rr][j].z + v[rr][j].w);
            const float mean = wave_sum_dpp(s) * (1.f / D); float s2 = 0.f;
#pragma unroll
            for (int j = 0; j < 8; ++j) { v[rr][j] = v[rr][j] - mean; s2 += (v[rr][j].x * v[rr][j].x + v[rr][j].y * v[rr][j].y) + (v[rr][j].z * v[rr][j].z + v[rr][j].w * v[rr][j].w); }
            const float rstd = 1.f / sqrtf(wave_sum_dpp(s2) * (1.f / D) + LN_EPS);
            GAS v2u* bo = (GAS v2u*)(XBO + (size_t)row * D) + lane;
#pragma unroll
            for (int j = 0; j < 8; ++j) { const f32x4 gj = GL[lane + 64 * j], bj = BL[lane + 64 * j]; const f32x4 y = v[rr][j] * rstd * gj + bj;
                const unsigned h0 = f2bf(y.x), h1 = f2bf(y.y), h2 = f2bf(y.z), h3 = f2bf(y.w); v2u hw; hw.x = h0 | (h1 << 16); hw.y = h2 | (h3 << 16); bo[64 * j] = hw;
                ((GAS int*)(F.ws + WS_XB8 + (size_t)row * D))[lane + 64 * j] = pk_fp8x4(y, 4.0f);
                v2u lw; lw.x = pk2(y.x - __uint_as_float(h0 << 16), y.y - __uint_as_float(h1 << 16)); lw.y = pk2(y.z - __uint_as_float(h2 << 16), y.w - __uint_as_float(h3 << 16));
                const int cidx = (lane >> 1) + 32 * j; const int off = lr * 4096 + ((cidx ^ lr) << 4) + (lane & 1) * 8;
                *(LAS v2u*)(XH + off) = hw; *(LAS v2u*)(XL + off) = lw; } }
        LN1_BAR();
        f32x4 acc[2] = {(f32x4){0.f, 0.f, 0.f, 0.f}, (f32x4){0.f, 0.f, 0.f, 0.f}};
        int wofs = fr * 2048 + 256 * wave + 8 * fq; asm volatile("" : "+v"(wofs));
#pragma unroll
        for (int ks = 0; ks < 8; ++ks) { const int k0 = 256 * wave + 32 * ks + 8 * fq; const int off = fr * 4096 + ((((k0 >> 3)) ^ fr) << 4);
            const bf16x8 xh = *(const LAS bf16x8*)(XH + off), xl = *(const LAS bf16x8*)(XL + off);
#pragma unroll
            for (int nt = 0; nt < 2; ++nt) { const bf16x8 wh = *(const GAS bf16x8*)(WH + wofs + nt * 16 * 2048 + 32 * ks), wl = *(const GAS bf16x8*)(WL + wofs + nt * 16 * 2048 + 32 * ks);
                acc[nt] = __builtin_amdgcn_mfma_f32_16x16x32_bf16(wh, xh, acc[nt], 0, 0, 0);
                acc[nt] = __builtin_amdgcn_mfma_f32_16x16x32_bf16(wl, xh, acc[nt], 0, 0, 0);
                acc[nt] = __builtin_amdgcn_mfma_f32_16x16x32_bf16(wh, xl, acc[nt], 0, 0, 0); } }
        if (bt < 3) LN1_LOAD(bt + 1);
        LN1_BAR();
        *(LAS f32x4*)(PART + (wave * 16 + fr) * 32 + 4 * fq) = acc[0]; *(LAS f32x4*)(PART + (wave * 16 + fr) * 32 + 16 + 4 * fq) = acc[1];
        LN1_BAR();
        {
            const int r = tid >> 5, n = tid & 31; float a = 0.f;
#pragma unroll
            for (int w = 0; w < 8; ++w) a += PART[(w * 16 + r) * 32 + n];
            a += lbias;
            LG[r * 32 + n] = a; }
        LN1_BAR();
        if (tid < 16) {
            float lg[20];
#pragma unroll
            for (int n = 0; n < 20; ++n) lg[n] = LG[tid * 32 + n];
            int gi = 0; float lm = lg[0];
#pragma unroll
            for (int k = 1; k < 4; ++k) if (lg[k] > lm) { lm = lg[k]; gi = k; }
            float den = 0.f;
#pragma unroll
            for (int k = 0; k < 4; ++k) den += __expf(lg[k] - lm);
            const float pg = 1.0f / den; float l2[4];
#pragma unroll
            for (int e = 0; e < 4; ++e) l2[e] = gi == 0 ? lg[4 + e] : gi == 1 ? lg[8 + e] : gi == 2 ? lg[12 + e] : lg[16 + e];
            int e1 = 0; float v1 = l2[0];
#pragma unroll
            for (int e = 1; e < 4; ++e) if (l2[e] > v1) { v1 = l2[e]; e1 = e; }
            int e2 = -1; float v2 = 0.f;
#pragma unroll
            for (int e = 0; e < 4; ++e) if (e != e1 && (e2 < 0 || l2[e] > v2)) { v2 = l2[e]; e2 = e; }
            const float t = __expf(v2 - v1); const float p1 = 1.0f / (1.0f + t), p2 = t / (1.0f + t);
            const int E1 = gi * 4 + e1, E2 = gi * 4 + e2, it = bt * 16 + tid;
            const int i1 = __hip_atomic_fetch_add(&hist[E1], 1, __ATOMIC_RELAXED, __HIP_MEMORY_SCOPE_WORKGROUP); const int i2 = __hip_atomic_fetch_add(&hist[E2], 1, __ATOMIC_RELAXED, __HIP_MEMORY_SCOPE_WORKGROUP);
            sE[2 * it] = E1; sI[2 * it] = i1; sW[2 * it] = pg * p1; sE[2 * it + 1] = E2; sI[2 * it + 1] = i2; sW[2 * it + 1] = pg * p2;
        }
        LN1_BAR();
    }
    if (DRY) { __syncthreads(); return; }
    if (tid < 16) hbase[tid] = (int)__hip_atomic_fetch_add((unsigned*)(F.ctl + CW_CNT + layer * 16 + tid), (unsigned)hist[tid], RLX_AGENT);
    __syncthreads();
    int* TS = (int*)(F.ws + WS_TOKSLOT);
    if (tid < 128) { const int sl = tid; const int row = rbase + (sl >> 1); const int E = sE[sl];
        const int idx = hbase[E] + sI[sl];
        GAS v4u* dst = (GAS v4u*)(TS + (size_t)(row * 2 + (sl & 1)) * 4); v4u w; w.x = (unsigned)E; w.y = (unsigned)idx; w.z = __float_as_uint(sW[sl]); w.w = 0u; *dst = w;
        ((int*)(F.ws + WS_EXPTOK))[(size_t)E * T + idx] = row; ((float*)(F.ws + WS_EXPW))[(size_t)E * T + idx] = sW[sl]; }
    __syncthreads();
}
template <bool DRY = false> __device__ __forceinline__ void ln2_phase(Ctx& F, int layer) {
    const int tid = fresh_tid(F.wave); const int lane = tid & 63, wave = F.wave;
    const bool last = layer == DEPTH - 1; float* xout = DRY ? (float*)(F.ws + WS_ARENA + 1010 * MiB) : F.out; bf16_t* XB = (bf16_t*)(F.ws + WS_XB); bf16_t* XBO = DRY ? (bf16_t*)(F.ws + WS_ARENA + 944 * MiB) : XB;
    const float* gam = F.in[1] + (size_t)(layer * 2 + 1) * D; const float* bet = F.in[2] + (size_t)(layer * 2 + 1) * D;
    const bf16_t* YG = (const bf16_t*)(F.ws + WS_YG); const int* TOKPOS = (const int*)(F.ws + WS_TOKPOS);
    const int rbase = blockIdx.x * 64;
    LAS int* tabL = (LAS int*)(F.lds + RING_OFF); LAS f32x4* GL = (LAS f32x4*)(F.lds + RING_OFF + 256); LAS f32x4* BL = GL + 512;
    GL[tid] = ((const GAS f32x4*)gam)[tid]; BL[tid] = ((const GAS f32x4*)bet)[tid];
    if (tid == 0) { int acc = 0; for (int e = 0; e < 16; ++e) { const unsigned c = __hip_atomic_load((unsigned*)(F.ctl + CW_CNT + layer * 16 + e), RLX_AGENT); tabL[e] = acc; acc += (int)((c + 255u) >> 8); } }
    __syncthreads();
    int pos = 0; if (lane < 16) { const int* ts = (const int*)(F.ws + WS_TOKSLOT) + (size_t)((rbase + (lane >> 1) * 8 + wave) * 2 + (lane & 1)) * 4; pos = tabL[ts[0]] * 256 + ts[1]; }
#define LN2_LOAD(it_, XR, YA, YB) do { const int row_ = rbase + (it_) * 8 + wave; \
        const int p0_ = __builtin_amdgcn_readfirstlane(__builtin_amdgcn_ds_bpermute((2 * (it_)) << 2, pos)), p1_ = __builtin_amdgcn_readfirstlane(__builtin_amdgcn_ds_bpermute((2 * (it_) + 1) << 2, pos)); \
        const GAS v2u* xr_ = (const GAS v2u*)(XB + (size_t)row_ * D) + lane; const GAS v2u* y0_ = (const GAS v2u*)(YG + (size_t)p0_ * D) + lane; const GAS v2u* y1_ = (const GAS v2u*)(YG + (size_t)p1_ * D) + lane; \
        _Pragma("unroll") for (int j_ = 0; j_ < 8; ++j_) { XR[j_] = xr_[64 * j_]; YA[j_] = __builtin_nontemporal_load(y0_ + 64 * j_); YB[j_] = __builtin_nontemporal_load(y1_ + 64 * j_); } } while (0)
    v2u xa[8], ya[8], yb[8];
    LN2_LOAD(0, xa, ya, yb);
#pragma unroll 1
    for (int it = 0; it < 8; ++it) {
        v2u xn[8], yna[8], ynb[8];
        if (it < 7) LN2_LOAD(it + 1, xn, yna, ynb);
        const int row = rbase + it * 8 + wave; f32x4 v[8]; float s = 0.f;
#pragma unroll
        for (int j = 0; j < 8; ++j) { const v2u xw = xa[j]; const v2u a = ya[j], b = yb[j];
            v[j].x = ALPHA * bflo(xw.x) + (bflo(a.x) + bflo(b.x)); v[j].y = ALPHA * bfhi(xw.x) + (bfhi(a.x) + bfhi(b.x)); v[j].z = ALPHA * bflo(xw.y) + (bflo(a.y) + bflo(b.y)); v[j].w = ALPHA * bfhi(xw.y) + (bfhi(a.y) + bfhi(b.y));
            s += (v[j].x + v[j].y) + (v[j].z + v[j].w); }
        const float mean = wave_sum_dpp(s) * (1.f / D); float s2 = 0.f;
#pragma unroll
        for (int j = 0; j < 8; ++j) { v[j] = v[j] - mean; s2 += (v[j].x * v[j].x + v[j].y * v[j].y) + (v[j].z * v[j].z + v[j].w * v[j].w); }
        const float rstd = 1.f / sqrtf(wave_sum_dpp(s2) * (1.f / D) + LN_EPS);
        GAS f32x4* xo = (GAS f32x4*)(xout + (size_t)row * D) + lane; GAS v2u* bo = (GAS v2u*)(XBO + (size_t)row * D) + lane;
#pragma unroll
        for (int j = 0; j < 8; ++j) { const f32x4 gj = GL[lane + 64 * j], bj = BL[lane + 64 * j]; const f32x4 y = v[j] * rstd * gj + bj;
            if (last) xo[64 * j] = y; else { v2u w; w.x = pk2(y.x, y.y); w.y = pk2(y.z, y.w); bo[64 * j] = w; if (F8_HY_IN && (layer & 1)) ((GAS int*)(F.ws + WS_XIN8 + (size_t)row * D))[lane + 64 * j] = pk_fp8x4(y, 4.0f); } }
#pragma unroll
        for (int j = 0; j < 8; ++j) { xa[j] = xn[j]; ya[j] = yna[j]; yb[j] = ynb[j]; }
    }
#undef LN2_LOAD
}
__device__ __forceinline__ void moe_tables(Ctx& F, int layer, int (&tab)[17]) {
    int acc = 0;
#pragma unroll
    for (int e = 0; e < 16; ++e) { const unsigned c = __hip_atomic_load((unsigned*)(F.ctl + CW_CNT + layer * 16 + e), RLX_AGENT); tab[e] = __builtin_amdgcn_readfirstlane(acc); acc += (int)((c + 255u) >> 8); }
    tab[16] = __builtin_amdgcn_readfirstlane(acc);
}
typedef float f32x4_t __attribute__((ext_vector_type(4)));
__device__ __forceinline__ float gelu_tanh_fast(float x) { const float u = 1.5957691216057308f * (x + 0.044715f * x * x * x); return x * __builtin_amdgcn_rcpf(1.0f + __expf(-u)); }
__device__ __forceinline__ void lru_local_item(Ctx& F, int jl, int item, int& hd_lds) {
    const int tid = fresh_tid(F.wave);
    const int lane = tid & 63, wave = __builtin_amdgcn_readfirstlane(tid >> 6);
    const int hd = item & 7, c = (item >> 3) & 63, b = item >> 9; const int r0 = b * SEQ + c * 64;
    const bf16_t* PROJ = (const bf16_t*)(F.ws + WS_PROJ);
    LAS float* XCF = (LAS float*)(F.lds + RING_OFF); LAS float* AF = (LAS float*)(F.lds + RING_OFF + 32768);
    LAS unsigned char* XCB = F.lds + RING_OFF + 65536;
    LAS float* QS = (LAS float*)(F.lds + RING_OFF + 65536 + 17408);
    LAS unsigned char* WL = F.lds + RING_OFF + 87040;
    LAS float* PT = (LAS float*)(F.lds + RING_OFF + 87040 + 65536);
    if (hd != hd_lds) { const bf16_t* W = (const bf16_t*)(F.ws + WS_WRI) + (size_t)(jl * 8 + hd) * 256 * 128; const int row = tid >> 1, hf = tid & 1;
        const GAS v4u* src = (const GAS v4u*)(W + (size_t)row * 128 + hf * 64);
#pragma unroll
        for (int i = 0; i < 8; ++i) *(LAS v4u*)(WL + row * 256 + (((hf * 8 + i) ^ (row & 15)) << 4)) = src[i];
        for (int i = tid; i < 8 * 128; i += NTHR) { const int k = i >> 7, jj = i & 127, ch = hd * 128 + jj;
            PT[i] = k < 4 ? F.in[4][(size_t)jl * 4 * 1024 + k * 1024 + ch] : k == 4 ? F.in[5][(size_t)jl * 1024 + ch] : k == 5 ? F.in[7][(size_t)jl * 1024 + ch] : k == 6 ? F.in[9][(size_t)jl * 1024 + ch] : ((const float*)(F.ws + WS_TOKPOS))[(size_t)jl * 1024 + ch]; }
        hd_lds = hd; __syncthreads(); }
    { const int tok = tid >> 3, cg = (tid & 7) * 16, ch0 = hd * 128 + cg; const int s = c * 64 + tok;
      float acc[16];
#pragma unroll
      for (int i = 0; i < 4; ++i) { const f32x4_t v = *(const LAS f32x4_t*)(PT + 4 * 128 + cg + 4 * i); acc[4 * i] = v.x; acc[4 * i + 1] = v.y; acc[4 * i + 2] = v.z; acc[4 * i + 3] = v.w; }
#pragma unroll
      for (int k = 0; k < 4; ++k) { const int sp = s - 3 + k;
          if (sp >= 0) { const GAS v4u* xr = (const GAS v4u*)(PROJ + (size_t)(r0 + tok - 3 + k) * HY_NP + ch0); const v4u x0 = xr[0], x1 = xr[1];
              const unsigned xw[8] = {x0.x, x0.y, x0.z, x0.w, x1.x, x1.y, x1.z, x1.w};
#pragma unroll
              for (int i = 0; i < 4; ++i) { const f32x4_t w = *(const LAS f32x4_t*)(PT + k * 128 + cg + 4 * i);
                  acc[4 * i] += bflo(xw[2 * i]) * w.x; acc[4 * i + 1] += bfhi(xw[2 * i]) * w.y; acc[4 * i + 2] += bflo(xw[2 * i + 1]) * w.z; acc[4 * i + 3] += bfhi(xw[2 * i + 1]) * w.w; } } }
#pragma unroll
      for (int i = 0; i < 4; ++i) *(LAS f32x4_t*)(XCF + tok * 128 + cg + 4 * i) = (f32x4_t){acc[4 * i], acc[4 * i + 1], acc[4 * i + 2], acc[4 * i + 3]};
      v4u o0, o1; o0.x = pk2(acc[0], acc[1]); o0.y = pk2(acc[2], acc[3]); o0.z = pk2(acc[4], acc[5]); o0.w = pk2(acc[6], acc[7]);
      o1.x = pk2(acc[8], acc[9]); o1.y = pk2(acc[10], acc[11]); o1.z = pk2(acc[12], acc[13]); o1.w = pk2(acc[14], acc[15]);
      *(LAS v4u*)(XCB + tok * 272 + cg * 2) = o0; *(LAS v4u*)(XCB + tok * 272 + cg * 2 + 16) = o1; }
    asm volatile("s_waitcnt lgkmcnt(0)" ::: "memory"); __builtin_amdgcn_s_barrier(); asm volatile("" ::: "memory");
    { const int rt = wave & 3, chalf = wave >> 2, fr = lane & 15, fq = lane >> 4;
      f32x4_t ar[4], ai[4];
#pragma unroll
      for (int nt = 0; nt < 4; ++nt) { ar[nt] = (f32x4_t){0.f, 0.f, 0.f, 0.f}; ai[nt] = (f32x4_t){0.f, 0.f, 0.f, 0.f}; }
#pragma unroll
      for (int ks = 0; ks < 4; ++ks) {
          const bf16x8 xa = *(const LAS bf16x8*)(XCB + (16 * rt + fr) * 272 + (32 * ks + 8 * fq) * 2);
#pragma unroll
          for (int nt = 0; nt < 4; ++nt) {
              const bf16x8 wr = *(const LAS bf16x8*)(WL + (64 * chalf + 16 * nt + fr) * 256 + (((4 * ks + fq) ^ fr) << 4));
              const bf16x8 wi = *(const LAS bf16x8*)(WL + (128 + 64 * chalf + 16 * nt + fr) * 256 + (((4 * ks + fq) ^ fr) << 4));
              ar[nt] = __builtin_amdgcn_mfma_f32_16x16x32_bf16(wr, xa, ar[nt], 0, 0, 0);
              ai[nt] = __builtin_amdgcn_mfma_f32_16x16x32_bf16(wi, xa, ai[nt], 0, 0, 0); } }
      const int tok = 16 * rt + fr;
#pragma unroll
      for (int nt = 0; nt < 4; ++nt) { const int cl = 64 * chalf + 16 * nt + 4 * fq, chg = hd * 128 + cl;
          const f32x4_t br = *(const LAS f32x4_t*)(PT + 5 * 128 + cl), bi = *(const LAS f32x4_t*)(PT + 6 * 128 + cl), lm = *(const LAS f32x4_t*)(PT + 7 * 128 + cl);
          const f32x4_t xc = *(LAS f32x4_t*)(XCF + tok * 128 + cl); f32x4_t av, uv;
#pragma unroll
          for (int e = 0; e < 4; ++e) { const float r = sigmoid_(ar[nt][e] + br[e]), ig = sigmoid_(ai[nt][e] + bi[e]);
              const float la = r * lm[e]; const float a = __expf(la); const float x2 = 2.0f * la;
              const float om = x2 > -0.1f ? -x2 * (1.0f + x2 * (0.5f + x2 * (0.16666667f + x2 * 0.041666667f))) : 1.0f - a * a;
              av[e] = a; uv[e] = sqrtf(om) * (ig * xc[e]); }
          *(LAS f32x4_t*)(AF + tok * 128 + cl) = av; *(LAS f32x4_t*)(XCF + tok * 128 + cl) = uv; } }
    asm volatile("s_waitcnt lgkmcnt(0)" ::: "memory"); __builtin_amdgcn_s_barrier(); asm volatile("" ::: "memory");
    { const int ch = tid & 127, q = tid >> 7; float hl[16], pl[16]; float h = 0.f, p = 1.f;
#pragma unroll
      for (int i = 0; i < 16; ++i) { const float a = AF[(16 * q + i) * 128 + ch], u = XCF[(16 * q + i) * 128 + ch]; h = a * h + u; p *= a; hl[i] = h; pl[i] = p; }
      QS[(q * 128 + ch) * 2] = p; QS[(q * 128 + ch) * 2 + 1] = h;
      asm volatile("s_waitcnt lgkmcnt(0)" ::: "memory"); __builtin_amdgcn_s_barrier(); asm volatile("" ::: "memory");
      float carry = 0.f, cump = 1.f;
      for (int q2 = 0; q2 < q; ++q2) { const float pq = QS[(q2 * 128 + ch) * 2], hq = QS[(q2 * 128 + ch) * 2 + 1]; carry = pq * carry + hq; cump *= pq; }
      bf16_t* HL = (bf16_t*)(F.ws + WS_HLOC) + (size_t)(r0 + 16 * q) * 1024 + hd * 128 + ch; bf16_t* CA = (bf16_t*)(F.ws + WS_CUMA) + (size_t)(r0 + 16 * q) * 1024 + hd * 128 + ch;
#pragma unroll
      for (int i = 0; i < 16; ++i) { hl[i] += pl[i] * carry; pl[i] *= cump; HL[(size_t)i * 1024] = (bf16_t)f2bf(hl[i]); CA[(size_t)i * 1024] = (bf16_t)f2bf(pl[i]); }
      if (q == 3) { float* LS = (float*)(F.ws + WS_LSUM) + ((size_t)(b * 64 + c) * 1024 + hd * 128 + ch) * 2; LS[0] = pl[15]; LS[1] = hl[15]; } }
    asm volatile("s_waitcnt lgkmcnt(0)" ::: "memory"); __builtin_amdgcn_s_barrier(); asm volatile("" ::: "memory");
}
__device__ __forceinline__ void lru_fix_item(Ctx& F, int item) {
    const int tid = fresh_tid(F.wave);
    const int c = item & 63, b = item >> 6; const int ch = 2 * tid;
    const float* LS = (const float*)(F.ws + WS_LSUM) + ((size_t)(b * 64) * 1024 + ch) * 2;
    float c0 = 0.f, c1 = 0.f;
    { int c2 = 0;
      for (; c2 + 8 <= c; c2 += 8) { f32x4_t v[8];
#pragma unroll
          for (int i = 0; i < 8; ++i) v[i] = *(const GAS f32x4_t*)(LS + (size_t)(c2 + i) * 2048);
#pragma unroll
          for (int i = 0; i < 8; ++i) { c0 = v[i].x * c0 + v[i].y; c1 = v[i].z * c1 + v[i].w; } }
      for (; c2 < c; ++c2) { const f32x4_t v = *(const GAS f32x4_t*)(LS + (size_t)c2 * 2048); c0 = v.x * c0 + v.y; c1 = v.z * c1 + v.w; } }
    const int r0 = b * SEQ + c * 64;
    const bf16_t* HL = (const bf16_t*)(F.ws + WS_HLOC) + (size_t)r0 * 1024 + ch; const bf16_t* CA = (const bf16_t*)(F.ws + WS_CUMA) + (size_t)r0 * 1024 + ch;
    const bf16_t* G = (const bf16_t*)(F.ws + WS_PROJ) + (size_t)r0 * HY_NP + 1024 + ch; bf16_t* Y = (bf16_t*)(F.ws + WS_YMIX) + (size_t)r0 * 2048 + ch;
#pragma unroll 1
    for (int i0 = 0; i0 < 64; i0 += 8) {
        unsigned hv[8], cv[8], gw[8];
#pragma unroll
        for (int k = 0; k < 8; ++k) { hv[k] = __builtin_nontemporal_load((const GAS unsigned*)(HL + (size_t)(i0 + k) * 1024)); cv[k] = __builtin_nontemporal_load((const GAS unsigned*)(CA + (size_t)(i0 + k) * 1024)); gw[k] = *(const GAS unsigned*)(G + (size_t)(i0 + k) * HY_NP); }
#pragma unroll
        for (int k = 0; k < 8; ++k) { const float h0 = bflo(hv[k]) + bflo(cv[k]) * c0, h1 = bfhi(hv[k]) + bfhi(cv[k]) * c1;
            const float o0 = h0 * gelu_tanh_fast(bflo(gw[k])), o1 = h1 * gelu_tanh_fast(bfhi(gw[k]));
            if (F8_HY_OUT) *(GAS unsigned short*)(F.ws + WS_YMIX8 + (size_t)(r0 + i0 + k) * 2048 + ch) = (unsigned short)__builtin_amdgcn_cvt_pk_fp8_f32(__builtin_amdgcn_fmed3f(4.0f * o0, -448.f, 448.f), __builtin_amdgcn_fmed3f(4.0f * o1, -448.f, 448.f), 0, false);
            else *(GAS unsigned*)(Y + (size_t)(i0 + k) * 2048) = pk2(o0, o1); } }
}
constexpr int SSD_LP = 136;
template <int NT> __device__ __forceinline__ void ssd_conv_load(const bf16_t* P, int row0, int s0, v4u (&xw)[NT + 3][2]) {
#pragma unroll
    for (int r = 0; r < NT + 3; ++r) { const bool ok = s0 - 3 + r >= 0;
        const GAS v4u* xr = (const GAS v4u*)(P + (size_t)(ok ? row0 - 3 + r : row0) * SS_NP); xw[r][0] = xr[0]; xw[r][1] = xr[1]; }
}
template <int NT, int WS = 768> __device__ __forceinline__ void ssd_conv_math(const v4u (&xr)[NT + 3][2], int s0, const LAS float* wl, float (&o)[NT][16]) {
    unsigned xw[NT + 3][8];
#pragma unroll
    for (int r = 0; r < NT + 3; ++r) { const unsigned m = (r >= 3 || s0 - 3 + r >= 0) ? 0xffffffffu : 0u;
#pragma unroll
        for (int q = 0; q < 8; ++q) xw[r][q] = xr[r][q >> 2][q & 3] & m; }
#pragma unroll
    for (int i4 = 0; i4 < 4; ++i4) { const f32x4_t bv = *(const LAS f32x4_t*)(wl + 4 * WS + 4 * i4);
        f32x4_t w[4];
#pragma unroll
        for (int k = 0; k < 4; ++k) w[k] = *(const LAS f32x4_t*)(wl + k * WS + 4 * i4);
#pragma unroll
        for (int t = 0; t < NT; ++t) { float a0 = bv.x, a1 = bv.y, a2 = bv.z, a3 = bv.w;
#pragma unroll
            for (int k = 0; k < 4; ++k) { a0 += bflo(xw[t + k][2 * i4]) * w[k].x; a1 += bfhi(xw[t + k][2 * i4]) * w[k].y; a2 += bflo(xw[t + k][2 * i4 + 1]) * w[k].z; a3 += bfhi(xw[t + k][2 * i4 + 1]) * w[k].w; }
            o[t][4 * i4] = silu_fast2(a0); o[t][4 * i4 + 1] = silu_fast2(a1); o[t][4 * i4 + 2] = silu_fast2(a2); o[t][4 * i4 + 3] = silu_fast2(a3); } }
}
template <int NT, int WS = 768> __device__ __forceinline__ void ssd_conv_tok(const bf16_t* P, int row0, int s0, const LAS float* wl, float (&o)[NT][16]) {
    v4u xw[NT + 3][2]; ssd_conv_load<NT>(P, row0, s0, xw); ssd_conv_math<NT, WS>(xw, s0, wl, o);
}
__device__ __forceinline__ void ssd_load_convw(Ctx& F, int jl, int g, LAS float* WL, int tid) {
    const float* cw = F.in[14] + (size_t)jl * 4 * SSD_CONV; const float* cb = F.in[15] + (size_t)jl * SSD_CONV;
    for (int i = tid; i < 5 * 768; i += NTHR) { const int k = i / 768, jj = i - k * 768; const int ch = jj < 512 ? g * 512 + jj : jj < 640 ? 4096 + g * 128 + (jj - 512) : 5120 + g * 128 + (jj - 640);
        WL[i] = k < 4 ? cw[(size_t)k * SSD_CONV + ch] : cb[ch]; }
}
__device__ __forceinline__ void ssd_states_item(Ctx& F, int jl, int item, int& g_lds) {
    const int tid = fresh_tid(F.wave);
    const int lane = tid & 63, wave = __builtin_amdgcn_readfirstlane(tid >> 6), fr = lane & 15, fq = lane >> 4;
    const int g = item & 7, c = (item >> 3) & 31, b = item >> 8, bc = b * 32 + c, r0 = bc * 128, s0 = c * 128;
    const bf16_t* PROJ = (const bf16_t*)(F.ws + WS_PROJ);
    const float* cw = F.in[14] + (size_t)jl * 4 * SSD_CONV; const float* cb = F.in[15] + (size_t)jl * SSD_CONV;
    LAS unsigned char* BT = F.lds + RING_OFF; LAS unsigned char* XT0 = F.lds + RING_OFF + 34816; LAS float* DTL = (LAS float*)(F.lds + RING_OFF + 104448); LAS float* ACSL = DTL + 1024;
    LAS float* WL = (LAS float*)(F.lds + RING_OFF + 112640);
    if (g != g_lds) { ssd_load_convw(F, jl, g, WL, tid); g_lds = g; __syncthreads(); }
    {
        const int h = 8 * g + wave; const float A = -__expf(F.in[17][jl * 64 + h]), dtb = F.in[16][jl * 64 + h];
        const int l0 = 2 * lane;
        const float* DTR = (const float*)(F.ws + WS_DTB);
        const float d0 = softplus_(DTR[(size_t)(r0 + l0) * 64 + h] + dtb), d1 = softplus_(DTR[(size_t)(r0 + l0 + 1) * 64 + h] + dtb);
        float sc = (d0 + d1) * A;
#pragma unroll
        for (int o = 1; o < 64; o <<= 1) { const float u = shfl_up_l(sc, o, lane); if (lane >= o) sc += u; }
        const float a1 = sc, a0 = sc - d1 * A;
        DTL[l0 * 8 + wave] = d0; DTL[(l0 + 1) * 8 + wave] = d1; ACSL[l0 * 8 + wave] = a0; ACSL[(l0 + 1) * 8 + wave] = a1;
        float* DTB = (float*)(F.ws + WS_DTB); float* ACSB = (float*)(F.ws + WS_ACSB);
        DTB[(size_t)(r0 + l0) * 64 + h] = d0; DTB[(size_t)(r0 + l0 + 1) * 64 + h] = d1; ACSB[(size_t)(r0 + l0) * 64 + h] = a0; ACSB[(size_t)(r0 + l0 + 1) * 64 + h] = a1;
    }
    {
        const int lp = tid >> 3, cg = (tid & 7) * 16; float o[2][16];
        ssd_conv_tok<2>(PROJ + 8192 + g * 128 + cg, r0 + 2 * lp, s0 + 2 * lp, WL + 512 + cg, o);
#pragma unroll
        for (int i = 0; i < 16; ++i) *(LAS unsigned*)(BT + ((cg + i) * SSD_LP + 2 * lp) * 2) = pk2(o[0][i], o[1][i]);
#pragma unroll
        for (int t = 0; t < 2; ++t) { v4u w0, w1; w0.x = pk2(o[t][0], o[t][1]); w0.y = pk2(o[t][2], o[t][3]); w0.z = pk2(o[t][4], o[t][5]); w0.w = pk2(o[t][6], o[t][7]); w1.x = pk2(o[t][8], o[t][9]); w1.y = pk2(o[t][10], o[t][11]); w1.z = pk2(o[t][12], o[t][13]); w1.w = pk2(o[t][14], o[t][15]);
            GAS v4u* d = (GAS v4u*)((bf16_t*)(F.ws + WS_BS) + (size_t)(r0 + 2 * lp + t) * 1024 + g * 128 + cg); d[0] = w0; d[1] = w1; }
    }
    __syncthreads();
    v4u xwc[5][2];
    { const int hh = tid >> 8, t2 = tid & 255, lp = t2 >> 2, pg = (t2 & 3) * 16; ssd_conv_load<2>(PROJ + 4096 + (8 * g + hh) * 64 + pg, r0 + 2 * lp, s0 + 2 * lp, xwc); }
#pragma unroll 1
    for (int hp = 0; hp < 4; ++hp) {
        LAS unsigned char* XT = XT0 + (hp & 1) * 34816;
        {
            int tq = tid; asm volatile("" : "+v"(tq));
            const int hh = tq >> 8, t2 = tq & 255, lp = t2 >> 2, pg = (t2 & 3) * 16, e = 2 * hp + hh, h = 8 * g + e; float o[2][16];
            ssd_conv_math<2>(xwc, s0 + 2 * lp, WL + e * 64 + pg, o);
            __builtin_amdgcn_sched_barrier(0);
            { const int hn = hp < 3 ? h + 2 : h; ssd_conv_load<2>(PROJ + 4096 + hn * 64 + pg, r0 + 2 * lp, s0 + 2 * lp, xwc); }
            const float al = ACSL[127 * 8 + e]; const float f0 = DTL[(2 * lp) * 8 + e] * __expf(al - ACSL[(2 * lp) * 8 + e]), f1 = DTL[(2 * lp + 1) * 8 + e] * __expf(al - ACSL[(2 * lp + 1) * 8 + e]);
#pragma unroll
            for (int i = 0; i < 16; ++i) *(LAS unsigned*)(XT + hh * 17408 + ((pg + i) * SSD_LP + 2 * lp) * 2) = pk2(o[0][i] * f0, o[1][i] * f1);
#pragma unroll
            for (int t = 0; t < 2; ++t) { v4u w0, w1; w0.x = pk2(o[t][0], o[t][1]); w0.y = pk2(o[t][2], o[t][3]); w0.z = pk2(o[t][4], o[t][5]); w0.w = pk2(o[t][6], o[t][7]); w1.x = pk2(o[t][8], o[t][9]); w1.y = pk2(o[t][10], o[t][11]); w1.z = pk2(o[t][12], o[t][13]); w1.w = pk2(o[t][14], o[t][15]);
                GAS v4u* d = (GAS v4u*)((bf16_t*)(F.ws + WS_XS) + (size_t)(r0 + 2 * lp + t) * 4096 + h * 64 + pg); d[0] = w0; d[1] = w1; }
        }
        asm volatile("s_waitcnt lgkmcnt(0)" ::: "memory"); __builtin_amdgcn_s_barrier(); asm volatile("" ::: "memory");
        {
            int lq = lane; asm volatile("" : "+v"(lq)); const int fr = lq & 15, fq = lq >> 4;
            const int hh = wave >> 2, pt = wave & 3, h = 8 * g + 2 * hp + hh;
            f32x4_t acc[8];
#pragma unroll
            for (int nt = 0; nt < 8; ++nt) acc[nt] = (f32x4_t){0.f, 0.f, 0.f, 0.f};
#pragma unroll
            for (int ks = 0; ks < 4; ++ks) { bf16x8 xa = *(const LAS bf16x8*)(XT + hh * 17408 + ((16 * pt + fr) * SSD_LP + 32 * ks + 8 * fq) * 2), bb[8];
#pragma unroll
                for (int nt = 0; nt < 8; ++nt) bb[nt] = *(const LAS bf16x8*)(BT + ((16 * nt + fr) * SSD_LP + 32 * ks + 8 * fq) * 2);
                asm volatile("s_waitcnt lgkmcnt(0)" : "+v"(xa), "+v"(bb[0]), "+v"(bb[1]), "+v"(bb[2]), "+v"(bb[3]), "+v"(bb[4]), "+v"(bb[5]), "+v"(bb[6]), "+v"(bb[7]));
#pragma unroll
                for (int nt = 0; nt < 8; ++nt) acc[nt] = __builtin_amdgcn_mfma_f32_16x16x32_bf16(bb[nt], xa, acc[nt], 0, 0, 0); }
            bf16_t* ST = (bf16_t*)(F.ws + WS_STATES) + (((size_t)bc * 64 + h) * 64 + 16 * pt + fr) * 128 + 4 * fq;
#pragma unroll
            for (int nt = 0; nt < 8; ++nt) { v2u w; w.x = pk2(acc[nt][0], acc[nt][1]); w.y = pk2(acc[nt][2], acc[nt][3]); *(GAS v2u*)(ST + 16 * nt) = w; }
        }
    }
    __syncthreads();
}
__device__ __forceinline__ void ssd_scan_item(Ctx& F, int item) {
    const int tid = fresh_tid(F.wave);
    const int b = item >> 6, h = item & 63;
    bf16_t* ST = (bf16_t*)(F.ws + WS_STATES) + ((size_t)(b * 32) * 64 + h) * 8192 + 16 * tid; const float* ACSB = (const float*)(F.ws + WS_ACSB) + (size_t)(b * 32) * 128 * 64 + 127 * 64 + h;
    float s[16];
#pragma unroll
    for (int i = 0; i < 16; ++i) s[i] = 0.f;
#pragma unroll 1
    for (int c0 = 0; c0 < 32; c0 += 8) {
        v4u la[8], lb[8]; float dec[8];
#pragma unroll
        for (int k = 0; k < 8; ++k) { const GAS v4u* p = (const GAS v4u*)(ST + (size_t)(c0 + k) * 64 * 8192); la[k] = __builtin_nontemporal_load(p); lb[k] = __builtin_nontemporal_load(p + 1); dec[k] = ACSB[(size_t)(c0 + k) * 128 * 64]; }
#pragma unroll
        for (int k = 0; k < 8; ++k) { GAS v4u* p = (GAS v4u*)(ST + (size_t)(c0 + k) * 64 * 8192); const float d = __expf(dec[k]);
            const unsigned w[8] = {la[k].x, la[k].y, la[k].z, la[k].w, lb[k].x, lb[k].y, lb[k].z, lb[k].w}; v4u o0, o1;
            o0.x = pk2(s[0], s[1]); o0.y = pk2(s[2], s[3]); o0.z = pk2(s[4], s[5]); o0.w = pk2(s[6], s[7]); o1.x = pk2(s[8], s[9]); o1.y = pk2(s[10], s[11]); o1.z = pk2(s[12], s[13]); o1.w = pk2(s[14], s[15]);
            p[0] = o0; p[1] = o1;
#pragma unroll
            for (int i = 0; i < 8; ++i) { s[2 * i] = s[2 * i] * d + bflo(w[i]); s[2 * i + 1] = s[2 * i + 1] * d + bfhi(w[i]); } }
    }
}
__device__ __forceinline__ void ssd_y_item(Ctx& F, int jl, int item, int& g_lds) {
    const int tid = fresh_tid(F.wave);
    const int lane = tid & 63, wave = F.wave, fr = lane & 15, fq = lane >> 4;
    const int g = item & 7, c = (item >> 3) & 31, b = item >> 8, bc = b * 32 + c, r0 = bc * 128, s0 = c * 128;
    const bf16_t* PROJ = (const bf16_t*)(F.ws + WS_PROJ);
    const float* cw = F.in[14] + (size_t)jl * 4 * SSD_CONV; const float* cb = F.in[15] + (size_t)jl * SSD_CONV;
    LAS unsigned char* CT = F.lds + RING_OFF; LAS unsigned char* BN = F.lds + RING_OFF + 34816; LAS unsigned char* MT = BN;
    LAS unsigned char* XT = F.lds + RING_OFF + 69632;
    LAS unsigned char* PV = F.lds + RING_OFF + 104448;
    LAS float* DTL = (LAS float*)(F.lds + RING_OFF + 139264); LAS float* ACSL = DTL + 1024; LAS float* WL = (LAS float*)(F.lds + RING_OFF + 147456); LAS float* NG = WL + 5 * 128;
    LAS float* DPL = NG + 512;
    if (g != g_lds) { const float* cwg = F.in[14] + (size_t)jl * 4 * SSD_CONV + 5120 + g * 128; const float* cbg = F.in[15] + (size_t)jl * SSD_CONV + 5120 + g * 128;
        for (int i = tid; i < 5 * 128; i += NTHR) { const int k = i >> 7, jj = i & 127; WL[i] = k < 4 ? cwg[(size_t)k * SSD_CONV + jj] : cbg[jj]; }
        NG[tid] = F.in[19][(size_t)jl * 4096 + g * 512 + tid];
        g_lds = g; }
    __syncthreads();
    {
        const float* DTB = (const float*)(F.ws + WS_DTB); const float* ACSB = (const float*)(F.ws + WS_ACSB);
#pragma unroll
        for (int i = 0; i < 2; ++i) { const int idx = tid + 512 * i, l = idx >> 3, e = idx & 7; DTL[e * 128 + l] = DTB[(size_t)(r0 + l) * 64 + 8 * g + e]; ACSL[e * 128 + l] = 1.4426950408889634f * ACSB[(size_t)(r0 + l) * 64 + 8 * g + e]; }
        if (tid < 8) DPL[tid] = F.in[18][jl * 64 + 8 * g + tid];
    }
    {
        const int l = tid >> 2, cg = (tid & 3) * 32;
#pragma unroll
        for (int hf = 0; hf < 2; ++hf) { float o[1][16];
            ssd_conv_tok<1, 128>(PROJ + 9216 + g * 128 + cg + 16 * hf, r0 + l, s0 + l, WL + cg + 16 * hf, o);
            v4u w0, w1; w0.x = pk2(o[0][0], o[0][1]); w0.y = pk2(o[0][2], o[0][3]); w0.z = pk2(o[0][4], o[0][5]); w0.w = pk2(o[0][6], o[0][7]); w1.x = pk2(o[0][8], o[0][9]); w1.y = pk2(o[0][10], o[0][11]); w1.z = pk2(o[0][12], o[0][13]); w1.w = pk2(o[0][14], o[0][15]);
            *(LAS v4u*)(CT + (l * SSD_LP + cg + 16 * hf) * 2) = w0; *(LAS v4u*)(CT + (l * SSD_LP + cg + 16 * hf) * 2 + 16) = w1;
            const GAS v4u* bs = (const GAS v4u*)((const bf16_t*)(F.ws + WS_BS) + (size_t)(r0 + l) * 1024 + g * 128 + cg + 16 * hf);
            *(LAS v4u*)(BN + (l * SSD_LP + cg + 16 * hf) * 2) = bs[0]; *(LAS v4u*)(BN + (l * SSD_LP + cg + 16 * hf) * 2 + 16) = bs[1]; }
    }
    const int lp = tid >> 3, pg = (tid & 7) * 8, l0 = 2 * lp; const int l = 16 * wave + fr, row = r0 + l;
    const bf16_t* xsrc = (const bf16_t*)(F.ws + WS_XS) + (size_t)(r0 + l0) * 4096 + (8 * g) * 64 + pg;
    const bf16_t* psrc = (const bf16_t*)(F.ws + WS_STATES) + (((size_t)bc * 64 + 8 * g) * 64 + (tid >> 3)) * 128 + (tid & 7) * 16;
    const bf16_t* zsrc = PROJ + (size_t)row * SS_NP + (8 * g) * 64 + 4 * fq;
    v4u xraw[2], pvr[2]; v2u zc[4];
#define SSD_PREFETCH(e_) do { xraw[0] = *(const GAS v4u*)(xsrc + (e_) * 64); xraw[1] = *(const GAS v4u*)(xsrc + 4096 + (e_) * 64); \
        pvr[0] = *(const GAS v4u*)(psrc + (size_t)(e_) * 8192); pvr[1] = *(const GAS v4u*)(psrc + (size_t)(e_) * 8192 + 8); } while (0)
#define SSD_PREFETCH_Z(e_) do { _Pragma("unroll") for (int pt_ = 0; pt_ < 4; ++pt_) zc[pt_] = *(const GAS v2u*)(zsrc + (e_) * 64 + 16 * pt_); } while (0)
    SSD_PREFETCH(0); SSD_PREFETCH_Z(0);
    __syncthreads();
    f32x4_t cbt[8];
#pragma unroll
    for (int st = 0; st < 8; ++st) cbt[st] = (f32x4_t){0.f, 0.f, 0.f, 0.f};
#pragma unroll
    for (int ks = 0; ks < 4; ++ks) { bf16x8 cf = *(const LAS bf16x8*)(CT + ((16 * wave + fr) * SSD_LP + 32 * ks + 8 * fq) * 2), bf[8];
#pragma unroll
        for (int st = 0; st < 8; ++st) bf[st] = *(const LAS bf16x8*)(BN + ((16 * st + fr) * SSD_LP + 32 * ks + 8 * fq) * 2);
        asm volatile("s_waitcnt lgkmcnt(0)" : "+v"(cf), "+v"(bf[0]), "+v"(bf[1]), "+v"(bf[2]), "+v"(bf[3]), "+v"(bf[4]), "+v"(bf[5]), "+v"(bf[6]), "+v"(bf[7]));
#pragma unroll
        for (int st = 0; st < 8; ++st) if (st <= wave) cbt[st] = __builtin_amdgcn_mfma_f32_16x16x32_bf16(bf[st], cf, cbt[st], 0, 0, 0); }
    __syncthreads();
    float ssq = 0.f; bf16_t* YN = (bf16_t*)(F.ws + WS_YN) + (size_t)row * 4096;
    v2u ykeep[8][4];
#pragma unroll
    for (int i = 0; i < 8; ++i)
#pragma unroll
        for (int pt = 0; pt < 4; ++pt) ykeep[i][pt] = (v2u){0u, 0u};
#pragma unroll 1
    for (int e = 0; e < 8; ++e) {
        const int h = 8 * g + e; LAS unsigned char* XTe = XT + (e & 1) * 17408; LAS unsigned char* PVe = PV + (e & 1) * 17408;
        float sz[16];
#pragma unroll
        for (int pt = 0; pt < 4; ++pt) { const v2u zw = zc[pt]; sz[4 * pt] = silu_fast2(bflo(zw.x)); sz[4 * pt + 1] = silu_fast2(bfhi(zw.x)); sz[4 * pt + 2] = silu_fast2(bflo(zw.y)); sz[4 * pt + 3] = silu_fast2(bfhi(zw.y)); }
        int wv = wave; asm volatile("" : "+s"(wv));
        {
            const float f0 = DTL[e * 128 + l0], f1 = DTL[e * 128 + l0 + 1];
            const unsigned xa[4] = {xraw[0].x, xraw[0].y, xraw[0].z, xraw[0].w}, xb[4] = {xraw[1].x, xraw[1].y, xraw[1].z, xraw[1].w};
#pragma unroll
            for (int i = 0; i < 4; ++i) { *(LAS unsigned*)(XTe + ((pg + 2 * i) * SSD_LP + l0) * 2) = pk2(bflo(xa[i]) * f0, bflo(xb[i]) * f1); *(LAS unsigned*)(XTe + ((pg + 2 * i + 1) * SSD_LP + l0) * 2) = pk2(bfhi(xa[i]) * f0, bfhi(xb[i]) * f1); }
            *(LAS v4u*)(PVe + ((tid >> 3) * SSD_LP + (tid & 7) * 16) * 2) = pvr[0]; *(LAS v4u*)(PVe + ((tid >> 3) * SSD_LP + (tid & 7) * 16) * 2 + 16) = pvr[1];
        }
        if (e < 7) { SSD_PREFETCH(e + 1); SSD_PREFETCH_Z(e + 1); }
        {
            const float al = ACSL[e * 128 + l]; const float dsk = DPL[e] * __builtin_amdgcn_rcpf(DTL[e * 128 + l]);
            f32x4_t asv[8];
#pragma unroll
            for (int st = 0; st < 8; ++st) asv[st] = *(const LAS f32x4_t*)(ACSL + e * 128 + 16 * st + 4 * fq);
            asm volatile("s_waitcnt lgkmcnt(0)" : "+v"(asv[0]), "+v"(asv[1]), "+v"(asv[2]), "+v"(asv[3]), "+v"(asv[4]), "+v"(asv[5]), "+v"(asv[6]), "+v"(asv[7]));
#pragma unroll
            for (int st = 0; st < 8; ++st) if (st <= (wv | 1)) { float m[4];
                const f32x4_t as4 = asv[st];
                if (st < wv) {
#pragma unroll
                    for (int i = 0; i < 4; ++i) m[i] = cbt[st][i] * __builtin_amdgcn_exp2f(al - as4[i]);
                } else {
#pragma unroll
                    for (int i = 0; i < 4; ++i) { const int s = 16 * st + 4 * fq + i; float v = s <= l ? cbt[st][i] * __builtin_amdgcn_exp2f(al - as4[i]) : 0.f; if (s == l) v += dsk; m[i] = v; } }
                v2u w; w.x = pk2(m[0], m[1]); w.y = pk2(m[2], m[3]); *(LAS v2u*)(MT + (l * SSD_LP + 16 * st + 4 * fq) * 2) = w; }
        }
        asm volatile("s_waitcnt lgkmcnt(0)" ::: "memory"); __builtin_amdgcn_s_barrier(); asm volatile("" ::: "memory");
        f32x4_t yd[4], yo[4];
#pragma unroll
        for (int pt = 0; pt < 4; ++pt) { yd[pt] = (f32x4_t){0.f, 0.f, 0.f, 0.f}; yo[pt] = (f32x4_t){0.f, 0.f, 0.f, 0.f}; }
        LAS unsigned char* pvl = PVe + (fr * SSD_LP + 8 * fq) * 2; LAS unsigned char* xtl = XTe + (fr * SSD_LP + 8 * fq) * 2; LAS unsigned char* ctl = CT + (l * SSD_LP + 8 * fq) * 2; LAS unsigned char* mtl = MT + (l * SSD_LP + 8 * fq) * 2;
        asm volatile("" : "+v"(pvl), "+v"(xtl), "+v"(ctl), "+v"(mtl));
#pragma unroll
        for (int ks = 0; ks < 4; ++ks) {
            const bool dk = 2 * ks <= wv;
            bf16x8 cf = *(const LAS bf16x8*)(ctl + 64 * ks), mf = *(const LAS bf16x8*)(mtl + 64 * ks), pf[4], xf[4];
#pragma unroll
            for (int pt = 0; pt < 4; ++pt) { pf[pt] = *(const LAS bf16x8*)(pvl + (16 * pt * SSD_LP + 32 * ks) * 2); xf[pt] = *(const LAS bf16x8*)(xtl + (16 * pt * SSD_LP + 32 * ks) * 2); }
            asm volatile("s_waitcnt lgkmcnt(0)" : "+v"(cf), "+v"(mf), "+v"(pf[0]), "+v"(pf[1]), "+v"(pf[2]), "+v"(pf[3]), "+v"(xf[0]), "+v"(xf[1]), "+v"(xf[2]), "+v"(xf[3]));
#pragma unroll
            for (int pt = 0; pt < 4; ++pt) yo[pt] = __builtin_amdgcn_mfma_f32_16x16x32_bf16(pf[pt], cf, yo[pt], 0, 0, 0);
            if (dk) {
#pragma unroll
                for (int pt = 0; pt < 4; ++pt) yd[pt] = __builtin_amdgcn_mfma_f32_16x16x32_bf16(xf[pt], mf, yd[pt], 0, 0, 0); }
        }
        {
            const float ea = __builtin_amdgcn_exp2f(ACSL[e * 128 + l]); v2u ynew[4];
#pragma unroll
            for (int pt = 0; pt < 4; ++pt) {
                const float y0 = (yd[pt][0] + ea * yo[pt][0]) * sz[4 * pt], y1 = (yd[pt][1] + ea * yo[pt][1]) * sz[4 * pt + 1];
                const float y2 = (yd[pt][2] + ea * yo[pt][2]) * sz[4 * pt + 2], y3 = (yd[pt][3] + ea * yo[pt][3]) * sz[4 * pt + 3];
                ssq += (y0 * y0 + y1 * y1) + (y2 * y2 + y3 * y3); v2u w; w.x = pk2(y0, y1); w.y = pk2(y2, y3); ynew[pt] = w; }
#pragma unroll
            for (int i = 0; i < 7; ++i)
#pragma unroll
                for (int pt = 0; pt < 4; ++pt) ykeep[i][pt] = ykeep[i + 1][pt];
#pragma unroll
            for (int pt = 0; pt < 4; ++pt) ykeep[7][pt] = ynew[pt];
        }

    }
#undef SSD_PREFETCH
#undef SSD_PREFETCH_Z
    ssq += shfl_xor_l(ssq, 16, lane); ssq += shfl_xor_l(ssq, 32, lane);
    const float rstd = 1.0f / sqrtf(ssq * (1.0f / 512.0f) + RMS_EPS);
    const float* ng = F.in[19] + (size_t)jl * 4096;
#pragma unroll
    for (int e = 0; e < 8; ++e)
#pragma unroll
        for (int pt = 0; pt < 4; ++pt) { const int ch = (8 * g + e) * 64 + 16 * pt + 4 * fq; const f32x4_t gv = *(const LAS f32x4_t*)(NG + e * 64 + 16 * pt + 4 * fq); const v2u yk = ykeep[e][pt];
            if (F8_SS_OUT) { const f32x4_t yv = {bflo(yk.x) * rstd * gv.x, bfhi(yk.x) * rstd * gv.y, bflo(yk.y) * rstd * gv.z, bfhi(yk.y) * rstd * gv.w}; *(GAS int*)(F.ws + WS_YN8 + (size_t)row * 4096 + ch) = pk_fp8x4(yv, 4.0f); }
            else { v2u w; w.x = pk2(bflo(yk.x) * rstd * gv.x, bfhi(yk.x) * rstd * gv.y); w.y = pk2(bflo(yk.y) * rstd * gv.z, bfhi(yk.y) * rstd * gv.w);
            *(GAS v2u*)(YN + ch) = w; } }
    __syncthreads();
}
template <int NT> __device__ __forceinline__ void skinny_proj(Ctx& F, const bf16_t* Wt, float* OUT, int NOUT) {
    const int tid = fresh_tid(F.wave); const int lane = tid & 63, fr = lane & 15, fq = lane >> 4, wave = F.wave;
    const bf16_t* XB = (const bf16_t*)(F.ws + WS_XB); LAS float* PART = (LAS float*)(F.lds + RING_OFF);
    const bf16_t* bp = Wt + (size_t)fr * D + 256 * wave + 8 * fq;
    bf16x8 wb[NT][8];
#pragma unroll
    for (int n = 0; n < NT; ++n)
#pragma unroll
        for (int ks = 0; ks < 8; ++ks) wb[n][ks] = *(const GAS bf16x8*)(bp + (size_t)n * 16 * D + 32 * ks);
    for (int rt = blockIdx.x; rt < T / 16; rt += F.G) {
        const bf16_t* ap = XB + (size_t)(rt * 16 + fr) * D + 256 * wave + 8 * fq;
        bf16x8 xa[8];
#pragma unroll
        for (int ks = 0; ks < 8; ++ks) xa[ks] = *(const GAS bf16x8*)(ap + 32 * ks);
#pragma unroll
        for (int n = 0; n < NT; ++n) {
            f32x4 acc = (f32x4){0.f, 0.f, 0.f, 0.f};
#pragma unroll
            for (int ks = 0; ks < 8; ++ks) acc = __builtin_amdgcn_mfma_f32_16x16x32_bf16(wb[n][ks], xa[ks], acc, 0, 0, 0);
            *(LAS f32x4*)(PART + (wave * 16 + fr) * (16 * NT) + 16 * n + 4 * fq) = acc; }
        __syncthreads();
        for (int o = tid; o < 16 * 16 * NT; o += NTHR) { const int r = o / (16 * NT), cidx = o - r * (16 * NT); float a = 0.f;
#pragma unroll
            for (int w = 0; w < 8; ++w) a += PART[(w * 16 + r) * (16 * NT) + cidx];
            if (cidx < NOUT) OUT[(size_t)(rt * 16 + r) * NOUT + cidx] = a; }
        __syncthreads();
    }
}
struct Params { const float* in[28]; float* out; unsigned char* ws; int layer_lo, layer_hi, st_lo, st_hi, bar_region, pad; };
constexpr int N_STEPS = 13;
#ifndef MK_ONE_LAUNCH
#define MK_ONE_LAUNCH 1
#endif
__host__ __device__ constexpr bool step_active(int layer, int k) {
    if (k == 5 || k == 6 || k == 9) return false;
    return (layer & 1) ? true : k != 4;
}
#define VB_LOOP(n) for (size_t vb = blockIdx.x; vb < (size_t)(n); vb += gridDim.x)
#ifndef PROBE_REP_MASK
#define PROBE_REP_MASK 0
#endif
#define REPS(k) _Pragma("unroll 1") for (int rep_ = 0; rep_ < (((PROBE_REP_MASK >> (k)) & 1) ? 2 : 1); ++rep_)
__global__ void __launch_bounds__(NTHR, 2) mk_fwd(Params args) {
    extern __shared__ __attribute__((aligned(16))) unsigned char lds_raw[];
    Ctx F;
    F.lds = (LAS unsigned char*)lds_raw; F.MISC = (volatile LAS unsigned*)(F.lds + MISC_OFF);
    F.wave = __builtin_amdgcn_readfirstlane((int)threadIdx.x >> 6); F.tid = fresh_tid(F.wave); F.lane = F.tid & 63;
    F.G = gridDim.x; { const int bx = blockIdx.x; F.vcu = (F.G % 8 == 0) ? (bx % 8) * (F.G / 8) + bx / 8 : bx; }
#pragma unroll
    for (int i = 0; i < 28; ++i) F.in[i] = args.in[i];
    F.out = args.out; F.ws = args.ws; F.ctl = (gu32*)(args.ws + WS_CTL);
    for (int u = F.tid; u < (LDS_BYTES - LDSCTL_OFF) / 4; u += NTHR) ((LAS unsigned*)(F.lds + LDSCTL_OFF))[u] = 0u;
    __syncthreads();
    XcdBarrier bar; bar.bar = (unsigned*)(F.ctl + CW_BAR); bar.x = 0; bar.st = nullptr;
    const bool has_bar = args.bar_region >= 0;
    if (has_bar) bar = xcd_barrier_post((unsigned*)(F.ctl + CW_BAR) + args.bar_region * XCD_BAR_WORDS, F.MISC + 8, F.tid);
    const int lo = args.st_lo, hi = args.st_hi;
#ifdef STEP_MASK
#define IN(k) (((STEP_MASK >> (k)) & 1) && lo <= (k) && (k) < hi && step_active(layer, (k)))
#else
#define IN(k) (lo <= (k) && (k) < hi && step_active(layer, (k)))
#endif
#define SEAM(k) do { bool more_ = layer + 1 < args.layer_hi; for (int k2 = (k) + 1; k2 < hi; ++k2) more_ = more_ || step_active(layer, k2); if (has_bar && more_) { const int bt_ = fresh_tid(F.wave); xcd_barrier(bar, bt_); if ((PROBE_REP_MASK >> 13) & 1) xcd_barrier(bar, bt_); } } while (0)
#define FRESH() do { F.tid = fresh_tid(F.wave); F.lane = F.tid & 63; } while (0)
    for (int layer = args.layer_lo; layer < args.layer_hi; ++layer) {
        const int j = layer >> 1; const bool even = (layer & 1) == 0;
        if (IN(0)) { FRESH(); REPS(0) s0_convert(F, layer); if (layer == 0 || hi <= 1) SEAM(0); else __syncthreads(); }
        if (IN(1)) {
            if (even ? F8_HY_IN : F8_SS_IN) {
                pg8::Gemm g{(const pg8::bf16_t*)(F.ws + WS_XIN8), even ? (const pg8::bf16_t*)(F.ws + WS_WHYIN8 + (size_t)j * 5120 * 2048) : (const pg8::bf16_t*)(F.ws + WS_WSSIN8 + (size_t)j * 10240 * 2048), T, even ? 5120 : 10240, D / 2};
                pg8::StaticOrder S; S.init(T, g.N, F.G, (int)blockIdx.x);
                pg8::EpiBf16P8 E{(pg8::bf16_t*)(F.ws + WS_PROJ), even ? HY_NP : SS_NP, 1.0f / 512.0f};
                REPS(1) pg8::gemm_phase<pg8::EpiBf16P8, pg8::StaticOrder, PG8_ALIGN, PG8_SP2>(F.lds + RING_OFF, g, S, E, F.wave);
            } else {
                pg8::Gemm g{(const pg8::bf16_t*)(F.ws + WS_XB), even ? (const pg8::bf16_t*)(F.ws + WS_WHYIN) + (size_t)j * HY_NP * 2048 : (const pg8::bf16_t*)(F.ws + WS_WSSIN) + (size_t)j * SS_NP * 2048, T, even ? 5120 : 10240, D};
                pg8::StaticOrder S; S.init(T, g.N, F.G, (int)blockIdx.x);
                pg8::EpiBf16P E{(pg8::bf16_t*)(F.ws + WS_PROJ), even ? HY_NP : SS_NP, 1.0f};
                REPS(1) pg8::gemm_phase<pg8::EpiBf16P, pg8::StaticOrder, PG8_ALIGN, PG8_SP2>(F.lds + RING_OFF, g, S, E, F.wave);
            }
            if (even) skinny_proj<1>(F, (const bf16_t*)(F.ws + WS_WHYIN) + ((size_t)j * HY_NP + 5120) * 2048, (float*)(F.ws + WS_FCUM), 8);
            else skinny_proj<4>(F, (const bf16_t*)(F.ws + WS_WSSIN) + ((size_t)j * SS_NP + 10240) * 2048, (float*)(F.ws + WS_DTB), 64);
            SEAM(1);
        }
        if (IN(2)) { FRESH();
            if (even) { const bf16_t* PROJ = (const bf16_t*)(F.ws + WS_PROJ); bf16_t* YMIX = (bf16_t*)(F.ws + WS_YMIX);
                REPS(2) for (int item = F.vcu; item < 256; item += F.G) fox::attn_item((char*)lds_raw, PROJ, (const float*)(F.ws + WS_FCUM), YMIX, F.in[11] + (size_t)j * 8, item, fresh_tid(F.wave));
                { int hd_lds = -1; REPS(3) for (int item = F.vcu; item < 2048; item += F.G) lru_local_item(F, j, item, hd_lds); }
            } else { int g_lds = -1; for (int item = F.vcu; item < 1024; item += F.G) ssd_states_item(F, j, item, g_lds); }
            SEAM(2); }
        if (IN(3)) { FRESH();
            if (even) { REPS(4) for (int item = F.vcu; item < 256; item += F.G) lru_fix_item(F, item); }
            else { for (int item = F.vcu; item < 256; item += F.G) ssd_scan_item(F, item); }
            SEAM(3); }
        if (IN(4)) { FRESH();
            { int g_lds = -1; REPS(6) for (int item = F.vcu; item < 1024; item += F.G) ssd_y_item(F, j, item, g_lds); }
            SEAM(4); }
        if (IN(7)) {
            pg8::StaticOrder S; S.init(T, D, F.G, (int)blockIdx.x);
            if (even ? F8_HY_OUT : F8_SS_OUT) {
                pg8::Gemm g{even ? (const pg8::bf16_t*)(F.ws + WS_YMIX8) : (const pg8::bf16_t*)(F.ws + WS_YN8), even ? (const pg8::bf16_t*)(F.ws + WS_WHYOUT + (size_t)j * 2048 * 2048) : (const pg8::bf16_t*)(F.ws + WS_WSSOUT + (size_t)j * 2048 * 4096), T, D, even ? 1024 : 2048};
                pg8::EpiBf16P8 E{(pg8::bf16_t*)(F.ws + WS_MBUF), D, 1.0f / 512.0f};
                REPS(7) pg8::gemm_phase<pg8::EpiBf16P8, pg8::StaticOrder, PG8_ALIGN, PG8_SP2>(F.lds + RING_OFF, g, S, E, F.wave);
            } else {
                pg8::Gemm g{even ? (const pg8::bf16_t*)(F.ws + WS_YMIX) : (const pg8::bf16_t*)(F.ws + WS_YN), even ? (const pg8::bf16_t*)(F.ws + WS_WHYOUT) + (size_t)j * 2048 * 2048 : (const pg8::bf16_t*)(F.ws + WS_WSSOUT) + (size_t)j * 2048 * 4096, T, D, even ? 2048 : 4096};
                pg8::EpiBf16P E{(pg8::bf16_t*)(F.ws + WS_MBUF), D, 1.0f};
                REPS(7) pg8::gemm_phase<pg8::EpiBf16P, pg8::StaticOrder, PG8_ALIGN, PG8_SP2>(F.lds + RING_OFF, g, S, E, F.wave);
            }
            SEAM(7);
        }
        if (IN(8)) { FRESH(); if ((PROBE_REP_MASK >> 8) & 1) ln1_router<true>(F, layer); ln1_router<false>(F, layer); SEAM(8); }
        if (IN(10)) {
            pg8::MoeGatherOrder S; moe_tables(F, layer, S.tab); const int Gg = moe_gemm_wgs(F, S.tab[16], layer + 1 < DEPTH); S.G = Gg; S.c = (int)blockIdx.x < Gg ? (int)blockIdx.x : 8 * S.tab[16]; S.exptok = (const int*)(F.ws + WS_EXPTOK); S.cnt = (const unsigned*)(F.ctl + CW_CNT + layer * 16); S.cap = T;
            pg8::Gemm g{(const pg8::bf16_t*)(F.ws + WS_XB8), (const pg8::bf16_t*)(F.ws + ((layer & 1) ? WS_WGU_B : WS_WGU)), T, 2048, D / 2};
            pg8::EpiSwiglu E{F.ws + WS_HID, (const float*)(F.ws + WS_EXPW), S.cnt, T, MOE_FF};
            REPS(10) pg8::gemm_phase<pg8::EpiSwiglu, pg8::MoeGatherOrder, PG8_ALIGN, PG8_SP2>(F.lds + RING_OFF, g, S, E, F.wave);
            if (layer + 1 < DEPTH) moe_tail_convert(F, layer + 1, Gg, 0);
            SEAM(10);
        }
        if (IN(11)) {
            pg8::MoeOrder S; moe_tables(F, layer, S.tab); const int Gg = moe_gemm_wgs(F, S.tab[16], layer + 1 < DEPTH); S.G = Gg; S.c = (int)blockIdx.x < Gg ? (int)blockIdx.x : 8 * S.tab[16];
            pg8::Gemm g{(const pg8::bf16_t*)(F.ws + WS_HID), (const pg8::bf16_t*)(F.ws + ((layer & 1) ? WS_WD_B : WS_WD)), MOE_ROWS, 2048, MOE_FF / 2};
            pg8::EpiBf16P8 E{(pg8::bf16_t*)(F.ws + WS_YG), D, 1.0f / 512.0f};
            REPS(11) pg8::gemm_phase<pg8::EpiBf16P8, pg8::MoeOrder, PG8_ALIGN, PG8_SP2>(F.lds + RING_OFF, g, S, E, F.wave);
            if (layer + 1 < DEPTH) moe_tail_convert(F, layer + 1, Gg, 1);
            SEAM(11);
        }
        if (IN(12)) { FRESH(); if ((PROBE_REP_MASK >> 12) & 1) { ln2_phase<true>(F, layer); __syncthreads(); } ln2_phase<false>(F, layer); SEAM(12); }
    }
#undef IN
#undef SEAM
}
extern "C" void kernel_launch(void* const* d_in, const int* in_sizes, int n_in, void* d_out, int out_size, void* d_ws, size_t ws_size, hipStream_t stream) {
    static int grid = 0;
    if (grid == 0) {
        if (n_in != 28 || out_size != T * D || ws_size < WS_END) { fprintf(stderr, "kernel_launch: unexpected shapes (n_in %d out %d ws %zu need %zu)\n", n_in, out_size, ws_size, (size_t)WS_END); grid = -1; return; }
        int dev = 0, cus = 0; (void)hipGetDevice(&dev); (void)hipDeviceGetAttribute(&cus, hipDeviceAttributeMultiprocessorCount, dev);
        if (hipFuncSetAttribute((const void*)mk_fwd, hipFuncAttributeMaxDynamicSharedMemorySize, LDS_BYTES) != hipSuccess) { fprintf(stderr, "kernel_launch: hipFuncSetAttribute failed\n"); grid = -1; return; }
        int per_cu = 0; (void)hipOccupancyMaxActiveBlocksPerMultiprocessor(&per_cu, (const void*)mk_fwd, NTHR, LDS_BYTES); (void)hipGetLastError();
        grid = 256; if (cus != 256 || per_cu < 1) fprintf(stderr, "kernel_launch: built for 256 CUs x 1 workgroup (144 KiB LDS each); device has %d CUs, occupancy query says %d\n", cus, per_cu);
    }
    if (grid < 0) return;
    (void)hipMemsetAsync((char*)d_ws + WS_CTL, 0, CTL_ZERO_BYTES, stream);
    Params a{};
    for (int i = 0; i < 28; ++i) a.in[i] = (const float*)d_in[i];
    a.out = (float*)d_out; a.ws = (unsigned char*)d_ws;
#if MK_ONE_LAUNCH
    a.layer_lo = 0; a.layer_hi = DEPTH; a.st_lo = 0; a.st_hi = N_STEPS; a.bar_region = 0;
    hipLaunchKernelGGL(mk_fwd, dim3(grid), dim3(NTHR), LDS_BYTES, stream, a);
#else
    for (int layer = 0; layer < DEPTH; ++layer)
        for (int s = 0; s < N_STEPS; ++s) if (step_active(layer, s)) {
            a.layer_lo = layer; a.layer_hi = layer + 1; a.st_lo = s; a.st_hi = s + 1; a.bar_region = -1;
            hipLaunchKernelGGL(mk_fwd, dim3(grid), dim3(NTHR), LDS_BYTES, stream, a);
        }
#endif
}
```

```cpp
#include <hip/hip_runtime.h>
#include <cstdio>
#include <cstdint>
__device__ __forceinline__ float shfl_xor_l(float v, int o, int lane) { return __int_as_float(__builtin_amdgcn_ds_bpermute((lane ^ o) << 2, __float_as_int(v))); }
__device__ __forceinline__ float shfl_up_l(float v, int o, int lane) { return __int_as_float(__builtin_amdgcn_ds_bpermute((lane - o) << 2, __float_as_int(v))); }
__device__ __forceinline__ int lane_id() { return (int)__builtin_amdgcn_mbcnt_hi(~0u, __builtin_amdgcn_mbcnt_lo(~0u, 0u)); }
__device__ __forceinline__ int fresh_tid(int wave) { int t; asm volatile("v_mbcnt_lo_u32_b32 %0, -1, 0\n\tv_mbcnt_hi_u32_b32 %0, -1, %0\n\tv_lshl_add_u32 %0, %1, 6, %0" : "=&v"(t) : "s"(wave)); return t; }
namespace pg8 {
#define PG8_LAS __attribute__((address_space(3)))
typedef unsigned short bf16_t;
typedef short bf16x8 __attribute__((ext_vector_type(8)));
typedef float f32x4 __attribute__((ext_vector_type(4)));
typedef unsigned u32x4 __attribute__((ext_vector_type(4)));
typedef int v8i __attribute__((ext_vector_type(8)));
constexpr int BM = 256, BK = 64, HALF = 128, HTB = HALF * BK * 2  , STAGE_BYTES = 8 * HTB, NXCD = 8, WGM = 8;

__host__ __device__ __forceinline__ int lds_byte(int r, int c) { const int st = (r >> 4) * 2 + (c >> 5), rr = r & 15, cc = c & 31, ob = rr * 64 + cc * 2; return st * 1024 + (ob ^ (((ob >> 9) & 1) << 5)); }
__host__ __device__ __forceinline__ void stage_rc(int b, int& R, int& C) { const int st = b / 1024, sb = b % 1024, swz = sb ^ (((sb >> 9) & 1) << 5); R = (st >> 1) * 16 + swz / 64; C = (st & 1) * 32 + (swz % 64) / 2; }
__host__ __device__ __forceinline__ int perm32(int rho) { const int n = rho >> 4, i = rho & 15; return 8 * (i >> 2) + 4 * n + (i & 3); }

struct Unit { int pm, pn, pb, e, lt; };
struct Gemm { const bf16_t* A; const bf16_t* Bt; int M, N, K; };

struct StaticOrder {
    static constexpr bool GATHER = false;
    int nM, nN, nwg, G, c;
    __host__ __device__ void init(int M, int N, int G_, int c_) { nM = M / BM; nN = N / BM; nwg = nM * nN; G = G_; c = c_; }
    __host__ __device__ bool next(int i, Unit& u) const {
        const long L = (long)i * G + c; if (L >= nwg) return false;
        int wgid = (int)L; { const int q = nwg / NXCD, r = nwg % NXCD, xcd = wgid % NXCD, off = wgid / NXCD; wgid = (xcd < r ? xcd * (q + 1) : r * (q + 1) + (xcd - r) * q) + off; }
        const int nig = WGM * nN, gid = wgid / nig, fm = gid * WGM, gsz = (nM - fm) < WGM ? (nM - fm) : WGM;
        u.pm = fm + ((wgid % nig) % gsz); u.pn = (wgid % nig) / gsz; u.pb = u.pn; u.e = 0; u.lt = 0; return true;
    }
    __device__ __forceinline__ void a_ready(const Unit&) const {}
    __device__ __forceinline__ void done(const Unit&) const {}
};
struct MoeOrder {
    static constexpr bool GATHER = false;
    int tab[17]; int G, c;
    __device__ bool next(int i, Unit& u) const {
        const int nt = tab[16]; const int L = i * G + c; if (L >= nt * 8) return false;
        const int wgid = (L & 7) * nt + (L >> 3); const int t = wgid >> 3, pn = wgid & 7;
        int E = 0;
#pragma unroll
        for (int e = 1; e < 16; ++e) E += (t >= tab[e]) ? 1 : 0;
        int t0 = 0;
#pragma unroll
        for (int e = 1; e < 16; ++e) t0 = (E == e) ? tab[e] : t0;
        u.pm = t; u.pn = pn; u.pb = E * 8 + pn; u.e = E; u.lt = t - t0; return true;
    }
    __device__ __forceinline__ void a_ready(const Unit&) const {}
    __device__ __forceinline__ void done(const Unit&) const {}
};
struct MoeGatherOrder : MoeOrder {
    static constexpr bool GATHER = true;
    const int* exptok; const unsigned* cnt; int cap;
    __device__ __forceinline__ int row_of(const Unit& u, int r) const { const int i = u.lt * 256 + r; const int n = (int)__hip_atomic_load(cnt + u.e, __ATOMIC_RELAXED, __HIP_MEMORY_SCOPE_AGENT);
        return i < n ? exptok[(size_t)u.e * cap + i] : 0; }
};
__device__ __forceinline__ unsigned cvt_pk_bf16(float lo, float hi) { unsigned r; asm volatile("v_cvt_pk_bf16_f32 %0, %1, %2" : "=v"(r) : "v"(lo), "v"(hi)); return r; }

template <bool F8> struct EpiBf16PT {
    static constexpr bool PERM = true, AFTER_DRAIN = false, FP8 = F8;
    bf16_t* O; int ldc; float oscale;
    __device__ __forceinline__ void operator()(const f32x4 (&acc)[2][2][4][2], const Unit& u, int wr, int wc, int fr, int fq) const {
        const int row0 = u.pm * BM + wr * 64 + fr, col0 = u.pn * BM + wc * 32 + 8 * fq;
#pragma unroll
        for (int ai = 0; ai < 2; ++ai)
#pragma unroll
            for (int m = 0; m < 4; ++m) { bf16_t* rowp = O + (size_t)(row0 + ai * HALF + m * 16) * ldc + col0;
#pragma unroll
                for (int bj = 0; bj < 2; ++bj) { f32x4 v0 = acc[ai][bj][m][0], v1 = acc[ai][bj][m][1]; if (F8) { v0 = v0 * oscale; v1 = v1 * oscale; }
                    u32x4 w; w.x = cvt_pk_bf16(v0[0], v0[1]); w.y = cvt_pk_bf16(v0[2], v0[3]); w.z = cvt_pk_bf16(v1[0], v1[1]); w.w = cvt_pk_bf16(v1[2], v1[3]);
                    *(u32x4*)(rowp + bj * HALF) = w; } }
    }
};
typedef EpiBf16PT<false> EpiBf16P;
typedef EpiBf16PT<true> EpiBf16P8;
__device__ __forceinline__ float silu_fast(float x) { return x * __builtin_amdgcn_rcpf(1.0f + __expf(-x)); }
struct EpiSwiglu {
    static constexpr bool PERM = true, AFTER_DRAIN = false, FP8 = true;
    unsigned char* H; const float* expw; const unsigned* cnt; int cap, ldc;
    __device__ __forceinline__ void operator()(const f32x4 (&acc)[2][2][4][2], const Unit& u, int wr, int wc, int fr, int fq) const {
        const int row0 = u.pm * BM + wr * 64 + fr, col0 = u.pn * HALF + wc * 32 + 8 * fq; const int nvalid = (int)__hip_atomic_load(cnt + u.e, __ATOMIC_RELAXED, __HIP_MEMORY_SCOPE_AGENT);
        float gtv[8];
#pragma unroll
        for (int k = 0; k < 8; ++k) { const int li = wr * 64 + fr + (k >> 2) * HALF + (k & 3) * 16 + u.lt * BM; gtv[k] = expw[(size_t)u.e * cap + li]; }
        asm volatile("" : "+v"(gtv[0]), "+v"(gtv[1]), "+v"(gtv[2]), "+v"(gtv[3]), "+v"(gtv[4]), "+v"(gtv[5]), "+v"(gtv[6]), "+v"(gtv[7]));
#pragma unroll
        for (int ai = 0; ai < 2; ++ai)
#pragma unroll
            for (int m = 0; m < 4; ++m) { const int row = row0 + ai * HALF + m * 16; const int li = row - u.pm * BM + u.lt * BM; const float gt = li < nvalid ? gtv[ai * 4 + m] : 0.f;
                const f32x4 g0 = acc[ai][0][m][0], g1 = acc[ai][0][m][1], u0 = acc[ai][1][m][0], u1 = acc[ai][1][m][1];
                float h[8]; const float ds = 1.0f / 512.0f, gs = gt * (4.0f / 512.0f);
#pragma unroll
                for (int i = 0; i < 4; ++i) { h[i] = __builtin_amdgcn_fmed3f(silu_fast(g0[i] * ds) * u0[i] * gs, -448.f, 448.f); h[4 + i] = __builtin_amdgcn_fmed3f(silu_fast(g1[i] * ds) * u1[i] * gs, -448.f, 448.f); }
                int w0 = __builtin_amdgcn_cvt_pk_fp8_f32(h[0], h[1], 0, false); w0 = __builtin_amdgcn_cvt_pk_fp8_f32(h[2], h[3], w0, true);
                int w1 = __builtin_amdgcn_cvt_pk_fp8_f32(h[4], h[5], 0, false); w1 = __builtin_amdgcn_cvt_pk_fp8_f32(h[6], h[7], w1, true);
                typedef int i32x2 __attribute__((ext_vector_type(2)));
                *(i32x2*)(H + (size_t)row * ldc + col0) = (i32x2){w0, w1}; }
    }
};
template <class Epi, class Sched, bool ALIGN_EPI = false, bool SP2 = true>
__device__ __forceinline__ void gemm_phase(PG8_LAS unsigned char* lds, const Gemm g, const Sched& S, const Epi& E, int wave_in) {
    static_assert(SP2, "only the two-super-phase K-loop is kept in this file");
    const int tid_ = fresh_tid(wave_in);
    const int tid = tid_, wid = __builtin_amdgcn_readfirstlane(tid >> 6), lane = tid & 63, wr = wid >> 2, wc = wid & 3, fr = lane & 15, fq = lane >> 4;
    const int K = g.K, nt = K / BK;
    constexpr bool GATHER = Sched::GATHER;
    unsigned voffB[2]; int RA[2], CA[2];
#pragma unroll
    for (int i = 0; i < 2; ++i) { int R, C; stage_rc(tid * 16 + i * 8192, R, C); const int Rb = Epi::PERM ? ((R & ~31) + perm32(R & 31)) : R; RA[i] = R; CA[i] = C; voffB[i] = (unsigned)(Rb * K + C) * 2u; }
    const size_t kstep = (size_t)(BK * 2);
    const size_t hstep = (size_t)HALF * K * 2;
    const size_t tstep = 2 * hstep;
    const unsigned ldsw = (unsigned)wid * 1024u;
    PG8_LAS int* IDX = (PG8_LAS int*)(lds + STAGE_BYTES);
    unsigned vc[2][2], vn[2][2];
#pragma unroll
    for (int h = 0; h < 2; ++h)
#pragma unroll
        for (int i = 0; i < 2; ++i) { vc[h][i] = (unsigned)((h * HALF + RA[i]) * K + CA[i]) * 2u; vn[h][i] = vc[h][i]; }
    const int aoff = lds_byte(wr * 64 + fr, fq * 8), boff = lds_byte(wc * 32 + fr, fq * 8);
#define PG8_SA(b, h) (((b) * 2 + (h)) * HTB)
#define PG8_SB(b, h) ((4 + (b) * 2 + (h)) * HTB)
#define PG8_STAGE(bufoff, gbase, voff) do { _Pragma("unroll") for (int _i = 0; _i < 2; ++_i) \
        __builtin_amdgcn_global_load_lds((const unsigned*)((const char*)(gbase) + (voff)[_i]), (PG8_LAS unsigned*)(lds + (bufoff) + ldsw + _i * 8192), 16, 0, 0); } while (0)
#define PG8_LDA(dst, b, h) do { _Pragma("unroll") for (int m = 0; m < 4; ++m) _Pragma("unroll") for (int k = 0; k < 2; ++k) dst[m][k] = *(const PG8_LAS bf16x8*)(lds + PG8_SA(b, h) + aoff + m * 2048 + k * 1024); } while (0)
#define PG8_LDB(dst, b, h) do { _Pragma("unroll") for (int n = 0; n < 2; ++n) _Pragma("unroll") for (int k = 0; k < 2; ++k) dst[n][k] = *(const PG8_LAS bf16x8*)(lds + PG8_SB(b, h) + boff + n * 2048 + k * 1024); } while (0)
#define PG8_MMA(ai, bj, At, Bt) do { __builtin_amdgcn_s_setprio(1); _Pragma("unroll") for (int m = 0; m < 4; ++m) _Pragma("unroll") for (int n = 0; n < 2; ++n) { \
        if constexpr (Epi::FP8) { v8i a8_, b8_; { const u32x4 x0_ = __builtin_bit_cast(u32x4, At[m][0]), x1_ = __builtin_bit_cast(u32x4, At[m][1]), y0_ = __builtin_bit_cast(u32x4, Bt[n][0]), y1_ = __builtin_bit_cast(u32x4, Bt[n][1]); \
                a8_ = (v8i){(int)x0_.x, (int)x0_.y, (int)x0_.z, (int)x0_.w, (int)x1_.x, (int)x1_.y, (int)x1_.z, (int)x1_.w}; b8_ = (v8i){(int)y0_.x, (int)y0_.y, (int)y0_.z, (int)y0_.w, (int)y1_.x, (int)y1_.y, (int)y1_.z, (int)y1_.w}; } \
            acc[ai][bj][m][n] = __builtin_amdgcn_mfma_scale_f32_16x16x128_f8f6f4(b8_, a8_, acc[ai][bj][m][n], 0, 0, 0, 0x7f7f7f7f, 0, 0x7f7f7f7f); asm volatile("" : "+v"(acc[ai][bj][m][n])); } \
        else { _Pragma("unroll") for (int k = 0; k < 2; ++k) acc[ai][bj][m][n] = __builtin_amdgcn_mfma_f32_16x16x32_bf16(Bt[n][k], At[m][k], acc[ai][bj][m][n], 0, 0, 0); } } \
        __builtin_amdgcn_s_setprio(0); } while (0)
#define PG8_WAIT_V(n) asm volatile("s_waitcnt vmcnt(" #n ")" ::: "memory")
#define PG8_WAIT_L(n) asm volatile("s_waitcnt lgkmcnt(" #n ")" ::: "memory")
#define PG8_BAR __builtin_amdgcn_s_barrier()
#define PG8_SCHED __builtin_amdgcn_sched_barrier(0)
#define PG8_FETCH_ROWS(u_, slot_) do { if (wid == 7) { int r4_[4]; _Pragma("unroll") for (int q_ = 0; q_ < 4; ++q_) r4_[q_] = S.row_of((u_), lane + 64 * q_); \
        asm volatile("s_waitcnt vmcnt(0)" ::: "memory"); _Pragma("unroll") for (int q_ = 0; q_ < 4; ++q_) IDX[(slot_) * 256 + lane + 64 * q_] = r4_[q_]; } } while (0)
#define PG8_ROW_OFFS(dst_, slot_) do { _Pragma("unroll") for (int h_ = 0; h_ < 2; ++h_) _Pragma("unroll") for (int i_ = 0; i_ < 2; ++i_) \
        dst_[h_][i_] = (unsigned)(IDX[(slot_) * 256 + h_ * HALF + RA[i_]] * K + CA[i_]) * 2u; } while (0)
    Unit cur, nxt; int ui = 0;
    if (!S.next(0, cur)) return;
    f32x4 acc[2][2][4][2];
#pragma unroll
    for (int a = 0; a < 2; ++a)
#pragma unroll
        for (int b = 0; b < 2; ++b)
#pragma unroll
            for (int m = 0; m < 4; ++m)
#pragma unroll
                for (int n = 0; n < 2; ++n) acc[a][b][m][n] = (f32x4){0.f, 0.f, 0.f, 0.f};
    bf16x8 At[4][2], B0[2][2], B1[2][2];
    const char* cA = GATHER ? (const char*)g.A : (const char*)g.A + (size_t)cur.pm * tstep; const char* cB = (const char*)g.Bt + (size_t)cur.pb * tstep;
    S.a_ready(cur);
    if constexpr (GATHER) { PG8_FETCH_ROWS(cur, 0); PG8_WAIT_L(0); PG8_BAR; asm volatile("" ::: "memory"); PG8_ROW_OFFS(vc, 0); }
    PG8_STAGE(PG8_SB(0, 0), cB, voffB); PG8_STAGE(PG8_SB(0, 1), cB + hstep, voffB); PG8_STAGE(PG8_SA(0, 0), cA, vc[0]); PG8_STAGE(PG8_SA(0, 1), cA, vc[1]);
    if (wr == 1) PG8_BAR;
    PG8_WAIT_V(2); PG8_BAR;
    PG8_STAGE(PG8_SB(1, 0), cB + kstep, voffB); PG8_STAGE(PG8_SA(1, 0), cA + kstep, vc[0]); PG8_STAGE(PG8_SB(1, 1), cB + hstep + kstep, voffB);
    PG8_WAIT_V(6); PG8_BAR;
    for (;;) {
        const bool has_next = S.next(ui + 1, nxt);
        const char* nA = GATHER ? (const char*)g.A : (has_next ? (const char*)g.A + (size_t)nxt.pm * tstep : cA); const char* nB = has_next ? (const char*)g.Bt + (size_t)nxt.pb * tstep : cB;
        if constexpr (GATHER) { if (has_next) PG8_FETCH_ROWS(nxt, (ui + 1) & 1); }
        for (int t = 0; t < nt; t += 2) {
            const bool last = (t == nt - 2);
            const char* a1 = cA + (size_t)(t + 1) * kstep;
            const char* a2 = last ? nA : cA + (size_t)(t + 2) * kstep; const char* b2 = last ? nB : cB + (size_t)(t + 2) * kstep;
            const char* a3 = a2 + kstep; const char* b3 = b2 + kstep;
            if (last && has_next) { S.a_ready(nxt); if constexpr (GATHER) { PG8_ROW_OFFS(vn, (ui + 1) & 1); } }
            unsigned v2[2][2];
#pragma unroll
            for (int h = 0; h < 2; ++h)
#pragma unroll
                for (int i = 0; i < 2; ++i) v2[h][i] = (GATHER && last && has_next) ? vn[h][i] : vc[h][i];
            PG8_LDB(B0, 0, 0); PG8_LDB(B1, 0, 1); PG8_SCHED; PG8_LDA(At, 0, 0); PG8_STAGE(PG8_SA(1, 1), a1, vc[1]);
            PG8_WAIT_V(8); PG8_WAIT_L(0); PG8_BAR; PG8_MMA(0, 0, At, B0); PG8_MMA(0, 1, At, B1); PG8_BAR; PG8_SCHED;
            PG8_LDA(At, 0, 1); PG8_STAGE(PG8_SB(0, 0), b2, voffB); PG8_STAGE(PG8_SB(0, 1), b2 + hstep, voffB); PG8_STAGE(PG8_SA(0, 0), a2, v2[0]);
            PG8_WAIT_V(8); PG8_WAIT_L(0); PG8_BAR; PG8_MMA(1, 0, At, B0); PG8_MMA(1, 1, At, B1); PG8_BAR; PG8_SCHED;
            PG8_LDB(B0, 1, 0); PG8_LDB(B1, 1, 1); PG8_SCHED; PG8_LDA(At, 1, 0); PG8_STAGE(PG8_SA(0, 1), a2, v2[1]);
            PG8_WAIT_V(8); PG8_WAIT_L(0); PG8_BAR; PG8_MMA(0, 0, At, B0); PG8_MMA(0, 1, At, B1); PG8_BAR; PG8_SCHED;
            PG8_LDA(At, 1, 1); PG8_STAGE(PG8_SB(1, 0), b3, voffB); PG8_STAGE(PG8_SB(1, 1), b3 + hstep, voffB); PG8_STAGE(PG8_SA(1, 0), a3, v2[0]);
            PG8_WAIT_V(8); PG8_WAIT_L(0); PG8_BAR; PG8_MMA(1, 0, At, B0); PG8_MMA(1, 1, At, B1); PG8_BAR; PG8_SCHED;
        }
        if constexpr (ALIGN_EPI) { if (wr == 0) PG8_BAR; }
        if constexpr (!Epi::AFTER_DRAIN) { E(acc, cur, wr, wc, fr, fq); S.done(cur); }
        if (!has_next) break;
#pragma unroll
        for (int a = 0; a < 2; ++a)
#pragma unroll
            for (int b = 0; b < 2; ++b)
#pragma unroll
                for (int m = 0; m < 4; ++m)
#pragma unroll
                    for (int n = 0; n < 2; ++n) acc[a][b][m][n] = (f32x4){0.f, 0.f, 0.f, 0.f};
        cur = nxt; cA = nA; cB = nB; ++ui;
        if constexpr (GATHER) {
#pragma unroll
            for (int h = 0; h < 2; ++h)
#pragma unroll
                for (int i = 0; i < 2; ++i) vc[h][i] = vn[h][i]; }
        if constexpr (ALIGN_EPI) { if (wr == 1) PG8_BAR; }
    }
    PG8_WAIT_V(0);
    if constexpr (!ALIGN_EPI) { if (wr == 0) PG8_BAR; }
    PG8_BAR;
    if constexpr (Epi::AFTER_DRAIN) { E.fused(acc, cur, wr, wc, fr, fq, lds, wid, lane); S.done(cur); }
#undef PG8_SA
#undef PG8_SB
#undef PG8_STAGE
#undef PG8_LDA
#undef PG8_LDB
#undef PG8_MMA
#undef PG8_WAIT_V
#undef PG8_WAIT_L
#undef PG8_BAR
#undef PG8_SCHED
#undef PG8_FETCH_ROWS
#undef PG8_ROW_OFFS
}
}
#ifndef PG8_SP2
#define PG8_SP2 true
#endif
#ifndef PG8_ALIGN
#define PG8_ALIGN true
#endif
constexpr int BATCH = 4, SEQ = 4096, T = BATCH * SEQ, D = 2048, DEPTH = 4;
constexpr int HY_N = 5128, HY_NP = 5376;
constexpr int SS_N = 10304, SS_NP = 10496;
constexpr int LRU_W = 1024;
constexpr int SSD_INNER = 4096, SSD_CONV = 6144, SSD_H = 64, SSD_P = 64, SSD_G = 8, SSD_NS = 128, SSD_L = 128, SSD_NC = SEQ / SSD_L;
constexpr int MOE_FF = 1024, MOE_E = 16, MOE_ROWS = 2 * T + MOE_E * 256;
constexpr float ALPHA = 1.6817928305074290f;
constexpr float LN_EPS = 1e-5f, RMS_EPS = 1e-5f;
constexpr int NWAVES = 8, NTHR = 512;
constexpr size_t MiB = 1u << 20;
constexpr size_t WS_CTL = 0, CTL_ZERO_BYTES = 1 * MiB;
constexpr size_t WS_TOKSLOT = 1 * MiB;
constexpr size_t WS_TOKPOS = WS_TOKSLOT + 512 * 1024;
constexpr size_t WS_ROWGATE = WS_TOKPOS + 128 * 1024;
constexpr size_t WS_WRT = 2 * MiB;
constexpr size_t WS_WRI = 3 * MiB;
constexpr size_t WS_WHYIN = 4 * MiB;
constexpr size_t WS_WHYOUT = 46 * MiB;
constexpr size_t WS_WSSIN = 62 * MiB;
constexpr size_t WS_WSSOUT = 144 * MiB;
constexpr size_t WS_WGU = 176 * MiB;
constexpr size_t WS_WD = 304 * MiB;
constexpr size_t WS_X = 368 * MiB;
#ifndef F8_HY_IN
#define F8_HY_IN 1
#endif
#ifndef F8_SS_IN
#define F8_SS_IN 0
#endif
#ifndef F8_HY_OUT
#define F8_HY_OUT 1
#endif
#ifndef F8_SS_OUT
#define F8_SS_OUT 0
#endif
constexpr size_t WS_YN8 = 420 * MiB;
constexpr size_t WS_XIN8 = 368 * MiB;
constexpr size_t WS_WHYIN8 = 400 * MiB;
constexpr size_t WS_WSSIN8 = 420 * MiB;
constexpr size_t WS_XB = 496 * MiB;
constexpr size_t WS_MBUF = 560 * MiB;
constexpr size_t WS_ARENA = 624 * MiB;
constexpr size_t WS_PROJ = WS_ARENA;
constexpr size_t WS_HLOC = WS_ARENA + 168 * MiB;
constexpr size_t WS_CUMA = WS_ARENA + 232 * MiB;
constexpr size_t WS_LSUM = WS_ARENA + 296 * MiB;
constexpr size_t WS_YMIX = WS_ARENA + 298 * MiB;
constexpr size_t WS_FCUM = WS_ARENA + 362 * MiB;
constexpr size_t WS_STATES = WS_ARENA + 328 * MiB;
constexpr size_t WS_YN = WS_ARENA + 456 * MiB;
constexpr size_t WS_YMIX8 = WS_ARENA + 298 * MiB;
constexpr size_t WS_DTB = WS_ARENA + 584 * MiB;
constexpr size_t WS_ACSB = WS_ARENA + 588 * MiB;
constexpr size_t WS_XS = WS_ARENA + 592 * MiB;
constexpr size_t WS_BS = WS_ARENA + 720 * MiB;
constexpr size_t WS_WGU_B = WS_ARENA + 752 * MiB;
constexpr size_t WS_WD_B = WS_ARENA + 880 * MiB;
constexpr size_t WS_EXPTOK = WS_ARENA;
constexpr size_t WS_EXPW = WS_ARENA + 1 * MiB;
constexpr size_t WS_XB8 = WS_ARENA + 4 * MiB;
constexpr size_t WS_XG = WS_ARENA;
constexpr size_t WS_HID = WS_ARENA + 144 * MiB;
constexpr size_t WS_YG = WS_ARENA + 216 * MiB;
constexpr size_t WS_NAIVE = WS_ARENA + 600 * MiB;
constexpr size_t WS_END = WS_ARENA + 1060 * MiB;
constexpr int CW_TMO = 0, CW_CODE = 1, CW_CNT = 64  , CW_CVTHEAD = 256  , CW_DONE = 512  , CW_BAR = 4096;
constexpr int N_BAR_REGIONS = 8;
constexpr int RING_OFF = 0, RING_BYTES = 159744, LDSCTL_OFF = RING_BYTES, MISC_OFF = LDSCTL_OFF + 320, LDS_BYTES = 163840;
constexpr int TAB_OFF = LDSCTL_OFF;

#define GAS __attribute__((address_space(1)))
#define LAS __attribute__((address_space(3)))
typedef unsigned short bf16_t;
typedef unsigned v4u __attribute__((ext_vector_type(4)));
typedef unsigned v2u __attribute__((ext_vector_type(2)));
typedef float f32x4 __attribute__((ext_vector_type(4)));
typedef short bf16x8 __attribute__((ext_vector_type(8)));
typedef GAS unsigned gu32;
#define RLX_AGENT __ATOMIC_RELAXED, __HIP_MEMORY_SCOPE_AGENT
#define LDS_WAIT() asm volatile("s_waitcnt lgkmcnt(0)" ::: "memory")
#define VM_WAIT() asm volatile("s_waitcnt vmcnt(0)" ::: "memory")
__device__ __forceinline__ unsigned f2bf(float f) { unsigned u = __builtin_bit_cast(unsigned, f); return (u + 0x7fffu + ((u >> 16) & 1u)) >> 16; }
typedef float f32x2_t __attribute__((ext_vector_type(2))); typedef __bf16 bf16x2_t __attribute__((ext_vector_type(2)));
__device__ __forceinline__ unsigned pk2(float lo, float hi) { f32x2_t v = {lo, hi}; bf16x2_t b = __builtin_convertvector(v, bf16x2_t); return __builtin_bit_cast(unsigned, b); }
__device__ __forceinline__ float bf2f(unsigned short v) { return __uint_as_float(((unsigned)v) << 16); }
__device__ __forceinline__ float bflo(unsigned w) { return __uint_as_float(w << 16); }
__device__ __forceinline__ float bfhi(unsigned w) { return __uint_as_float(w & 0xffff0000u); }
__device__ __forceinline__ float sigmoid_(float x) { return __builtin_amdgcn_rcpf(1.0f + __expf(-x)); }
__device__ __forceinline__ float silu_(float x) { return x / (1.0f + __expf(-x)); }
__device__ __forceinline__ int pk_fp8x4(f32x4 v, float sc) { v = v * sc;
    const float a = __builtin_amdgcn_fmed3f(v.x, -448.f, 448.f), b = __builtin_amdgcn_fmed3f(v.y, -448.f, 448.f), c = __builtin_amdgcn_fmed3f(v.z, -448.f, 448.f), d = __builtin_amdgcn_fmed3f(v.w, -448.f, 448.f);
    int w = __builtin_amdgcn_cvt_pk_fp8_f32(a, b, 0, false); return __builtin_amdgcn_cvt_pk_fp8_f32(c, d, w, true); }
__device__ __forceinline__ float silu_fast2(float x) { return x * __builtin_amdgcn_rcpf(1.0f + __expf(-x)); }
__device__ __forceinline__ float log1p_fast(float e) { return e < 0.06f ? e * (1.0f - e * (0.5f - e * (0.33333333f - e * 0.25f))) : __logf(1.0f + e); }
__device__ __forceinline__ float softplus_(float x) { return fmaxf(x, 0.f) + log1p_fast(__expf(-fabsf(x))); }
__device__ __forceinline__ float gelu_tanh_(float x) { const float u = 0.7978845608028654f * (x + 0.044715f * x * x * x); return 0.5f * x * (1.0f + tanhf(u)); }
#define XB_TMO      128
#define XB_XCNT(j)  (256  + 64 * (j))
#define XB_XSUB(j)  (1280 + 64 * (j))
#define XB_XGEN(j)  (2304 + 64 * (j))
#define XB_TOP      3328
#define XB_TOPGEN   3392
#define XCD_BAR_WORDS 3456
#define XB_SPIN_CAP (1u << 18)

__device__ __forceinline__ unsigned xb_ld(unsigned* p)              { return __hip_atomic_load(p, __ATOMIC_RELAXED, __HIP_MEMORY_SCOPE_AGENT); }
__device__ __forceinline__ unsigned xb_add(unsigned* p, unsigned v) { return __hip_atomic_fetch_add(p, v, __ATOMIC_RELAXED, __HIP_MEMORY_SCOPE_AGENT); }
__device__ __forceinline__ unsigned xb_xcc_id() { return (unsigned)__builtin_amdgcn_s_getreg((3 << 11) | 20) & 0xFu; }
#define XB_SPIN(cond, bar) do { unsigned _sp = 0; while (cond) { __builtin_amdgcn_s_sleep(1); \
    if ((++_sp & 255u) == 0u) { if (xb_ld(&(bar)[XB_TMO])) break; if (_sp > XB_SPIN_CAP) { atomicAdd(&(bar)[XB_TMO], 1u); break; } } } } while (0)

struct XcdBarrier {
    unsigned* bar; unsigned x;
    volatile LAS unsigned* st;
};

__device__ __forceinline__ XcdBarrier xcd_barrier_post(unsigned* bar, volatile LAS unsigned* st, int tid) {
    XcdBarrier b; b.bar = bar; b.x = xb_xcc_id(); b.st = st;
    if (tid == 0) (void)xb_add(&bar[XB_XCNT(b.x)], 1u);
    return b;
}
__device__ __forceinline__ void xcd_barrier_complete(unsigned* bar, unsigned x, unsigned& nloc, unsigned& nx) {
    const unsigned G = gridDim.x * gridDim.y * gridDim.z;
    unsigned sum, cnt, mine, sp = 0u;
    for (;;) {
        sum = 0u; cnt = 0u; mine = 0u;
#pragma unroll
        for (unsigned j = 0; j < 16; ++j) { const unsigned c = xb_ld(&bar[XB_XCNT(j)]); sum += c; cnt += (c > 0u) ? 1u : 0u; mine = (j == x) ? c : mine; }
        if (sum == G) break;
        __builtin_amdgcn_s_sleep(1);
        if ((++sp & 255u) == 0u) { if (xb_ld(&bar[XB_TMO])) break; if (sp > XB_SPIN_CAP) { atomicAdd(&bar[XB_TMO], 1u); break; } }
    }
    nloc = mine > 0u ? mine : 1u; nx = cnt > 0u ? cnt : 1u;
}

__device__ __forceinline__ void xcd_barrier(const XcdBarrier& b, int tid) {
    asm volatile("s_waitcnt vmcnt(0)" ::: "memory");
    __syncthreads();
    if (tid == 0) {
        unsigned* bar = b.bar;
        __builtin_amdgcn_s_waitcnt(0);
        unsigned nloc = b.st[0], nx = b.st[1];
        if (nloc == 0u) { xcd_barrier_complete(bar, b.x, nloc, nx); b.st[0] = nloc; b.st[1] = nx; }
        const unsigned old = xb_add(&bar[XB_XSUB(b.x)], 1u);
        const unsigned gen = old / nloc;
        if (old + 1u == (gen + 1u) * nloc) {
            __builtin_amdgcn_fence(__ATOMIC_RELEASE, "agent");
            asm volatile("s_waitcnt vmcnt(0)" ::: "memory");
            const unsigned og = xb_add(&bar[XB_TOP], 1u);
            const unsigned tg = og / nx;
            if (og + 1u == (tg + 1u) * nx) xb_add(&bar[XB_TOPGEN], 1u);
            else XB_SPIN(xb_ld(&bar[XB_TOPGEN]) == tg, bar);
            __builtin_amdgcn_fence(__ATOMIC_ACQUIRE, "agent");
            xb_add(&bar[XB_XGEN(b.x)], 1u);
            asm volatile("s_waitcnt vmcnt(0)" ::: "memory");
        } else {
            XB_SPIN(xb_ld(&bar[XB_XGEN(b.x)]) == gen, bar);
            __builtin_amdgcn_fence(__ATOMIC_ACQUIRE, "agent");
            asm volatile("s_waitcnt vmcnt(0)" ::: "memory");
        }
    }
    __syncthreads();
}
namespace fox {
using bf16 = unsigned short;
constexpr int D = 128, QPITCH = 5376, KVPITCH = 5376, OPITCH = 2048;
constexpr bool WSKIP = false;
constexpr float THR = 8.f;
constexpr float SCALE = 0.08838834764831845f;
constexpr int NW = 8, QBLK = 32, KVBLK = 64, QB = NW * QBLK;
constexpr int SHM_V = KVBLK * D * 2, SHM_K = KVBLK * D * 2;
constexpr int ATT_LDS = 2 * SHM_V + 2 * SHM_K + NW * 64 * 4;
constexpr int FB_OFF = ATT_LDS;
constexpr int ATT_LDS_TOTAL = FB_OFF + 4096 * 8;
typedef short bf16x8 __attribute__((ext_vector_type(8)));
typedef short s16x4 __attribute__((ext_vector_type(4)));
typedef float f32x16 __attribute__((ext_vector_type(16)));
typedef float f32x4 __attribute__((ext_vector_type(4)));
typedef unsigned u32x4 __attribute__((ext_vector_type(4)));
template <class A, class Bt> struct same_t { static constexpr bool v = false; };
template <class A> struct same_t<A, A> { static constexpr bool v = true; };

#define KSWZ(row, colB) ((row) * 256 + ((colB) ^ (((row) & 7) << 4)))
#define SBAR() __builtin_amdgcn_sched_barrier(0)
__device__ __forceinline__ int v_st(int k, int c) { const int kk = (k & ~0xC) | ((k & 4) << 1) | ((k & 8) >> 1); return ((kk >> 3) * 4 + (c >> 5)) * 512 + ((kk & 7) * 32 + (c & 31)) * 2; }
__device__ __forceinline__ int v_rd_base(int lane) { return ((lane & 3) << 3) | (((lane >> 2) & 3) << 6) | (((lane >> 4) & 1) << 5) | (((lane >> 5) & 1) << 8); }
constexpr int v_rd_off(int d0, int ks, int half) { return d0 * 512 + ks * 4096 + half * 2048; }
__device__ __forceinline__ int crow(int r, int hi) { return (r & 3) + 8 * (r >> 2) + 4 * hi; }
__device__ __forceinline__ unsigned cvtpk(float lo, float hi) {
    unsigned r; asm volatile("v_cvt_pk_bf16_f32 %0, %1, %2" : "=v"(r) : "v"(lo), "v"(hi)); return r;
}
__device__ __forceinline__ bf16x8 pack8(f32x4 a, f32x4 b) {
    u32x4 w = {cvtpk(a[0], a[1]), cvtpk(a[2], a[3]), cvtpk(b[0], b[1]), cvtpk(b[2], b[3])};
    return *reinterpret_cast<bf16x8*>(&w);
}
template <class T> __device__ __forceinline__ bf16x8 load8(const T* p) {
    if constexpr (same_t<T, float>::v) { return pack8(*(const f32x4*)p, *(const f32x4*)(p + 4)); }
    else { return *reinterpret_cast<const bf16x8*>(p); }
}
__device__ __forceinline__ void mask_tile(f32x16& p0, f32x16& p1, int dq, unsigned W) {
    const float NEG = -__builtin_inff();
#pragma unroll
    for (int r = 0; r < 16; ++r) {
        const int c = (r & 3) + 8 * (r >> 2);
        if ((unsigned)(dq - c) >= W) p0[r] = NEG;
        if ((unsigned)(dq - c - 32) >= W) p1[r] = NEG;
    }
}
__device__ __forceinline__ void partialSM(f32x16& p0, f32x16& p1, float& m_reg, float& mn, float& alpha) {
    float pmax = p0[0]; for (int r = 1; r < 16; ++r) pmax = fmaxf(pmax, p0[r]); for (int r = 0; r < 16; ++r) pmax = fmaxf(pmax, p1[r]);
    { auto rr = __builtin_amdgcn_permlane32_swap(__float_as_uint(pmax), __float_as_uint(pmax), false, false);
      pmax = fmaxf(__uint_as_float(rr[0]), __uint_as_float(rr[1])); }
    constexpr float C2 = 1.4426950408889634f * SCALE;
    if (__builtin_expect(__all((pmax - m_reg) * SCALE <= THR), 1)) { mn = m_reg; alpha = 1.f; }
    else { mn = fmaxf(m_reg, pmax); alpha = __builtin_amdgcn_exp2f((m_reg - mn) * C2); m_reg = mn; }
    const float mnL = -mn * C2;
    for (int r = 0; r < 16; ++r) p0[r] = fmaf(p0[r], C2, mnL); for (int r = 0; r < 16; ++r) p1[r] = fmaf(p1[r], C2, mnL);
    for (int r = 0; r < 16; ++r) p0[r] = __builtin_amdgcn_exp2f(p0[r]);
}
__device__ __forceinline__ void finishSM(f32x16& p0, f32x16& p1, float alpha, float& l_reg, bf16x8& pa0, bf16x8& pa1, bf16x8& pa2, bf16x8& pa3) {
    for (int r = 0; r < 16; ++r) p1[r] = __builtin_amdgcn_exp2f(p1[r]);
    float ps = 0; for (int r = 0; r < 16; ++r) ps += p0[r]; for (int r = 0; r < 16; ++r) ps += p1[r];
    { auto rr = __builtin_amdgcn_permlane32_swap(__float_as_uint(ps), __float_as_uint(ps), false, false);
      ps = __uint_as_float(rr[0]) + __uint_as_float(rr[1]); }
    l_reg = l_reg * alpha + ps;
#define PK4(P, B_, OUT) do { unsigned a0 = cvtpk(P[B_+0], P[B_+1]), a1 = cvtpk(P[B_+2], P[B_+3]);                          \
        unsigned b0 = cvtpk(P[B_+4], P[B_+5]), b1 = cvtpk(P[B_+6], P[B_+7]);                                             \
        auto r0 = __builtin_amdgcn_permlane32_swap(a0, b0, false, false); auto r1 = __builtin_amdgcn_permlane32_swap(a1, b1, false, false); \
        u32x4 w = {r0[0], r1[0], r0[1], r1[1]}; OUT = *reinterpret_cast<bf16x8*>(&w); } while (0)
    PK4(p0, 0, pa0); PK4(p0, 8, pa1); PK4(p1, 0, pa2); PK4(p1, 8, pa3);
#undef PK4
}
template <int KB, bool SK>
__device__ __forceinline__ void qkt(f32x16& p0, f32x16& p1, const char* K_lds, int r32, int hi, const bf16x8* qr, bool act, const char* fbp) {
    if (SK && !act) { const float NEG = -__builtin_inff();
#pragma unroll
        for (int r = 0; r < 16; ++r) { p0[r] = NEG; p1[r] = NEG; } return; }
    p0 = f32x16{}; p1 = f32x16{};
    const char* kb[4];
#pragma unroll
    for (int dd = 0; dd < 4; ++dd) kb[dd] = K_lds + KB * SHM_K + KSWZ(r32, (dd * 16 + hi * 8) * 2);
#pragma unroll
    for (int d0 = 0; d0 < 8; ++d0) { const char* a = kb[d0 & 3] + (d0 >> 2) * 128;
        bf16x8 b0 = *reinterpret_cast<const bf16x8*>(a);
        bf16x8 b1 = *reinterpret_cast<const bf16x8*>(a + 32 * 256);
        p0 = __builtin_amdgcn_mfma_f32_32x32x16_bf16(b0, qr[d0], p0, 0, 0, 0);
        p1 = __builtin_amdgcn_mfma_f32_32x32x16_bf16(b1, qr[d0], p1, 0, 0, 0); }
#ifndef FOX_NO_BIAS
    { typedef unsigned u32x2 __attribute__((ext_vector_type(2)));
      const u32x2 f0 = *reinterpret_cast<const u32x2*>(fbp), f1 = *reinterpret_cast<const u32x2*>(fbp + 32 * 8);
      const unsigned m = hi ? 0u : 0xffffffffu;
      u32x4 a0 = {f0.x & m, f0.y & m, 0u, 0u}, a1 = {f1.x & m, f1.y & m, 0u, 0u}; u32x4 qa = {0x3f803f80u, 0x00003f80u, 0u, 0u};
      p0 = __builtin_amdgcn_mfma_f32_32x32x16_bf16(*reinterpret_cast<bf16x8*>(&a0), *reinterpret_cast<bf16x8*>(&qa), p0, 0, 0, 0);
      p1 = __builtin_amdgcn_mfma_f32_32x32x16_bf16(*reinterpret_cast<bf16x8*>(&a1), *reinterpret_cast<bf16x8*>(&qa), p1, 0, 0, 0); }
#endif
}
template <int VB, bool SK>
__device__ __forceinline__ void pv_tile(f32x16* o, int vb0, bf16x8 pa0, bf16x8 pa1, bf16x8 pa2, bf16x8 pa3, bool act) {
    if (SK && !act) return;
#define TRRD(dst, off) asm volatile("ds_read_b64_tr_b16 %0, %1 offset:%2" : "=&v"(dst) : "v"(vb0), "i"(off) : "memory")
#define PV_D0(d0) do { s16x4 l0, l1, l2, l3, h0, h1, h2, h3; constexpr int b_ = VB * SHM_V + v_rd_off(d0, 0, 0);     \
        TRRD(l0, b_); TRRD(h0, b_ + 2048); TRRD(l1, b_ + 4096); TRRD(h1, b_ + 6144); TRRD(l2, b_ + 8192); TRRD(h2, b_ + 10240); TRRD(l3, b_ + 12288); TRRD(h3, b_ + 14336); \
        asm volatile("s_waitcnt lgkmcnt(0)" ::: "memory"); SBAR();                 \
        o[d0] = __builtin_amdgcn_mfma_f32_32x32x16_bf16(pa0, (bf16x8){l0[0], l0[1], l0[2], l0[3], h0[0], h0[1], h0[2], h0[3]}, o[d0], 0, 0, 0);   \
        o[d0] = __builtin_amdgcn_mfma_f32_32x32x16_bf16(pa1, (bf16x8){l1[0], l1[1], l1[2], l1[3], h1[0], h1[1], h1[2], h1[3]}, o[d0], 0, 0, 0);   \
        o[d0] = __builtin_amdgcn_mfma_f32_32x32x16_bf16(pa2, (bf16x8){l2[0], l2[1], l2[2], l2[3], h2[0], h2[1], h2[2], h2[3]}, o[d0], 0, 0, 0);   \
        o[d0] = __builtin_amdgcn_mfma_f32_32x32x16_bf16(pa3, (bf16x8){l3[0], l3[1], l3[2], l3[3], h3[0], h3[1], h3[2], h3[3]}, o[d0], 0, 0, 0); } while (0)
    PV_D0(0); PV_D0(1); PV_D0(2); PV_D0(3);
#undef PV_D0
#undef TRRD
}

template <class TIn, class TOut> struct BlockRef { const TIn* Q; const TIn* K; const TIn* V; TOut* O; int P0; };
template <class TIn> struct Seam {
    bf16x8 qr[8];
    bf16x8 st_v0, st_v1, st_k0, st_k1; f32x4 sf0, sf1, sf2, sf3;
    f32x4 tq[16];
};
__device__ __forceinline__ int swa_jlo(int P0, int W) { const int lowk = P0 - W + 1; return lowk > 0 ? lowk / KVBLK : 0; }
#define ROW(p, k0, rr) ((p) + (size_t)((k0) + (rr)) * KVPITCH + sc)
#define VMW() asm volatile("s_waitcnt vmcnt(0)" ::: "memory")
#define VMWN(n) asm volatile("s_waitcnt vmcnt(%0)" :: "i"(n) : "memory")
#define SLOAD_H(Kp, Vp, k0) do { S.st_v0 = load8<TIn>(ROW(Vp, k0, sr)); S.st_v1 = load8<TIn>(ROW(Vp, k0, 32 + sr));              \
                         S.st_k0 = load8<TIn>(ROW(Kp, k0, sr)); S.st_k1 = load8<TIn>(ROW(Kp, k0, 32 + sr)); } while (0)
#define SWRITE_HK(bf) do { *(bf16x8*)(K_lds + (bf) * SHM_K + kws) = S.st_k0; *(bf16x8*)(K_lds + (bf) * SHM_K + kws + 32 * 256) = S.st_k1; } while (0)
#define SWRITE_HV(bf) do { *(bf16x8*)(V_lds + (bf) * SHM_V + vst0) = S.st_v0; *(bf16x8*)(V_lds + (bf) * SHM_V + vst1) = S.st_v1; } while (0)
#define SWRITE_H(bf) do { SWRITE_HV(bf); SWRITE_HK(bf); } while (0)
#define SLOAD_F(p, k0) do { S.sf0 = *(const f32x4*)ROW(p, k0, sr); S.sf1 = *(const f32x4*)(ROW(p, k0, sr) + 4);                \
                            S.sf2 = *(const f32x4*)ROW(p, k0, 32 + sr); S.sf3 = *(const f32x4*)(ROW(p, k0, 32 + sr) + 4); } while (0)
#define SWRITE_KF(bf) do { *(bf16x8*)(K_lds + (bf) * SHM_K + kws) = pack8(S.sf0, S.sf1); *(bf16x8*)(K_lds + (bf) * SHM_K + kws + 32 * 256) = pack8(S.sf2, S.sf3); } while (0)
#define SWRITE_VF(bf) do { *(bf16x8*)(V_lds + (bf) * SHM_V + vst0) = pack8(S.sf0, S.sf1); *(bf16x8*)(V_lds + (bf) * SHM_V + vst1) = pack8(S.sf2, S.sf3); } while (0)
template <class TIn, class TOut>
__device__ __forceinline__ void causal_swa_prime(const BlockRef<TIn, TOut>& cur, int W, char* lds, Seam<TIn>& S, int tid_in) {
    constexpr bool F32 = same_t<TIn, float>::v;
    const int tid_ = fresh_tid(tid_in  ); const int tid = tid_, wid = __builtin_amdgcn_readfirstlane(tid >> 6), lane = tid & 63, r32 = lane & 31, hi = lane >> 5;
    const int sr = tid >> 4, sc = (tid & 15) * 8, kws = KSWZ(sr, sc * 2); char* K_lds = lds + 2 * SHM_V;
    const int kb0 = swa_jlo(cur.P0, W) * KVBLK;
    for (int d0 = 0; d0 < 8; ++d0) S.qr[d0] = load8<TIn>(cur.Q + (size_t)(wid * QBLK + r32) * QPITCH + d0 * 16 + hi * 8);
    if constexpr (F32) { SLOAD_F((const float*)cur.K, kb0); VMW(); SWRITE_KF(0); SBAR(); SLOAD_F((const float*)cur.V, kb0); }
    else { SLOAD_H(cur.K, cur.V, kb0); VMW(); SWRITE_HK(0); }
    __syncthreads();
}
template <class TIn, class TOut>
__device__ __forceinline__ void causal_swa_block(const BlockRef<TIn, TOut>& cur, const BlockRef<TIn, TOut>& nxt, int skv, int W, char* lds, Seam<TIn>& S, int tid_in) {
    constexpr bool F32 = same_t<TIn, float>::v;
    const int tid_ = fresh_tid(tid_in  ); const int tid = tid_, wid = __builtin_amdgcn_readfirstlane(tid >> 6), lane = tid & 63, r32 = lane & 31, hi = lane >> 5;
    const int j_lo = swa_jlo(cur.P0, W);
    int j_hi = (cur.P0 + QB - 1) / KVBLK + 1; if (j_hi > skv / KVBLK) j_hi = skv / KVBLK;
    const int NT = j_hi - j_lo;
    const int kbn = swa_jlo(nxt.P0, W) * KVBLK;
    const int qlo = cur.P0 + wid * QBLK, qm = qlo + r32 - 4 * hi;
    char* V_lds = lds; char* K_lds = lds + 2 * SHM_V; const char* fbl = lds + FB_OFF + r32 * 8;
    float* ws = (float*)(lds + 2 * SHM_V + 2 * SHM_K) + wid * 64; float* li_l = ws, * al_l = ws + 32;
    float m_reg = -1e30f, l_reg = 0; f32x16 o[4] = {};
    const int sr = tid >> 4, sc = (tid & 15) * 8, vst0 = v_st(sr, sc), vst1 = v_st(32 + sr, sc), kws = KSWZ(sr, sc * 2);
    const int vb0 = (int)(uintptr_t)V_lds + v_rd_base(lane);
    const TIn* Kh = cur.K; const TIn* Vh = cur.V;
#define RESC(a) do { if (__any((a) < 1.f)) { if (hi == 0) al_l[r32] = (a); asm volatile("s_waitcnt lgkmcnt(0)" ::: "memory");              \
                     for (int d_ = 0; d_ < 4; ++d_) for (int r = 0; r < 16; ++r) o[d_][r] *= al_l[crow(r, hi)]; } } while (0)
#define KBASE(t) ((j_lo + (t)) * KVBLK)
#define ACT(t) (KBASE(t) <= qlo + QBLK - 1 && KBASE(t) + KVBLK - 1 >= qlo - W + 1)
#define MASKT(P0_, P1_, t) do { const int kb_ = KBASE(t); if ((!SK || ACT(t)) && (kb_ + KVBLK - 1 > qlo || kb_ <= qlo + QBLK - 1 - W)) mask_tile(P0_, P1_, qm - kb_, (unsigned)W); } while (0)
    constexpr int NQL = F32 ? 16 : 8;
    constexpr bool SK = WSKIP && !F32;
#define SEAM_K0() do { VMWN(NQL); if constexpr (F32) { SWRITE_KF(0); SBAR(); SLOAD_F((const float*)nxt.V, kbn); } else { SWRITE_HK(0); } SBAR(); } while (0)
    f32x16 pA0, pA1, pB0, pB1; float mnA, mnB, alA, alB; bf16x8 pa0, pa1, pa2, pa3;
    if constexpr (F32) { VMW(); SWRITE_VF(0); SBAR(); } else { SWRITE_HV(0); SBAR(); }
    if (NT > 1) { if constexpr (F32) SLOAD_F((const float*)Kh, KBASE(1)); else SLOAD_H(Kh, Vh, KBASE(1)); }
    SBAR(); qkt<0, SK>(pA0, pA1, K_lds, r32, hi, S.qr, ACT(0), fbl + KBASE(0) * 8);
    if constexpr (F32) { if (NT > 1) { VMW(); SWRITE_KF(1); SBAR(); SLOAD_F((const float*)Vh, KBASE(1)); } }
    MASKT(pA0, pA1, 0); partialSM(pA0, pA1, m_reg, mnA, alA);
    if (NT > 1) { VMW(); if constexpr (F32) { SWRITE_VF(1); SBAR(); if (NT > 2) SLOAD_F((const float*)Kh, KBASE(2)); } else SWRITE_H(1); }
    __syncthreads();
#define HALF_STEP(PX0, PX1, mnX, alX, PY0, PY1, alY, t, KB, VB, SB) do {                                                      \
        SBAR(); qkt<KB, SK>(PX0, PX1, K_lds, r32, hi, S.qr, ACT(t), fbl + KBASE(t) * 8);                                             \
        finishSM(PY0, PY1, alY, l_reg, pa0, pa1, pa2, pa3); SBAR();                                                           \
        if ((t) + 1 < NT) { if constexpr (F32) { VMW(); SWRITE_KF(SB); SBAR(); SLOAD_F((const float*)Vh, KBASE((t) + 1)); }  \
                            else { SLOAD_H(Kh, Vh, KBASE((t) + 1)); } SBAR(); }                                               \
        pv_tile<VB, SK>(o, vb0, pa0, pa1, pa2, pa3, ACT((t) - 1)); MASKT(PX0, PX1, (t)); partialSM(PX0, PX1, m_reg, mnX, alX);                                        \
        __syncthreads();                                                                                                      \
        if ((t) + 1 < NT) { VMW(); if constexpr (F32) { SWRITE_VF(SB); SBAR(); if ((t) + 2 < NT) SLOAD_F((const float*)Kh, KBASE((t) + 2)); } \
                            else { SWRITE_H(SB); } }                                                                          \
        RESC(alX); __syncthreads(); } while (0)
    for (int t = 1; t + 1 < NT; t += 2) {
        HALF_STEP(pB0, pB1, mnB, alB, pA0, pA1, alA, t, 1, 0, 0);
        HALF_STEP(pA0, pA1, mnA, alA, pB0, pB1, alB, t + 1, 0, 1, 1);
    }
    const bool even = (NT & 1) == 0;
    if (even) { SBAR(); qkt<1, SK>(pB0, pB1, K_lds, r32, hi, S.qr, ACT(NT - 1), fbl + KBASE(NT - 1) * 8); SBAR(); }
#define QROW(e) (nxt.Q + (size_t)(wid * QBLK + r32) * QPITCH + ((e) >> 1) * 16 + hi * 8 + ((e) & 1) * 4)
    if constexpr (F32) { SLOAD_F((const float*)nxt.K, kbn); SBAR();
#pragma unroll
        for (int e = 0; e < 8; ++e) S.tq[e] = *(const f32x4*)QROW(e); }
    else { SLOAD_H(nxt.K, nxt.V, kbn); SBAR();
#pragma unroll
        for (int d0 = 0; d0 < 8; ++d0) S.qr[d0] = load8<TIn>(nxt.Q + (size_t)(wid * QBLK + r32) * QPITCH + d0 * 16 + hi * 8); }
    SBAR();
    finishSM(pA0, pA1, alA, l_reg, pa0, pa1, pa2, pa3); SBAR();
    if constexpr (F32) {
#pragma unroll
        for (int e = 8; e < 16; ++e) S.tq[e] = *(const f32x4*)QROW(e); SBAR(); }
#undef QROW
    pv_tile<0, SK>(o, vb0, pa0, pa1, pa2, pa3, ACT(even ? NT - 2 : NT - 1));
    if (even) { MASKT(pB0, pB1, NT - 1); partialSM(pB0, pB1, m_reg, mnB, alB); __syncthreads(); RESC(alB);
        finishSM(pB0, pB1, alB, l_reg, pa0, pa1, pa2, pa3); SBAR(); pv_tile<1, SK>(o, vb0, pa0, pa1, pa2, pa3, ACT(NT - 1)); }
    SBAR(); SEAM_K0();
    if (hi == 0) li_l[r32] = l_reg; asm volatile("s_waitcnt lgkmcnt(0)" ::: "memory");
    float rli[16];
#pragma unroll
    for (int r = 0; r < 16; ++r) rli[r] = __builtin_amdgcn_rcpf(li_l[crow(r, hi)]);
    TOut* Ow = cur.O + (size_t)(wid * QBLK) * OPITCH;
#pragma unroll
    for (int r = 0; r < 16; ++r) { const int orow = crow(r, hi);
#pragma unroll
        for (int d0 = 0; d0 < 4; ++d0) { const float v = o[d0][r] * rli[r];
            if constexpr (same_t<TOut, float>::v) { Ow[(size_t)orow * OPITCH + d0 * 32 + r32] = v; }
            else { const float vn = shfl_xor_l(v, 1, lane);
                   if ((r32 & 1) == 0) { if (F8_HY_OUT) *(unsigned short*)((unsigned char*)cur.O + (size_t)(wid * QBLK + orow) * OPITCH + d0 * 32 + r32) = (unsigned short)__builtin_amdgcn_cvt_pk_fp8_f32(__builtin_amdgcn_fmed3f(4.0f * v, -448.f, 448.f), __builtin_amdgcn_fmed3f(4.0f * vn, -448.f, 448.f), 0, false);
                                          else *(unsigned*)(Ow + (size_t)orow * OPITCH + d0 * 32 + r32) = cvtpk(v, vn); } } } }
    if constexpr (F32) {
#pragma unroll
        for (int d0 = 0; d0 < 8; ++d0) S.qr[d0] = pack8(S.tq[2 * d0], S.tq[2 * d0 + 1]); }
    __syncthreads();
#undef RESC
#undef KBASE
#undef ACT
#undef MASKT
#undef SEAM_K0
#undef HALF_STEP
}
#undef ROW
#undef VMW
#undef VMWN
#undef SLOAD_H
#undef SWRITE_HK
#undef SWRITE_HV
#undef SWRITE_H
#undef SLOAD_F
#undef SWRITE_KF
#undef SWRITE_VF

__device__ __forceinline__ void bias_table(char* lds, const float* fl  , float bf, int nkeys, int tid) {
    asm volatile("" : "+v"(tid));
    typedef unsigned u32x2 __attribute__((ext_vector_type(2)));
    float* wsum = (float*)(lds + FB_OFF + 4096 * 8); u32x2* FB = (u32x2*)(lds + FB_OFF);
    const int lane = tid & 63, wave = tid >> 6; float lf[8];
#pragma unroll
    for (int i = 0; i < 8; ++i) { const int s = 8 * tid + i; float v = 0.f;
        if (s < nkeys) { const float x = fl[(size_t)s * 8] + bf; const float e = __expf(-x); v = -(x < -20.f ? -x : (e < 0.06f ? e * (1.0f - e * (0.5f - e * (0.33333333f - e * 0.25f))) : __logf(1.0f + e))); }
        lf[i] = v; }
#pragma unroll
    for (int i = 1; i < 8; ++i) lf[i] += lf[i - 1];
    const float tot = lf[7]; float sc = tot;
#pragma unroll
    for (int o = 1; o < 64; o <<= 1) { const float u = shfl_up_l(sc, o, lane); if (lane >= o) sc += u; }
    if (lane == 63) wsum[wave] = sc;
    __syncthreads();
    float base = sc - tot;
    for (int w = 0; w < wave; ++w) base += wsum[w];
#pragma unroll
    for (int i = 0; i < 8; ++i) { const int s = 8 * tid + i; const float G = -(base + lf[i]) * (1.0f / SCALE);
        unsigned u = __float_as_uint(G); const unsigned h16 = (u + 0x7fffu + ((u >> 16) & 1u)) >> 16; const float r1 = G - __uint_as_float(h16 << 16);
        u = __float_as_uint(r1); const unsigned m16 = (u + 0x7fffu + ((u >> 16) & 1u)) >> 16; const float r2 = r1 - __uint_as_float(m16 << 16);
        u = __float_as_uint(r2); const unsigned l16 = (u + 0x7fffu + ((u >> 16) & 1u)) >> 16;
        FB[s] = (u32x2){h16 | (m16 << 16), l16}; }
    __syncthreads();
}
__device__ __forceinline__ void attn_item(char* lds, const unsigned short* PROJ, const float* FLB, unsigned short* YMIX, const float* b_f, int item, int tid) {
    const int bh = item >> 3, x = item & 7, b = bh >> 3, h = bh & 7;
    const unsigned short* base = PROJ + (size_t)b * 4096 * KVPITCH + h * 128;
    bias_table(lds, FLB + (size_t)b * 4096 * 8 + h, b_f[h], (16 - x) * QB, tid);
    typedef BlockRef<bf16, bf16> Ref;
    Ref r0, r1;
    r0.Q = base + 2048 + (size_t)(x * QB) * QPITCH; r0.K = base + 3072; r0.V = base + 4096; r0.O = F8_HY_OUT ? (unsigned short*)((unsigned char*)YMIX + ((size_t)b * 4096 + x * QB) * OPITCH + 1024 + h * 128) : YMIX + ((size_t)b * 4096 + x * QB) * OPITCH + 1024 + h * 128; r0.P0 = x * QB;
    r1 = r0; r1.Q = base + 2048 + (size_t)((15 - x) * QB) * QPITCH; r1.O = F8_HY_OUT ? (unsigned short*)((unsigned char*)YMIX + ((size_t)b * 4096 + (15 - x) * QB) * OPITCH + 1024 + h * 128) : YMIX + ((size_t)b * 4096 + (15 - x) * QB) * OPITCH + 1024 + h * 128; r1.P0 = (15 - x) * QB;
    Seam<bf16> S; const int wv = __builtin_amdgcn_readfirstlane(tid >> 6);
    causal_swa_prime<bf16, bf16>(r0, 4096, lds, S, wv);
    Ref cur = r0;
    for (int pass = 0; pass < 2; ++pass) {
        causal_swa_block<bf16, bf16>(cur, r1, 4096, 4096, lds, S, wv);
        cur = r1;
    }
    asm volatile("s_waitcnt vmcnt(0)" ::: "memory");
    __syncthreads();
}
}
struct Ctx {
    LAS unsigned char* lds;
    volatile LAS unsigned* MISC;
    gu32* ctl;
    int tid, lane, wave, vcu, G;
    const float* in[28];
    float* out; unsigned char* ws;
};
__device__ __forceinline__ float wave_max(float v) {
#pragma unroll
    for (int o = 1; o < 64; o <<= 1) v = fmaxf(v, __shfl_xor(v, o));
    return v;
}
__device__ __forceinline__ float wave_sum_dpp(float v) {
    v += __builtin_bit_cast(float, __builtin_amdgcn_update_dpp(0, __builtin_bit_cast(int, v), 0x111, 0xf, 0xf, true));
    v += __builtin_bit_cast(float, __builtin_amdgcn_update_dpp(0, __builtin_bit_cast(int, v), 0x112, 0xf, 0xf, true));
    v += __builtin_bit_cast(float, __builtin_amdgcn_update_dpp(0, __builtin_bit_cast(int, v), 0x114, 0xf, 0xf, true));
    v += __builtin_bit_cast(float, __builtin_amdgcn_update_dpp(0, __builtin_bit_cast(int, v), 0x118, 0xf, 0xf, true));
    v += __builtin_bit_cast(float, __builtin_amdgcn_update_dpp(0, __builtin_bit_cast(int, v), 0x142, 0xa, 0xf, false));
    v += __builtin_bit_cast(float, __builtin_amdgcn_update_dpp(0, __builtin_bit_cast(int, v), 0x143, 0xc, 0xf, false));
    return __builtin_bit_cast(float, __builtin_amdgcn_readlane(__builtin_bit_cast(int, v), 63));
}
__device__ __forceinline__ float wave_sum(float v, int lane) {
#pragma unroll
    for (int o = 1; o < 64; o <<= 1) v += shfl_xor_l(v, o, lane);
    return v;
}
__device__ __forceinline__ float wave_sum(float v) {
#pragma unroll
    for (int o = 1; o < 64; o <<= 1) v += __shfl_xor(v, o);
    return v;
}
struct CvtJob { const float* W; bf16_t* WT; int K, N, mode, row_off, nblk, item, f8; };
__device__ __forceinline__ void cvt_load(const CvtJob& j, int lane, f32x4 (&v)[8]) {
    const int kb = j.item / j.nblk, nb = j.item - kb * j.nblk, k0 = 64 * kb, n0 = 32 * nb;
    const int c4 = (lane & 7) * 4, nn = n0 + c4; const bool ok = nn < j.N;
#pragma unroll
    for (int i = 0; i < 8; ++i) { const int kk = 8 * i + (lane >> 3); v[i] = ok ? __builtin_nontemporal_load((const GAS f32x4*)(j.W + (size_t)(k0 + kk) * j.N + nn)) : (f32x4){0.f, 0.f, 0.f, 0.f}; }
}
__device__ __forceinline__ void cvt_finish(const CvtJob& j, const f32x4 (&v)[8], LAS float* scr, int lane) {
    const int kb = j.item / j.nblk, nb = j.item - kb * j.nblk, k0 = 64 * kb, n0 = 32 * nb; const int c4 = (lane & 7) * 4;
#pragma unroll
    for (int i = 0; i < 8; ++i) { const int kk = 8 * i + (lane >> 3); LAS float* d = scr + kk * 33 + c4; d[0] = v[i].x; d[1] = v[i].y; d[2] = v[i].z; d[3] = v[i].w; }
    LDS_WAIT(); asm volatile("" ::: "memory");
    if (j.f8) {
        const int n = lane >> 1, hf = lane & 1; const LAS float* sp = scr + (32 * hf) * 33 + n; v4u o[2];
#pragma unroll
        for (int q = 0; q < 8; ++q) { int w = __builtin_amdgcn_cvt_pk_fp8_f32(__builtin_amdgcn_fmed3f(sp[(4 * q) * 33] * 128.0f, -448.f, 448.f), __builtin_amdgcn_fmed3f(sp[(4 * q + 1) * 33] * 128.0f, -448.f, 448.f), 0, false);
            w = __builtin_amdgcn_cvt_pk_fp8_f32(__builtin_amdgcn_fmed3f(sp[(4 * q + 2) * 33] * 128.0f, -448.f, 448.f), __builtin_amdgcn_fmed3f(sp[(4 * q + 3) * 33] * 128.0f, -448.f, 448.f), w, true);
            o[q >> 2][q & 3] = (unsigned)w; }
        const int ns = n0 + n; const int drow = j.mode == 0 ? j.row_off + ns : ((ns >> 7) * 256 + (ns & 127) + (j.mode == 2 ? 128 : 0));
        GAS v4u* dst = (GAS v4u*)((unsigned char*)j.WT + (size_t)drow * j.K + k0 + 32 * hf); dst[0] = o[0]; dst[1] = o[1];
        LDS_WAIT(); asm volatile("" ::: "memory"); return; }
    const int c = lane & 7;
#pragma unroll
    for (int q = 0; q < 4; ++q) { const int n = (lane >> 3) + 8 * q; const LAS float* sp = scr + (8 * c) * 33 + n;
        v4u o; o.x = pk2(sp[0 * 33], sp[1 * 33]); o.y = pk2(sp[2 * 33], sp[3 * 33]); o.z = pk2(sp[4 * 33], sp[5 * 33]); o.w = pk2(sp[6 * 33], sp[7 * 33]);
        const int ns = n0 + n; const int drow = j.mode == 0 ? j.row_off + ns : ((ns >> 7) * 256 + (ns & 127) + (j.mode == 2 ? 128 : 0));
        *(GAS v4u*)(j.WT + (size_t)drow * j.K + k0 + 8 * c) = o; }
    LDS_WAIT(); asm volatile("" ::: "memory");
}
__device__ __forceinline__ void cvt_item(const float* W, int K, int N, bf16_t* WT, int mode, int row_off, LAS float* scr, int item, int nblk, int lane, int f8 = 0) {
    const CvtJob j{W, WT, K, N, mode, row_off, nblk, item, f8}; f32x4 v[8]; cvt_load(j, lane, v); cvt_finish(j, v, scr, lane);
}
constexpr int MOE_CVT_ITEMS = 48 * 1024;
__device__ __forceinline__ CvtJob moe_cvt_job(Ctx& F, int layer, int it) {
    unsigned char* WGU = F.ws + ((layer & 1) ? WS_WGU_B : WS_WGU); unsigned char* WD = F.ws + ((layer & 1) ? WS_WD_B : WS_WD);
    const float* wg = F.in[25] + (size_t)layer * 16 * 2048 * 1024; const float* wu = F.in[26] + (size_t)layer * 16 * 2048 * 1024; const float* wd = F.in[27] + (size_t)layer * 16 * 1024 * 2048;
    const int mat = it >> 10, r0 = it & 1023, E = mat / 3, which = mat - 3 * E;
    const int nblk_ = which == 2 ? 64 : 32, p_ = r0 >> 1, r = (2 * (p_ / nblk_) + (r0 & 1)) * nblk_ + (p_ % nblk_);
    if (which == 0) return CvtJob{wg + (size_t)E * 2048 * 1024, (bf16_t*)(WGU + (size_t)E * 2048 * 2048), 2048, 1024, 1, 0, 32, r, 1};
    if (which == 1) return CvtJob{wu + (size_t)E * 2048 * 1024, (bf16_t*)(WGU + (size_t)E * 2048 * 2048), 2048, 1024, 2, 0, 32, r, 1};
    return CvtJob{wd + (size_t)E * 1024 * 2048, (bf16_t*)(WD + (size_t)E * 2048 * 1024), 1024, 2048, 0, 0, 64, r, 1};
}
__device__ __forceinline__ void moe_cvt_pair(Ctx& F, int layer, int itA, int itB, LAS float* scr) {
    const bool hasB = itB < MOE_CVT_ITEMS; const CvtJob ja = moe_cvt_job(F, layer, itA), jb = moe_cvt_job(F, layer, hasB ? itB : itA);
    f32x4 va[8], vb[8]; cvt_load(ja, F.lane, va); cvt_load(jb, F.lane, vb);
    cvt_finish(ja, va, scr, F.lane); if (hasB) cvt_finish(jb, vb, scr, F.lane);
}
__device__ __forceinline__ void moe_cvt_item(Ctx& F, int layer, int it, LAS float* scr) { const CvtJob j = moe_cvt_job(F, layer, it); f32x4 v[8]; cvt_load(j, F.lane, v); cvt_finish(j, v, scr, F.lane); }
__device__ __forceinline__ int moe_ntiles(Ctx& F, int layer) { int acc = 0;
#pragma unroll
    for (int e = 0; e < 16; ++e) { const unsigned c = __hip_atomic_load((unsigned*)(F.ctl + CW_CNT + layer * 16 + e), RLX_AGENT); acc += (int)((c + 255u) >> 8); }
    return __builtin_amdgcn_readfirstlane(acc); }
__device__ __forceinline__ int moe_cvt_done(Ctx& F, int layer) {
    if (layer == 0) return 0;
    const int h = (int)__hip_atomic_load((unsigned*)(F.ctl + CW_CVTHEAD + layer * 64), RLX_AGENT); return __builtin_amdgcn_readfirstlane(h < MOE_CVT_ITEMS ? h : MOE_CVT_ITEMS);
}
__device__ __forceinline__ int moe_gemm_wgs(Ctx& F, int ntiles, bool has_next) {
    const int U = 8 * ntiles; if (!has_next || U == 0) return F.G;
    const int rounds = (U + F.G - 1) / F.G; return (U + rounds - 1) / rounds; }
__device__ __forceinline__ void moe_tail_convert(Ctx& F, int next_layer, int Gg, int which) {
    const int rem = Gg; if (rem >= F.G) return;
    F.tid = fresh_tid(F.wave); F.lane = F.tid & 63;
    unsigned* done = (unsigned*)(F.ctl + CW_DONE + ((next_layer - 1) * 2 + which) * 64); unsigned* head = (unsigned*)(F.ctl + CW_CVTHEAD + next_layer * 64);
    if ((int)blockIdx.x < rem) { if (F.tid == 0) (void)__hip_atomic_fetch_add(done, 1u, RLX_AGENT); return; }
    LAS float* scr = (LAS float*)(F.lds + RING_OFF + F.wave * 16384); volatile LAS int* slot = (volatile LAS int*)(F.lds + RING_OFF + 8 * 16384);
    for (;;) {
        if (F.tid == 0) { int c = -1; if ((int)__hip_atomic_load(done, RLX_AGENT) < rem) c = (int)__hip_atomic_fetch_add(head, 16u, RLX_AGENT); *slot = c; }
        __syncthreads();
        const int c = *slot;
        if (c < 0 || c >= MOE_CVT_ITEMS) break;
        moe_cvt_pair(F, next_layer, c + 2 * F.wave, c + 2 * F.wave + 1, scr);
        __syncthreads();
    }
}
__device__ __forceinline__ void s0_convert(Ctx& F, int layer) {
    LAS float* scr = (LAS float*)(F.lds + RING_OFF + F.wave * 16384);
    const int gw = F.vcu * NWAVES + F.wave, NGW = F.G * NWAVES;
    for (int it = moe_cvt_done(F, layer) + 2 * gw; it < MOE_CVT_ITEMS; it += 2 * NGW) moe_cvt_pair(F, layer, it, it + 1, scr);
    if (layer == 0) {
        constexpr int I_HI = 32 * (HY_NP / 32), I_HO = 32 * 64, I_SI = 32 * (SS_NP / 32), I_SO = 64 * 64, I_RI = 2 * 4;
        constexpr int NIT = 2 * I_HI + 2 * I_HO + 2 * I_SI + 2 * I_SO + 32 * I_RI;
        for (int it = gw; it < NIT; it += NGW) {
            int r = it;
            if (r < 2 * I_HI) { const int j = r / I_HI; r -= j * I_HI; const bool f8 = F8_HY_IN && (r % (HY_NP / 32)) * 32 < 5120;
                cvt_item(F.in[3] + (size_t)j * 2048 * HY_N, 2048, HY_N, f8 ? (bf16_t*)(F.ws + WS_WHYIN8 + (size_t)j * 5120 * 2048) : (bf16_t*)(F.ws + WS_WHYIN) + (size_t)j * HY_NP * 2048, 0, 0, scr, r, HY_NP / 32, F.lane, f8); continue; } r -= 2 * I_HI;
            if (r < 2 * I_HO) { const int j = r / I_HO; r -= j * I_HO; cvt_item(F.in[12] + (size_t)j * 2048 * 2048, 2048, 2048, F8_HY_OUT ? (bf16_t*)(F.ws + WS_WHYOUT + (size_t)j * 2048 * 2048) : (bf16_t*)(F.ws + WS_WHYOUT) + (size_t)j * 2048 * 2048, 0, 0, scr, r, 64, F.lane, F8_HY_OUT); continue; } r -= 2 * I_HO;
            if (r < 2 * I_SI) { const int j = r / I_SI; r -= j * I_SI; const bool f8 = F8_SS_IN && (r % (SS_NP / 32)) * 32 < 10240;
                cvt_item(F.in[13] + (size_t)j * 2048 * SS_N, 2048, SS_N, f8 ? (bf16_t*)(F.ws + WS_WSSIN8 + (size_t)j * 10240 * 2048) : (bf16_t*)(F.ws + WS_WSSIN) + (size_t)j * SS_NP * 2048, 0, 0, scr, r, SS_NP / 32, F.lane, f8); continue; } r -= 2 * I_SI;
            if (r < 2 * I_SO) { const int j = r / I_SO; r -= j * I_SO; cvt_item(F.in[20] + (size_t)j * 4096 * 2048, 4096, 2048, F8_SS_OUT ? (bf16_t*)(F.ws + WS_WSSOUT + (size_t)j * 2048 * 4096) : (bf16_t*)(F.ws + WS_WSSOUT) + (size_t)j * 2048 * 4096, 0, 0, scr, r, 64, F.lane, F8_SS_OUT); continue; } r -= 2 * I_SO;
            { const int m = r / I_RI; r -= m * I_RI; const int jh = m >> 1, which = m & 1;
              cvt_item((which ? F.in[8] : F.in[6]) + (size_t)jh * 128 * 128, 128, 128, (bf16_t*)(F.ws + WS_WRI) + (size_t)jh * 256 * 128, 0, which * 128, scr, r, 4, F.lane); }
        }
        { bf16_t* WH = (bf16_t*)(F.ws + WS_WRT); bf16_t* WL = WH + 4 * 32 * 2048;
          for (int i = blockIdx.x * NTHR + F.tid; i < 4 * 32 * 2048; i += F.G * NTHR) { const int k = i & 2047, n = (i >> 11) & 31, L = i >> 16;
              const float v = n < 4 ? F.in[21][((size_t)L * 2048 + k) * 4 + n] : n < 20 ? F.in[23][(((size_t)L * 4 + ((n - 4) >> 2)) * 2048 + k) * 4 + ((n - 4) & 3)] : 0.f;
              const unsigned h = f2bf(v); WH[i] = (bf16_t)h; WL[i] = (bf16_t)f2bf(v - __uint_as_float(h << 16)); } }
        { float* LK = (float*)(F.ws + WS_TOKPOS); for (int i = blockIdx.x * NTHR + F.tid; i < 2 * 1024; i += F.G * NTHR) LK[i] = -8.0f * softplus_(-F.in[10][i]); }
        const float* x = F.in[0]; bf16_t* XB = (bf16_t*)(F.ws + WS_XB);
        for (int m = gw; m < T; m += NGW) { const GAS f32x4* xr = (const GAS f32x4*)(x + (size_t)m * D) + F.lane; GAS v2u* o = (GAS v2u*)(XB + (size_t)m * D) + F.lane;
#pragma unroll
            for (int j = 0; j < 8; ++j) { const f32x4 v = xr[64 * j]; v2u w; w.x = pk2(v.x, v.y); w.y = pk2(v.z, v.w); o[64 * j] = w;
                ((GAS int*)(F.ws + WS_XIN8 + (size_t)m * D))[F.lane + 64 * j] = pk_fp8x4(v, 4.0f); } }
    }
}
template <bool DRY = false> __device__ __forceinline__ void ln1_router(Ctx& F, int layer) {
    const int tid = fresh_tid(F.wave);
    const int lane = tid & 63, wave = __builtin_amdgcn_readfirstlane(tid >> 6), fr = lane & 15, fq = lane >> 4;
    const float* xin = F.in[0]; bf16_t* XB = (bf16_t*)(F.ws + WS_XB); bf16_t* XBO = DRY ? (bf16_t*)(F.ws + WS_ARENA + 944 * MiB) : XB;
    const float* gam = F.in[1] + (size_t)(layer * 2) * D; const float* bet = F.in[2] + (size_t)(layer * 2) * D;
    const bf16_t* MB = (const bf16_t*)(F.ws + WS_MBUF);
    LAS unsigned char* XH = F.lds + RING_OFF; LAS unsigned char* XL = F.lds + RING_OFF + 65536;
    LAS float* PART = (LAS float*)(F.lds + RING_OFF);
    LAS float* LG = (LAS float*)(F.lds + RING_OFF + 131072);
    LAS int* hist = (LAS int*)(F.lds + MISC_OFF + 256); LAS int* hbase = hist + 16; LAS int* sE = hist + 32; LAS int* sI = sE + 128; LAS float* sW = (LAS float*)(sI + 128);
    if (tid < 16) hist[tid] = 0;
    LAS f32x4* GL = (LAS f32x4*)(F.lds + RING_OFF + 135168); LAS f32x4* BL = GL + 512;
    GL[tid] = ((const GAS f32x4*)gam)[tid]; BL[tid] = ((const GAS f32x4*)bet)[tid];
    __syncthreads();
    const bf16_t* WH = (const bf16_t*)(F.ws + WS_WRT) + (size_t)layer * 32 * 2048; const bf16_t* WL = WH + 4 * 32 * 2048;
    const int rbase = blockIdx.x * 64;
    const int nb_ = tid & 31; const float lbias = nb_ < 4 ? F.in[22][layer * 4 + nb_] : nb_ < 20 ? F.in[24][layer * 16 + nb_ - 4] : 0.f;
    v2u xh[2][8], mh[2][8];
#define LN1_LOAD(bt_) do { _Pragma("unroll") for (int rr_ = 0; rr_ < 2; ++rr_) { const int row_ = rbase + (bt_) * 16 + 2 * wave + rr_; \
        const GAS v2u* xb_ = (const GAS v2u*)(XB + (size_t)row_ * D) + lane; const GAS v2u* mr_ = (const GAS v2u*)(MB + (size_t)row_ * D) + lane; \
        _Pragma("unroll") for (int j_ = 0; j_ < 8; ++j_) { xh[rr_][j_] = xb_[64 * j_]; mh[rr_][j_] = __builtin_nontemporal_load(mr_ + 64 * j_); } } } while (0)
#define LN1_BAR() do { asm volatile("s_waitcnt lgkmcnt(0)" ::: "memory"); __builtin_amdgcn_s_barrier(); asm volatile("" ::: "memory"); } while (0)
    LN1_LOAD(0);
#pragma unroll 1
    for (int bt = 0; bt < 4; ++bt) {
        f32x4 v[2][8];
#pragma unroll
        for (int rr = 0; rr < 2; ++rr) { const int row = rbase + bt * 16 + 2 * wave + rr;
            {
#pragma unroll
                for (int j = 0; j < 8; ++j) { const v2u xw = xh[rr][j]; const v2u mw = mh[rr][j];
                    v[rr][j].x = ALPHA * bflo(xw.x) + bflo(mw.x); v[rr][j].y = ALPHA * bfhi(xw.x) + bfhi(mw.x); v[rr][j].z = ALPHA * bflo(xw.y) + bflo(mw.y); v[rr][j].w = ALPHA * bfhi(xw.y) + bfhi(mw.y); }
            } (void)row; }
#pragma unroll
        for (int rr = 0; rr < 2; ++rr) { const int lr = 2 * wave + rr, row = rbase + bt * 16 + lr; float s = 0.f;
#pragma unroll
            for (int j = 0; j < 8; ++j) s += (v[rr][j].x + v[rr][j].y) + (v[rr][j].z + v[rr][j].w);
            const float mean = wave_sum_dpp(s) * (1.f / D); float s2 = 0.f;
#pragma unroll
            for (int j = 0; j < 8; ++j) { v[rr][j] = v[rr][j] - mean; s2 += (v[rr][j].x * v[rr][j].x + v[rr][j].y * v[rr][j].y) + (v[rr][j].z * v[rr][j].z + v[rr][j].w * v[rr][j].w); }
            const float rstd = 1.f / sqrtf(wave_sum_dpp(s2) * (1.f / D) + LN_EPS);
            GAS v2u* bo = (GAS v2u*)(XBO + (size_t)row * D) + lane;
#pragma unroll
            for (int j = 0; j < 8; ++j) { const f32x4 gj = GL[lane + 64 * j], bj = BL[lane + 64 * j]; const f32x4 y = v[rr][j] * rstd * gj + bj;
                const unsigned h0 = f2bf(y.x), h1 = f2bf(y.y), h2 = f2bf(y.z), h3 = f2bf(y.w); v2u hw; hw.x = h0 | (h1 << 16); hw.y = h2 | (h3 << 16); bo[64 * j] = hw;
                ((GAS int*)(F.ws + WS_XB8 + (size_t)row * D))[lane + 64 * j] = pk_fp8x4(y, 4.0f);
                v2u lw; lw.x = pk2(y.x - __uint_as_float(h0 << 16), y.y - __uint_as_float(h1 << 16)); lw.y = pk2(y.z - __uint_as_float(h2 << 16), y.w - __uint_as_float(h3 << 16));
                const int cidx = (lane >> 1) + 32 * j; const int off = lr * 4096 + ((cidx ^ lr) << 4) + (lane & 1) * 8;
                *(LAS v2u*)(XH + off) = hw; *(LAS v2u*)(XL + off) = lw; } }
        LN1_BAR();
        f32x4 acc[2] = {(f32x4){0.f, 0.f, 0.f, 0.f}, (f32x4){0.f, 0.f, 0.f, 0.f}};
        int wofs = fr * 2048 + 256 * wave + 8 * fq; asm volatile("" : "+v"(wofs));
#pragma unroll
        for (int ks = 0; ks < 8; ++ks) { const int k0 = 256 * wave + 32 * ks + 8 * fq; const int off = fr * 4096 + ((((k0 >> 3)) ^ fr) << 4);
            const bf16x8 xh = *(const LAS bf16x8*)(XH + off), xl = *(const LAS bf16x8*)(XL + off);
#pragma unroll
            for (int nt = 0; nt < 2; ++nt) { const bf16x8 wh = *(const GAS bf16x8*)(WH + wofs + nt * 16 * 2048 + 32 * ks), wl = *(const GAS bf16x8*)(WL + wofs + nt * 16 * 2048 + 32 * ks);
                acc[nt] = __builtin_amdgcn_mfma_f32_16x16x32_bf16(wh, xh, acc[nt], 0, 0, 0);
                acc[nt] = __builtin_amdgcn_mfma_f32_16x16x32_bf16(wl, xh, acc[nt], 0, 0, 0);
                acc[nt] = __builtin_amdgcn_mfma_f32_16x16x32_bf16(wh, xl, acc[nt], 0, 0, 0); } }
        if (bt < 3) LN1_LOAD(bt + 1);
        LN1_BAR();
        *(LAS f32x4*)(PART + (wave * 16 + fr) * 32 + 4 * fq) = acc[0]; *(LAS f32x4*)(PART + (wave * 16 + fr) * 32 + 16 + 4 * fq) = acc[1];
        LN1_BAR();
        {
            const int r = tid >> 5, n = tid & 31; float a = 0.f;
#pragma unroll
            for (int w = 0; w < 8; ++w) a += PART[(w * 16 + r) * 32 + n];
            a += lbias;
            LG[r * 32 + n] = a; }
        LN1_BAR();
        if (tid < 16) {
            float lg[20];
#pragma unroll
            for (int n = 0; n < 20; ++n) lg[n] = LG[tid * 32 + n];
            int gi = 0; float lm = lg[0];
#pragma unroll
            for (int k = 1; k < 4; ++k) if (lg[k] > lm) { lm = lg[k]; gi = k; }
            float den = 0.f;
#pragma unroll
            for (int k = 0; k < 4; ++k) den += __expf(lg[k] - lm);
            const float pg = 1.0f / den; float l2[4];
#pragma unroll
            for (int e = 0; e < 4; ++e) l2[e] = gi == 0 ? lg[4 + e] : gi == 1 ? lg[8 + e] : gi == 2 ? lg[12 + e] : lg[16 + e];
            int e1 = 0; float v1 = l2[0];
#pragma unroll
            for (int e = 1; e < 4; ++e) if (l2[e] > v1) { v1 = l2[e]; e1 = e; }
            int e2 = -1; float v2 = 0.f;
#pragma unroll
            for (int e = 0; e < 4; ++e) if (e != e1 && (e2 < 0 || l2[e] > v2)) { v2 = l2[e]; e2 = e; }
            const float t = __expf(v2 - v1); const float p1 = 1.0f / (1.0f + t), p2 = t / (1.0f + t);
            const int E1 = gi * 4 + e1, E2 = gi * 4 + e2, it = bt * 16 + tid;
            const int i1 = __hip_atomic_fetch_add(&hist[E1], 1, __ATOMIC_RELAXED, __HIP_MEMORY_SCOPE_WORKGROUP); const int i2 = __hip_atomic_fetch_add(&hist[E2], 1, __ATOMIC_RELAXED, __HIP_MEMORY_SCOPE_WORKGROUP);
            sE[2 * it] = E1; sI[2 * it] = i1; sW[2 * it] = pg * p1; sE[2 * it + 1] = E2; sI[2 * it + 1] = i2; sW[2 * it + 1] = pg * p2;
        }
        LN1_BAR();
    }
    if (DRY) { __syncthreads(); return; }
    if (tid < 16) hbase[tid] = (int)__hip_atomic_fetch_add((unsigned*)(F.ctl + CW_CNT + layer * 16 + tid), (unsigned)hist[tid], RLX_AGENT);
    __syncthreads();
    int* TS = (int*)(F.ws + WS_TOKSLOT);
    if (tid < 128) { const int sl = tid; const int row = rbase + (sl >> 1); const int E = sE[sl];
        const int idx = hbase[E] + sI[sl];
        GAS v4u* dst = (GAS v4u*)(TS + (size_t)(row * 2 + (sl & 1)) * 4); v4u w; w.x = (unsigned)E; w.y = (unsigned)idx; w.z = __float_as_uint(sW[sl]); w.w = 0u; *dst = w;
        ((int*)(F.ws + WS_EXPTOK))[(size_t)E * T + idx] = row; ((float*)(F.ws + WS_EXPW))[(size_t)E * T + idx] = sW[sl]; }
    __syncthreads();
}
template <bool DRY = false> __device__ __forceinline__ void ln2_phase(Ctx& F, int layer) {
    const int tid = fresh_tid(F.wave); const int lane = tid & 63, wave = F.wave;
    const bool last = layer == DEPTH - 1; float* xout = DRY ? (float*)(F.ws + WS_ARENA + 1010 * MiB) : F.out; bf16_t* XB = (bf16_t*)(F.ws + WS_XB); bf16_t* XBO = DRY ? (bf16_t*)(F.ws + WS_ARENA + 944 * MiB) : XB;
    const float* gam = F.in[1] + (size_t)(layer * 2 + 1) * D; const float* bet = F.in[2] + (size_t)(layer * 2 + 1) * D;
    const bf16_t* YG = (const bf16_t*)(F.ws + WS_YG); const int* TOKPOS = (const int*)(F.ws + WS_TOKPOS);
    const int rbase = blockIdx.x * 64;
    LAS int* tabL = (LAS int*)(F.lds + RING_OFF); LAS f32x4* GL = (LAS f32x4*)(F.lds + RING_OFF + 256); LAS f32x4* BL = GL + 512;
    GL[tid] = ((const GAS f32x4*)gam)[tid]; BL[tid] = ((const GAS f32x4*)bet)[tid];
    if (tid == 0) { int acc = 0; for (int e = 0; e < 16; ++e) { const unsigned c = __hip_atomic_load((unsigned*)(F.ctl + CW_CNT + layer * 16 + e), RLX_AGENT); tabL[e] = acc; acc += (int)((c + 255u) >> 8); } }
    __syncthreads();
    int pos = 0; if (lane < 16) { const int* ts = (const int*)(F.ws + WS_TOKSLOT) + (size_t)((rbase + (lane >> 1) * 8 + wave) * 2 + (lane & 1)) * 4; pos = tabL[ts[0]] * 256 + ts[1]; }
#define LN2_LOAD(it_, XR, YA, YB) do { const int row_ = rbase + (it_) * 8 + wave; \
        const int p0_ = __builtin_amdgcn_readfirstlane(__builtin_amdgcn_ds_bpermute((2 * (it_)) << 2, pos)), p1_ = __builtin_amdgcn_readfirstlane(__builtin_amdgcn_ds_bpermute((2 * (it_) + 1) << 2, pos)); \
        const GAS v2u* xr_ = (const GAS v2u*)(XB + (size_t)row_ * D) + lane; const GAS v2u* y0_ = (const GAS v2u*)(YG + (size_t)p0_ * D) + lane; const GAS v2u* y1_ = (const GAS v2u*)(YG + (size_t)p1_ * D) + lane; \
        _Pragma("unroll") for (int j_ = 0; j_ < 8; ++j_) { XR[j_] = xr_[64 * j_]; YA[j_] = __builtin_nontemporal_load(y0_ + 64 * j_); YB[j_] = __builtin_nontemporal_load(y1_ + 64 * j_); } } while (0)
    auto ln2_row = [&](int it, const v2u (&XA)[8], const v2u (&YA)[8], const v2u (&YB)[8]) __attribute__((always_inline)) {
        const int row = rbase + it * 8 + wave; f32x4 v[8]; float s = 0.f;
#pragma unroll
        for (int j = 0; j < 8; ++j) { const v2u xw = XA[j]; const v2u a = YA[j], b = YB[j];
            v[j].x = ALPHA * bflo(xw.x) + (bflo(a.x) + bflo(b.x)); v[j].y = ALPHA * bfhi(xw.x) + (bfhi(a.x) + bfhi(b.x)); v[j].z = ALPHA * bflo(xw.y) + (bflo(a.y) + bflo(b.y)); v[j].w = ALPHA * bfhi(xw.y) + (bfhi(a.y) + bfhi(b.y));
            s += (v[j].x + v[j].y) + (v[j].z + v[j].w); }
        const float mean = wave_sum_dpp(s) * (1.f / D); float s2 = 0.f;
#pragma unroll
        for (int j = 0; j < 8; ++j) { v[j] = v[j] - mean; s2 += (v[j].x * v[j].x + v[j].y * v[j].y) + (v[j].z * v[j].z + v[j].w * v[j].w); }
        const float rstd = 1.f / sqrtf(wave_sum_dpp(s2) * (1.f / D) + LN_EPS);
        GAS f32x4* xo = (GAS f32x4*)(xout + (size_t)row * D) + lane; GAS v2u* bo = (GAS v2u*)(XBO + (size_t)row * D) + lane;
#pragma unroll
        for (int j = 0; j < 8; ++j) { const f32x4 gj = GL[lane + 64 * j], bj = BL[lane + 64 * j]; const f32x4 y = v[j] * rstd * gj + bj;
            if (last) xo[64 * j] = y; else { v2u w; w.x = pk2(y.x, y.y); w.y = pk2(y.z, y.w); bo[64 * j] = w; if (F8_HY_IN && (layer & 1)) ((GAS int*)(F.ws + WS_XIN8 + (size_t)row * D))[lane + 64 * j] = pk_fp8x4(y, 4.0f); } }
    };
    v2u xa[8], ya[8], yb[8], xb2[8], yc[8], yd[8];
    LN2_LOAD(0, xa, ya, yb);
#pragma unroll 1
    for (int it = 0; it < 8; it += 2) {
        LN2_LOAD(it + 1, xb2, yc, yd);
        ln2_row(it, xa, ya, yb);
        { const int i2 = it + 2 < 8 ? it + 2 : 7; LN2_LOAD(i2, xa, ya, yb); }
        ln2_row(it + 1, xb2, yc, yd);
    }
#undef LN2_LOAD
}
__device__ __forceinline__ void moe_tables(Ctx& F, int layer, int (&tab)[17]) {
    int acc = 0;
#pragma unroll
    for (int e = 0; e < 16; ++e) { const unsigned c = __hip_atomic_load((unsigned*)(F.ctl + CW_CNT + layer * 16 + e), RLX_AGENT); tab[e] = __builtin_amdgcn_readfirstlane(acc); acc += (int)((c + 255u) >> 8); }
    tab[16] = __builtin_amdgcn_readfirstlane(acc);
}
typedef float f32x4_t __attribute__((ext_vector_type(4)));
__device__ __forceinline__ float gelu_tanh_fast(float x) { const float u = 1.5957691216057308f * (x + 0.044715f * x * x * x); return x * __builtin_amdgcn_rcpf(1.0f + __expf(-u)); }
__device__ __forceinline__ void lru_local_item(Ctx& F, int jl, int item, int& hd_lds) {
    const int tid = fresh_tid(F.wave);
    const int lane = tid & 63, wave = __builtin_amdgcn_readfirstlane(tid >> 6);
    const int hd = item & 7, c = (item >> 3) & 63, b = item >> 9; const int r0 = b * SEQ + c * 64;
    const bf16_t* PROJ = (const bf16_t*)(F.ws + WS_PROJ);
    LAS float* XCF = (LAS float*)(F.lds + RING_OFF); LAS float* AF = (LAS float*)(F.lds + RING_OFF + 32768);
    LAS unsigned char* XCB = F.lds + RING_OFF + 65536;
    LAS float* QS = (LAS float*)(F.lds + RING_OFF + 65536 + 17408);
    LAS unsigned char* WL = F.lds + RING_OFF + 87040;
    LAS float* PT = (LAS float*)(F.lds + RING_OFF + 87040 + 65536);
    if (hd != hd_lds) { const bf16_t* W = (const bf16_t*)(F.ws + WS_WRI) + (size_t)(jl * 8 + hd) * 256 * 128; const int row = tid >> 1, hf = tid & 1;
        const GAS v4u* src = (const GAS v4u*)(W + (size_t)row * 128 + hf * 64);
#pragma unroll
        for (int i = 0; i < 8; ++i) *(LAS v4u*)(WL + row * 256 + (((hf * 8 + i) ^ (row & 15)) << 4)) = src[i];
        for (int i = tid; i < 8 * 128; i += NTHR) { const int k = i >> 7, jj = i & 127, ch = hd * 128 + jj;
            PT[i] = k < 4 ? F.in[4][(size_t)jl * 4 * 1024 + k * 1024 + ch] : k == 4 ? F.in[5][(size_t)jl * 1024 + ch] : k == 5 ? F.in[7][(size_t)jl * 1024 + ch] : k == 6 ? F.in[9][(size_t)jl * 1024 + ch] : ((const float*)(F.ws + WS_TOKPOS))[(size_t)jl * 1024 + ch]; }
        hd_lds = hd; __syncthreads(); }
    { const int tok = tid >> 3, cg = (tid & 7) * 16, ch0 = hd * 128 + cg; const int s = c * 64 + tok;
      float acc[16];
#pragma unroll
      for (int i = 0; i < 4; ++i) { const f32x4_t v = *(const LAS f32x4_t*)(PT + 4 * 128 + cg + 4 * i); acc[4 * i] = v.x; acc[4 * i + 1] = v.y; acc[4 * i + 2] = v.z; acc[4 * i + 3] = v.w; }
#pragma unroll
      for (int k = 0; k < 4; ++k) { const int sp = s - 3 + k;
          if (sp >= 0) { const GAS v4u* xr = (const GAS v4u*)(PROJ + (size_t)(r0 + tok - 3 + k) * HY_NP + ch0); const v4u x0 = xr[0], x1 = xr[1];
              const unsigned xw[8] = {x0.x, x0.y, x0.z, x0.w, x1.x, x1.y, x1.z, x1.w};
#pragma unroll
              for (int i = 0; i < 4; ++i) { const f32x4_t w = *(const LAS f32x4_t*)(PT + k * 128 + cg + 4 * i);
                  acc[4 * i] += bflo(xw[2 * i]) * w.x; acc[4 * i + 1] += bfhi(xw[2 * i]) * w.y; acc[4 * i + 2] += bflo(xw[2 * i + 1]) * w.z; acc[4 * i + 3] += bfhi(xw[2 * i + 1]) * w.w; } } }
#pragma unroll
      for (int i = 0; i < 4; ++i) *(LAS f32x4_t*)(XCF + tok * 128 + cg + 4 * i) = (f32x4_t){acc[4 * i], acc[4 * i + 1], acc[4 * i + 2], acc[4 * i + 3]};
      v4u o0, o1; o0.x = pk2(acc[0], acc[1]); o0.y = pk2(acc[2], acc[3]); o0.z = pk2(acc[4], acc[5]); o0.w = pk2(acc[6], acc[7]);
      o1.x = pk2(acc[8], acc[9]); o1.y = pk2(acc[10], acc[11]); o1.z = pk2(acc[12], acc[13]); o1.w = pk2(acc[14], acc[15]);
      *(LAS v4u*)(XCB + tok * 272 + cg * 2) = o0; *(LAS v4u*)(XCB + tok * 272 + cg * 2 + 16) = o1; }
    asm volatile("s_waitcnt lgkmcnt(0)" ::: "memory"); __builtin_amdgcn_s_barrier(); asm volatile("" ::: "memory");
    { const int rt = wave & 3, chalf = wave >> 2, fr = lane & 15, fq = lane >> 4;
      f32x4_t ar[4], ai[4];
#pragma unroll
      for (int nt = 0; nt < 4; ++nt) { ar[nt] = (f32x4_t){0.f, 0.f, 0.f, 0.f}; ai[nt] = (f32x4_t){0.f, 0.f, 0.f, 0.f}; }
#pragma unroll
      for (int ks = 0; ks < 4; ++ks) {
          const bf16x8 xa = *(const LAS bf16x8*)(XCB + (16 * rt + fr) * 272 + (32 * ks + 8 * fq) * 2);
#pragma unroll
          for (int nt = 0; nt < 4; ++nt) {
              const bf16x8 wr = *(const LAS bf16x8*)(WL + (64 * chalf + 16 * nt + fr) * 256 + (((4 * ks + fq) ^ fr) << 4));
              const bf16x8 wi = *(const LAS bf16x8*)(WL + (128 + 64 * chalf + 16 * nt + fr) * 256 + (((4 * ks + fq) ^ fr) << 4));
              ar[nt] = __builtin_amdgcn_mfma_f32_16x16x32_bf16(wr, xa, ar[nt], 0, 0, 0);
              ai[nt] = __builtin_amdgcn_mfma_f32_16x16x32_bf16(wi, xa, ai[nt], 0, 0, 0); } }
      const int tok = 16 * rt + fr;
#pragma unroll
      for (int nt = 0; nt < 4; ++nt) { const int cl = 64 * chalf + 16 * nt + 4 * fq, chg = hd * 128 + cl;
          const f32x4_t br = *(const LAS f32x4_t*)(PT + 5 * 128 + cl), bi = *(const LAS f32x4_t*)(PT + 6 * 128 + cl), lm = *(const LAS f32x4_t*)(PT + 7 * 128 + cl);
          const f32x4_t xc = *(LAS f32x4_t*)(XCF + tok * 128 + cl); f32x4_t av, uv;
#pragma unroll
          for (int e = 0; e < 4; ++e) { const float r = sigmoid_(ar[nt][e] + br[e]), ig = sigmoid_(ai[nt][e] + bi[e]);
              const float la = r * lm[e]; const float a = __expf(la); const float x2 = 2.0f * la;
              const float om = x2 > -0.1f ? -x2 * (1.0f + x2 * (0.5f + x2 * (0.16666667f + x2 * 0.041666667f))) : 1.0f - a * a;
              av[e] = a; uv[e] = sqrtf(om) * (ig * xc[e]); }
          *(LAS f32x4_t*)(AF + tok * 128 + cl) = av; *(LAS f32x4_t*)(XCF + tok * 128 + cl) = uv; } }
    asm volatile("s_waitcnt lgkmcnt(0)" ::: "memory"); __builtin_amdgcn_s_barrier(); asm volatile("" ::: "memory");
    { const int ch = tid & 127, q = tid >> 7; float hl[16], pl[16]; float h = 0.f, p = 1.f;
#pragma unroll
      for (int i = 0; i < 16; ++i) { const float a = AF[(16 * q + i) * 128 + ch], u = XCF[(16 * q + i) * 128 + ch]; h = a * h + u; p *= a; hl[i] = h; pl[i] = p; }
      QS[(q * 128 + ch) * 2] = p; QS[(q * 128 + ch) * 2 + 1] = h;
      asm volatile("s_waitcnt lgkmcnt(0)" ::: "memory"); __builtin_amdgcn_s_barrier(); asm volatile("" ::: "memory");
      float carry = 0.f, cump = 1.f;
      for (int q2 = 0; q2 < q; ++q2) { const float pq = QS[(q2 * 128 + ch) * 2], hq = QS[(q2 * 128 + ch) * 2 + 1]; carry = pq * carry + hq; cump *= pq; }
      bf16_t* HL = (bf16_t*)(F.ws + WS_HLOC) + (size_t)(r0 + 16 * q) * 1024 + hd * 128 + ch; bf16_t* CA = (bf16_t*)(F.ws + WS_CUMA) + (size_t)(r0 + 16 * q) * 1024 + hd * 128 + ch;
#pragma unroll
      for (int i = 0; i < 16; ++i) { hl[i] += pl[i] * carry; pl[i] *= cump; HL[(size_t)i * 1024] = (bf16_t)f2bf(hl[i]); CA[(size_t)i * 1024] = (bf16_t)f2bf(pl[i]); }
      if (q == 3) { float* LS = (float*)(F.ws + WS_LSUM) + ((size_t)(b * 64 + c) * 1024 + hd * 128 + ch) * 2; LS[0] = pl[15]; LS[1] = hl[15]; } }
    asm volatile("s_waitcnt lgkmcnt(0)" ::: "memory"); __builtin_amdgcn_s_barrier(); asm volatile("" ::: "memory");
}
__device__ __forceinline__ void lru_fix_item(Ctx& F, int item) {
    const int tid = fresh_tid(F.wave);
    const int c = item & 63, b = item >> 6; const int ch = 2 * tid;
    const float* LS = (const float*)(F.ws + WS_LSUM) + ((size_t)(b * 64) * 1024 + ch) * 2;
    float c0 = 0.f, c1 = 0.f;
    { int c2 = 0;
      for (; c2 + 8 <= c; c2 += 8) { f32x4_t v[8];
#pragma unroll
          for (int i = 0; i < 8; ++i) v[i] = *(const GAS f32x4_t*)(LS + (size_t)(c2 + i) * 2048);
#pragma unroll
          for (int i = 0; i < 8; ++i) { c0 = v[i].x * c0 + v[i].y; c1 = v[i].z * c1 + v[i].w; } }
      for (; c2 < c; ++c2) { const f32x4_t v = *(const GAS f32x4_t*)(LS + (size_t)c2 * 2048); c0 = v.x * c0 + v.y; c1 = v.z * c1 + v.w; } }
    const int r0 = b * SEQ + c * 64;
    const bf16_t* HL = (const bf16_t*)(F.ws + WS_HLOC) + (size_t)r0 * 1024 + ch; const bf16_t* CA = (const bf16_t*)(F.ws + WS_CUMA) + (size_t)r0 * 1024 + ch;
    const bf16_t* G = (const bf16_t*)(F.ws + WS_PROJ) + (size_t)r0 * HY_NP + 1024 + ch; bf16_t* Y = (bf16_t*)(F.ws + WS_YMIX) + (size_t)r0 * 2048 + ch;
#pragma unroll 1
    for (int i0 = 0; i0 < 64; i0 += 8) {
        unsigned hv[8], cv[8], gw[8];
#pragma unroll
        for (int k = 0; k < 8; ++k) { hv[k] = __builtin_nontemporal_load((const GAS unsigned*)(HL + (size_t)(i0 + k) * 1024)); cv[k] = __builtin_nontemporal_load((const GAS unsigned*)(CA + (size_t)(i0 + k) * 1024)); gw[k] = *(const GAS unsigned*)(G + (size_t)(i0 + k) * HY_NP); }
#pragma unroll
        for (int k = 0; k < 8; ++k) { const float h0 = bflo(hv[k]) + bflo(cv[k]) * c0, h1 = bfhi(hv[k]) + bfhi(cv[k]) * c1;
            const float o0 = h0 * gelu_tanh_fast(bflo(gw[k])), o1 = h1 * gelu_tanh_fast(bfhi(gw[k]));
            if (F8_HY_OUT) *(GAS unsigned short*)(F.ws + WS_YMIX8 + (size_t)(r0 + i0 + k) * 2048 + ch) = (unsigned short)__builtin_amdgcn_cvt_pk_fp8_f32(__builtin_amdgcn_fmed3f(4.0f * o0, -448.f, 448.f), __builtin_amdgcn_fmed3f(4.0f * o1, -448.f, 448.f), 0, false);
            else *(GAS unsigned*)(Y + (size_t)(i0 + k) * 2048) = pk2(o0, o1); } }
}
constexpr int SSD_LP = 136;
template <int NT> __device__ __forceinline__ void ssd_conv_load(const bf16_t* P, int row0, int s0, unsigned (&xw)[NT + 3][8]) {
#pragma unroll
    for (int r = 0; r < NT + 3; ++r) { const bool ok = s0 - 3 + r >= 0;
        const GAS v4u* xr = (const GAS v4u*)(P + (size_t)(ok ? row0 - 3 + r : row0) * SS_NP); const v4u a = xr[0], b = xr[1]; const unsigned m = ok ? 0xffffffffu : 0u;
        xw[r][0] = a.x & m; xw[r][1] = a.y & m; xw[r][2] = a.z & m; xw[r][3] = a.w & m; xw[r][4] = b.x & m; xw[r][5] = b.y & m; xw[r][6] = b.z & m; xw[r][7] = b.w & m; }
}
template <int NT, int WS = 768> __device__ __forceinline__ void ssd_conv_math(const unsigned (&xw)[NT + 3][8], const LAS float* wl, float (&o)[NT][16]) {
#pragma unroll
    for (int i4 = 0; i4 < 4; ++i4) { const f32x4_t bv = *(const LAS f32x4_t*)(wl + 4 * WS + 4 * i4);
        f32x4_t w[4];
#pragma unroll
        for (int k = 0; k < 4; ++k) w[k] = *(const LAS f32x4_t*)(wl + k * WS + 4 * i4);
#pragma unroll
        for (int t = 0; t < NT; ++t) { float a0 = bv.x, a1 = bv.y, a2 = bv.z, a3 = bv.w;
#pragma unroll
            for (int k = 0; k < 4; ++k) { a0 += bflo(xw[t + k][2 * i4]) * w[k].x; a1 += bfhi(xw[t + k][2 * i4]) * w[k].y; a2 += bflo(xw[t + k][2 * i4 + 1]) * w[k].z; a3 += bfhi(xw[t + k][2 * i4 + 1]) * w[k].w; }
            o[t][4 * i4] = silu_fast2(a0); o[t][4 * i4 + 1] = silu_fast2(a1); o[t][4 * i4 + 2] = silu_fast2(a2); o[t][4 * i4 + 3] = silu_fast2(a3); } }
}
template <int NT, int WS = 768> __device__ __forceinline__ void ssd_conv_tok(const bf16_t* P, int row0, int s0, const LAS float* wl, float (&o)[NT][16]) {
    unsigned xw[NT + 3][8]; ssd_conv_load<NT>(P, row0, s0, xw); ssd_conv_math<NT, WS>(xw, wl, o);
}
__device__ __forceinline__ void ssd_load_convw(Ctx& F, int jl, int g, LAS float* WL, int tid) {
    const float* cw = F.in[14] + (size_t)jl * 4 * SSD_CONV; const float* cb = F.in[15] + (size_t)jl * SSD_CONV;
    for (int i = tid; i < 5 * 768; i += NTHR) { const int k = i / 768, jj = i - k * 768; const int ch = jj < 512 ? g * 512 + jj : jj < 640 ? 4096 + g * 128 + (jj - 512) : 5120 + g * 128 + (jj - 640);
        WL[i] = k < 4 ? cw[(size_t)k * SSD_CONV + ch] : cb[ch]; }
}
__device__ __forceinline__ void ssd_states_item(Ctx& F, int jl, int item, int& g_lds) {
    const int tid = fresh_tid(F.wave);
    const int lane = tid & 63, wave = __builtin_amdgcn_readfirstlane(tid >> 6), fr = lane & 15, fq = lane >> 4;
    const int g = item & 7, c = (item >> 3) & 31, b = item >> 8, bc = b * 32 + c, r0 = bc * 128, s0 = c * 128;
    const bf16_t* PROJ = (const bf16_t*)(F.ws + WS_PROJ);
    const float* cw = F.in[14] + (size_t)jl * 4 * SSD_CONV; const float* cb = F.in[15] + (size_t)jl * SSD_CONV;
    LAS unsigned char* BT = F.lds + RING_OFF; LAS unsigned char* XT0 = F.lds + RING_OFF + 34816; LAS float* DTL = (LAS float*)(F.lds + RING_OFF + 104448); LAS float* ACSL = DTL + 1024;
    LAS float* WL = (LAS float*)(F.lds + RING_OFF + 112640);
    if (g != g_lds) { ssd_load_convw(F, jl, g, WL, tid); g_lds = g; __syncthreads(); }
    {
        const int h = 8 * g + wave; const float A = -__expf(F.in[17][jl * 64 + h]), dtb = F.in[16][jl * 64 + h];
        const int l0 = 2 * lane;
        const float* DTR = (const float*)(F.ws + WS_DTB);
        const float d0 = softplus_(DTR[(size_t)(r0 + l0) * 64 + h] + dtb), d1 = softplus_(DTR[(size_t)(r0 + l0 + 1) * 64 + h] + dtb);
        float sc = (d0 + d1) * A;
#pragma unroll
        for (int o = 1; o < 64; o <<= 1) { const float u = shfl_up_l(sc, o, lane); if (lane >= o) sc += u; }
        const float a1 = sc, a0 = sc - d1 * A;
        DTL[l0 * 8 + wave] = d0; DTL[(l0 + 1) * 8 + wave] = d1; ACSL[l0 * 8 + wave] = a0; ACSL[(l0 + 1) * 8 + wave] = a1;
        float* DTB = (float*)(F.ws + WS_DTB); float* ACSB = (float*)(F.ws + WS_ACSB);
        DTB[(size_t)(r0 + l0) * 64 + h] = d0; DTB[(size_t)(r0 + l0 + 1) * 64 + h] = d1; ACSB[(size_t)(r0 + l0) * 64 + h] = a0; ACSB[(size_t)(r0 + l0 + 1) * 64 + h] = a1;
    }
    {
        const int lp = tid >> 3, cg = (tid & 7) * 16; float o[2][16];
        ssd_conv_tok<2>(PROJ + 8192 + g * 128 + cg, r0 + 2 * lp, s0 + 2 * lp, WL + 512 + cg, o);
#pragma unroll
        for (int i = 0; i < 16; ++i) *(LAS unsigned*)(BT + ((cg + i) * SSD_LP + 2 * lp) * 2) = pk2(o[0][i], o[1][i]);
#pragma unroll
        for (int t = 0; t < 2; ++t) { v4u w0, w1; w0.x = pk2(o[t][0], o[t][1]); w0.y = pk2(o[t][2], o[t][3]); w0.z = pk2(o[t][4], o[t][5]); w0.w = pk2(o[t][6], o[t][7]); w1.x = pk2(o[t][8], o[t][9]); w1.y = pk2(o[t][10], o[t][11]); w1.z = pk2(o[t][12], o[t][13]); w1.w = pk2(o[t][14], o[t][15]);
            GAS v4u* d = (GAS v4u*)((bf16_t*)(F.ws + WS_BS) + (size_t)(r0 + 2 * lp + t) * 1024 + g * 128 + cg); d[0] = w0; d[1] = w1; }
    }
    __syncthreads();
    unsigned xwc[5][8];
    { const int hh = tid >> 8, t2 = tid & 255, lp = t2 >> 2, pg = (t2 & 3) * 16; ssd_conv_load<2>(PROJ + 4096 + (8 * g + hh) * 64 + pg, r0 + 2 * lp, s0 + 2 * lp, xwc); }
#pragma unroll 1
    for (int hp = 0; hp < 4; ++hp) {
        LAS unsigned char* XT = XT0 + (hp & 1) * 34816;
        {
            int tq = tid; asm volatile("" : "+v"(tq));
            const int hh = tq >> 8, t2 = tq & 255, lp = t2 >> 2, pg = (t2 & 3) * 16, e = 2 * hp + hh, h = 8 * g + e; float o[2][16];
            ssd_conv_math<2>(xwc, WL + e * 64 + pg, o);
            if (hp < 3) ssd_conv_load<2>(PROJ + 4096 + (h + 2) * 64 + pg, r0 + 2 * lp, s0 + 2 * lp, xwc);
            const float al = ACSL[127 * 8 + e]; const float f0 = DTL[(2 * lp) * 8 + e] * __expf(al - ACSL[(2 * lp) * 8 + e]), f1 = DTL[(2 * lp + 1) * 8 + e] * __expf(al - ACSL[(2 * lp + 1) * 8 + e]);
#pragma unroll
            for (int i = 0; i < 16; ++i) *(LAS unsigned*)(XT + hh * 17408 + ((pg + i) * SSD_LP + 2 * lp) * 2) = pk2(o[0][i] * f0, o[1][i] * f1);
#pragma unroll
            for (int t = 0; t < 2; ++t) { v4u w0, w1; w0.x = pk2(o[t][0], o[t][1]); w0.y = pk2(o[t][2], o[t][3]); w0.z = pk2(o[t][4], o[t][5]); w0.w = pk2(o[t][6], o[t][7]); w1.x = pk2(o[t][8], o[t][9]); w1.y = pk2(o[t][10], o[t][11]); w1.z = pk2(o[t][12], o[t][13]); w1.w = pk2(o[t][14], o[t][15]);
                GAS v4u* d = (GAS v4u*)((bf16_t*)(F.ws + WS_XS) + (size_t)(r0 + 2 * lp + t) * 4096 + h * 64 + pg); d[0] = w0; d[1] = w1; }
        }
        asm volatile("s_waitcnt lgkmcnt(0)" ::: "memory"); __builtin_amdgcn_s_barrier(); asm volatile("" ::: "memory");
        {
            int lq = lane; asm volatile("" : "+v"(lq)); const int fr = lq & 15, fq = lq >> 4;
            const int hh = wave >> 2, pt = wave & 3, h = 8 * g + 2 * hp + hh;
            f32x4_t acc[8];
#pragma unroll
            for (int nt = 0; nt < 8; ++nt) acc[nt] = (f32x4_t){0.f, 0.f, 0.f, 0.f};
#pragma unroll
            for (int ks = 0; ks < 4; ++ks) { bf16x8 xa = *(const LAS bf16x8*)(XT + hh * 17408 + ((16 * pt + fr) * SSD_LP + 32 * ks + 8 * fq) * 2), bb[8];
#pragma unroll
                for (int nt = 0; nt < 8; ++nt) bb[nt] = *(const LAS bf16x8*)(BT + ((16 * nt + fr) * SSD_LP + 32 * ks + 8 * fq) * 2);
                asm volatile("s_waitcnt lgkmcnt(0)" : "+v"(xa), "+v"(bb[0]), "+v"(bb[1]), "+v"(bb[2]), "+v"(bb[3]), "+v"(bb[4]), "+v"(bb[5]), "+v"(bb[6]), "+v"(bb[7]));
#pragma unroll
                for (int nt = 0; nt < 8; ++nt) acc[nt] = __builtin_amdgcn_mfma_f32_16x16x32_bf16(bb[nt], xa, acc[nt], 0, 0, 0); }
            bf16_t* ST = (bf16_t*)(F.ws + WS_STATES) + (((size_t)bc * 64 + h) * 64 + 16 * pt + fr) * 128 + 4 * fq;
#pragma unroll
            for (int nt = 0; nt < 8; ++nt) { v2u w; w.x = pk2(acc[nt][0], acc[nt][1]); w.y = pk2(acc[nt][2], acc[nt][3]); *(GAS v2u*)(ST + 16 * nt) = w; }
        }
    }
    __syncthreads();
}
__device__ __forceinline__ void ssd_scan_item(Ctx& F, int item) {
    const int tid = fresh_tid(F.wave);
    const int b = item >> 6, h = item & 63;
    bf16_t* ST = (bf16_t*)(F.ws + WS_STATES) + ((size_t)(b * 32) * 64 + h) * 8192 + 16 * tid; const float* ACSB = (const float*)(F.ws + WS_ACSB) + (size_t)(b * 32) * 128 * 64 + 127 * 64 + h;
    float s[16];
#pragma unroll
    for (int i = 0; i < 16; ++i) s[i] = 0.f;
#pragma unroll 1
    for (int c0 = 0; c0 < 32; c0 += 8) {
        v4u la[8], lb[8]; float dec[8];
#pragma unroll
        for (int k = 0; k < 8; ++k) { const GAS v4u* p = (const GAS v4u*)(ST + (size_t)(c0 + k) * 64 * 8192); la[k] = __builtin_nontemporal_load(p); lb[k] = __builtin_nontemporal_load(p + 1); dec[k] = ACSB[(size_t)(c0 + k) * 128 * 64]; }
#pragma unroll
        for (int k = 0; k < 8; ++k) { GAS v4u* p = (GAS v4u*)(ST + (size_t)(c0 + k) * 64 * 8192); const float d = __expf(dec[k]);
            const unsigned w[8] = {la[k].x, la[k].y, la[k].z, la[k].w, lb[k].x, lb[k].y, lb[k].z, lb[k].w}; v4u o0, o1;
            o0.x = pk2(s[0], s[1]); o0.y = pk2(s[2], s[3]); o0.z = pk2(s[4], s[5]); o0.w = pk2(s[6], s[7]); o1.x = pk2(s[8], s[9]); o1.y = pk2(s[10], s[11]); o1.z = pk2(s[12], s[13]); o1.w = pk2(s[14], s[15]);
            p[0] = o0; p[1] = o1;
#pragma unroll
            for (int i = 0; i < 8; ++i) { s[2 * i] = s[2 * i] * d + bflo(w[i]); s[2 * i + 1] = s[2 * i + 1] * d + bfhi(w[i]); } }
    }
}
__device__ __forceinline__ void ssd_y_item(Ctx& F, int jl, int item, int& g_lds) {
    const int tid = fresh_tid(F.wave);
    const int lane = tid & 63, wave = F.wave, fr = lane & 15, fq = lane >> 4;
    const int g = item & 7, c = (item >> 3) & 31, b = item >> 8, bc = b * 32 + c, r0 = bc * 128, s0 = c * 128;
    const bf16_t* PROJ = (const bf16_t*)(F.ws + WS_PROJ);
    const float* cw = F.in[14] + (size_t)jl * 4 * SSD_CONV; const float* cb = F.in[15] + (size_t)jl * SSD_CONV;
    LAS unsigned char* CT = F.lds + RING_OFF; LAS unsigned char* BN = F.lds + RING_OFF + 34816; LAS unsigned char* MT = BN;
    LAS unsigned char* XT = F.lds + RING_OFF + 69632;
    LAS unsigned char* PV = F.lds + RING_OFF + 104448;
    LAS float* DTL = (LAS float*)(F.lds + RING_OFF + 139264); LAS float* ACSL = DTL + 1024; LAS float* WL = (LAS float*)(F.lds + RING_OFF + 147456); LAS float* NG = WL + 5 * 128;
    LAS float* DPL = NG + 512;
    if (g != g_lds) { const float* cwg = F.in[14] + (size_t)jl * 4 * SSD_CONV + 5120 + g * 128; const float* cbg = F.in[15] + (size_t)jl * SSD_CONV + 5120 + g * 128;
        for (int i = tid; i < 5 * 128; i += NTHR) { const int k = i >> 7, jj = i & 127; WL[i] = k < 4 ? cwg[(size_t)k * SSD_CONV + jj] : cbg[jj]; }
        NG[tid] = F.in[19][(size_t)jl * 4096 + g * 512 + tid];
        g_lds = g; }
    __syncthreads();
    {
        const float* DTB = (const float*)(F.ws + WS_DTB); const float* ACSB = (const float*)(F.ws + WS_ACSB);
#pragma unroll
        for (int i = 0; i < 2; ++i) { const int idx = tid + 512 * i, l = idx >> 3, e = idx & 7; DTL[e * 128 + l] = DTB[(size_t)(r0 + l) * 64 + 8 * g + e]; ACSL[e * 128 + l] = 1.4426950408889634f * ACSB[(size_t)(r0 + l) * 64 + 8 * g + e]; }
        if (tid < 8) DPL[tid] = F.in[18][jl * 64 + 8 * g + tid];
    }
    {
        const int l = tid >> 2, cg = (tid & 3) * 32;
#pragma unroll
        for (int hf = 0; hf < 2; ++hf) { float o[1][16];
            ssd_conv_tok<1, 128>(PROJ + 9216 + g * 128 + cg + 16 * hf, r0 + l, s0 + l, WL + cg + 16 * hf, o);
            v4u w0, w1; w0.x = pk2(o[0][0], o[0][1]); w0.y = pk2(o[0][2], o[0][3]); w0.z = pk2(o[0][4], o[0][5]); w0.w = pk2(o[0][6], o[0][7]); w1.x = pk2(o[0][8], o[0][9]); w1.y = pk2(o[0][10], o[0][11]); w1.z = pk2(o[0][12], o[0][13]); w1.w = pk2(o[0][14], o[0][15]);
            *(LAS v4u*)(CT + (l * SSD_LP + cg + 16 * hf) * 2) = w0; *(LAS v4u*)(CT + (l * SSD_LP + cg + 16 * hf) * 2 + 16) = w1;
            const GAS v4u* bs = (const GAS v4u*)((const bf16_t*)(F.ws + WS_BS) + (size_t)(r0 + l) * 1024 + g * 128 + cg + 16 * hf);
            *(LAS v4u*)(BN + (l * SSD_LP + cg + 16 * hf) * 2) = bs[0]; *(LAS v4u*)(BN + (l * SSD_LP + cg + 16 * hf) * 2 + 16) = bs[1]; }
    }
    const int lp = tid >> 3, pg = (tid & 7) * 8, l0 = 2 * lp; const int l = 16 * wave + fr, row = r0 + l;
    const bf16_t* xsrc = (const bf16_t*)(F.ws + WS_XS) + (size_t)(r0 + l0) * 4096 + (8 * g) * 64 + pg;
    const bf16_t* psrc = (const bf16_t*)(F.ws + WS_STATES) + (((size_t)bc * 64 + 8 * g) * 64 + (tid >> 3)) * 128 + (tid & 7) * 16;
    const bf16_t* zsrc = PROJ + (size_t)row * SS_NP + (8 * g) * 64 + 4 * fq;
    v4u xraw[2], pvr[2]; v2u zc[4];
#define SSD_PREFETCH(e_) do { xraw[0] = *(const GAS v4u*)(xsrc + (e_) * 64); xraw[1] = *(const GAS v4u*)(xsrc + 4096 + (e_) * 64); \
        pvr[0] = *(const GAS v4u*)(psrc + (size_t)(e_) * 8192); pvr[1] = *(const GAS v4u*)(psrc + (size_t)(e_) * 8192 + 8); } while (0)
#define SSD_PREFETCH_Z(e_) do { _Pragma("unroll") for (int pt_ = 0; pt_ < 4; ++pt_) zc[pt_] = *(const GAS v2u*)(zsrc + (e_) * 64 + 16 * pt_); } while (0)
    SSD_PREFETCH(0); SSD_PREFETCH_Z(0);
    __syncthreads();
    f32x4_t cbt[8];
#pragma unroll
    for (int st = 0; st < 8; ++st) cbt[st] = (f32x4_t){0.f, 0.f, 0.f, 0.f};
#pragma unroll
    for (int ks = 0; ks < 4; ++ks) { bf16x8 cf = *(const LAS bf16x8*)(CT + ((16 * wave + fr) * SSD_LP + 32 * ks + 8 * fq) * 2), bf[8];
#pragma unroll
        for (int st = 0; st < 8; ++st) bf[st] = *(const LAS bf16x8*)(BN + ((16 * st + fr) * SSD_LP + 32 * ks + 8 * fq) * 2);
        asm volatile("s_waitcnt lgkmcnt(0)" : "+v"(cf), "+v"(bf[0]), "+v"(bf[1]), "+v"(bf[2]), "+v"(bf[3]), "+v"(bf[4]), "+v"(bf[5]), "+v"(bf[6]), "+v"(bf[7]));
#pragma unroll
        for (int st = 0; st < 8; ++st) if (st <= wave) cbt[st] = __builtin_amdgcn_mfma_f32_16x16x32_bf16(bf[st], cf, cbt[st], 0, 0, 0); }
    __syncthreads();
    float ssq = 0.f; bf16_t* YN = (bf16_t*)(F.ws + WS_YN) + (size_t)row * 4096;
    v2u ykeep[8][4];
#pragma unroll
    for (int i = 0; i < 8; ++i)
#pragma unroll
        for (int pt = 0; pt < 4; ++pt) ykeep[i][pt] = (v2u){0u, 0u};
#pragma unroll 1
    for (int e = 0; e < 8; ++e) {
        const int h = 8 * g + e; LAS unsigned char* XTe = XT + (e & 1) * 17408; LAS unsigned char* PVe = PV + (e & 1) * 17408;
        float sz[16];
#pragma unroll
        for (int pt = 0; pt < 4; ++pt) { const v2u zw = zc[pt]; sz[4 * pt] = silu_fast2(bflo(zw.x)); sz[4 * pt + 1] = silu_fast2(bfhi(zw.x)); sz[4 * pt + 2] = silu_fast2(bflo(zw.y)); sz[4 * pt + 3] = silu_fast2(bfhi(zw.y)); }
        int wv = wave; asm volatile("" : "+s"(wv));
        {
            const float f0 = DTL[e * 128 + l0], f1 = DTL[e * 128 + l0 + 1];
            const unsigned xa[4] = {xraw[0].x, xraw[0].y, xraw[0].z, xraw[0].w}, xb[4] = {xraw[1].x, xraw[1].y, xraw[1].z, xraw[1].w};
#pragma unroll
            for (int i = 0; i < 4; ++i) { *(LAS unsigned*)(XTe + ((pg + 2 * i) * SSD_LP + l0) * 2) = pk2(bflo(xa[i]) * f0, bflo(xb[i]) * f1); *(LAS unsigned*)(XTe + ((pg + 2 * i + 1) * SSD_LP + l0) * 2) = pk2(bfhi(xa[i]) * f0, bfhi(xb[i]) * f1); }
            *(LAS v4u*)(PVe + ((tid >> 3) * SSD_LP + (tid & 7) * 16) * 2) = pvr[0]; *(LAS v4u*)(PVe + ((tid >> 3) * SSD_LP + (tid & 7) * 16) * 2 + 16) = pvr[1];
        }
        if (e < 7) { SSD_PREFETCH(e + 1); SSD_PREFETCH_Z(e + 1); }
        {
            const float al = ACSL[e * 128 + l]; const float dsk = DPL[e] * __builtin_amdgcn_rcpf(DTL[e * 128 + l]);
            f32x4_t asv[8];
#pragma unroll
            for (int st = 0; st < 8; ++st) asv[st] = *(const LAS f32x4_t*)(ACSL + e * 128 + 16 * st + 4 * fq);
            asm volatile("s_waitcnt lgkmcnt(0)" : "+v"(asv[0]), "+v"(asv[1]), "+v"(asv[2]), "+v"(asv[3]), "+v"(asv[4]), "+v"(asv[5]), "+v"(asv[6]), "+v"(asv[7]));
#pragma unroll
            for (int st = 0; st < 8; ++st) if (st <= (wv | 1)) { float m[4];
                const f32x4_t as4 = asv[st];
                if (st < wv) {
#pragma unroll
                    for (int i = 0; i < 4; ++i) m[i] = cbt[st][i] * __builtin_amdgcn_exp2f(al - as4[i]);
                } else {
#pragma unroll
                    for (int i = 0; i < 4; ++i) { const int s = 16 * st + 4 * fq + i; float v = s <= l ? cbt[st][i] * __builtin_amdgcn_exp2f(al - as4[i]) : 0.f; if (s == l) v += dsk; m[i] = v; } }
                v2u w; w.x = pk2(m[0], m[1]); w.y = pk2(m[2], m[3]); *(LAS v2u*)(MT + (l * SSD_LP + 16 * st + 4 * fq) * 2) = w; }
        }
        asm volatile("s_waitcnt lgkmcnt(0)" ::: "memory"); __builtin_amdgcn_s_barrier(); asm volatile("" ::: "memory");
        f32x4_t yd[4], yo[4];
#pragma unroll
        for (int pt = 0; pt < 4; ++pt) { yd[pt] = (f32x4_t){0.f, 0.f, 0.f, 0.f}; yo[pt] = (f32x4_t){0.f, 0.f, 0.f, 0.f}; }
        LAS unsigned char* pvl = PVe + (fr * SSD_LP + 8 * fq) * 2; LAS unsigned char* xtl = XTe + (fr * SSD_LP + 8 * fq) * 2; LAS unsigned char* ctl = CT + (l * SSD_LP + 8 * fq) * 2; LAS unsigned char* mtl = MT + (l * SSD_LP + 8 * fq) * 2;
        asm volatile("" : "+v"(pvl), "+v"(xtl), "+v"(ctl), "+v"(mtl));
#pragma unroll
        for (int ks = 0; ks < 4; ++ks) {
            const bool dk = 2 * ks <= wv;
            bf16x8 cf = *(const LAS bf16x8*)(ctl + 64 * ks), mf = *(const LAS bf16x8*)(mtl + 64 * ks), pf[4], xf[4];
#pragma unroll
            for (int pt = 0; pt < 4; ++pt) { pf[pt] = *(const LAS bf16x8*)(pvl + (16 * pt * SSD_LP + 32 * ks) * 2); xf[pt] = *(const LAS bf16x8*)(xtl + (16 * pt * SSD_LP + 32 * ks) * 2); }
            asm volatile("s_waitcnt lgkmcnt(0)" : "+v"(cf), "+v"(mf), "+v"(pf[0]), "+v"(pf[1]), "+v"(pf[2]), "+v"(pf[3]), "+v"(xf[0]), "+v"(xf[1]), "+v"(xf[2]), "+v"(xf[3]));
#pragma unroll
            for (int pt = 0; pt < 4; ++pt) yo[pt] = __builtin_amdgcn_mfma_f32_16x16x32_bf16(pf[pt], cf, yo[pt], 0, 0, 0);
            if (dk) {
#pragma unroll
                for (int pt = 0; pt < 4; ++pt) yd[pt] = __builtin_amdgcn_mfma_f32_16x16x32_bf16(xf[pt], mf, yd[pt], 0, 0, 0); }
        }
        {
            const float ea = __builtin_amdgcn_exp2f(ACSL[e * 128 + l]); v2u ynew[4];
#pragma unroll
            for (int pt = 0; pt < 4; ++pt) {
                const float y0 = (yd[pt][0] + ea * yo[pt][0]) * sz[4 * pt], y1 = (yd[pt][1] + ea * yo[pt][1]) * sz[4 * pt + 1];
                const float y2 = (yd[pt][2] + ea * yo[pt][2]) * sz[4 * pt + 2], y3 = (yd[pt][3] + ea * yo[pt][3]) * sz[4 * pt + 3];
                ssq += (y0 * y0 + y1 * y1) + (y2 * y2 + y3 * y3); v2u w; w.x = pk2(y0, y1); w.y = pk2(y2, y3); ynew[pt] = w; }
#pragma unroll
            for (int i = 0; i < 7; ++i)
#pragma unroll
                for (int pt = 0; pt < 4; ++pt) ykeep[i][pt] = ykeep[i + 1][pt];
#pragma unroll
            for (int pt = 0; pt < 4; ++pt) ykeep[7][pt] = ynew[pt];
        }

    }
#undef SSD_PREFETCH
#undef SSD_PREFETCH_Z
    ssq += shfl_xor_l(ssq, 16, lane); ssq += shfl_xor_l(ssq, 32, lane);
    const float rstd = 1.0f / sqrtf(ssq * (1.0f / 512.0f) + RMS_EPS);
    const float* ng = F.in[19] + (size_t)jl * 4096;
#pragma unroll
    for (int e = 0; e < 8; ++e)
#pragma unroll
        for (int pt = 0; pt < 4; ++pt) { const int ch = (8 * g + e) * 64 + 16 * pt + 4 * fq; const f32x4_t gv = *(const LAS f32x4_t*)(NG + e * 64 + 16 * pt + 4 * fq); const v2u yk = ykeep[e][pt];
            if (F8_SS_OUT) { const f32x4_t yv = {bflo(yk.x) * rstd * gv.x, bfhi(yk.x) * rstd * gv.y, bflo(yk.y) * rstd * gv.z, bfhi(yk.y) * rstd * gv.w}; *(GAS int*)(F.ws + WS_YN8 + (size_t)row * 4096 + ch) = pk_fp8x4(yv, 4.0f); }
            else { v2u w; w.x = pk2(bflo(yk.x) * rstd * gv.x, bfhi(yk.x) * rstd * gv.y); w.y = pk2(bflo(yk.y) * rstd * gv.z, bfhi(yk.y) * rstd * gv.w);
            *(GAS v2u*)(YN + ch) = w; } }
    __syncthreads();
}
template <int NT> __device__ __forceinline__ void skinny_proj(Ctx& F, const bf16_t* Wt, float* OUT, int NOUT) {
    const int tid = fresh_tid(F.wave); const int lane = tid & 63, fr = lane & 15, fq = lane >> 4, wave = F.wave;
    const bf16_t* XB = (const bf16_t*)(F.ws + WS_XB); LAS float* PART = (LAS float*)(F.lds + RING_OFF);
    const bf16_t* bp = Wt + (size_t)fr * D + 256 * wave + 8 * fq;
    bf16x8 wb[NT][8];
#pragma unroll
    for (int n = 0; n < NT; ++n)
#pragma unroll
        for (int ks = 0; ks < 8; ++ks) wb[n][ks] = *(const GAS bf16x8*)(bp + (size_t)n * 16 * D + 32 * ks);
    for (int rt = blockIdx.x; rt < T / 16; rt += F.G) {
        const bf16_t* ap = XB + (size_t)(rt * 16 + fr) * D + 256 * wave + 8 * fq;
        bf16x8 xa[8];
#pragma unroll
        for (int ks = 0; ks < 8; ++ks) xa[ks] = *(const GAS bf16x8*)(ap + 32 * ks);
#pragma unroll
        for (int n = 0; n < NT; ++n) {
            f32x4 acc = (f32x4){0.f, 0.f, 0.f, 0.f};
#pragma unroll
            for (int ks = 0; ks < 8; ++ks) acc = __builtin_amdgcn_mfma_f32_16x16x32_bf16(wb[n][ks], xa[ks], acc, 0, 0, 0);
            *(LAS f32x4*)(PART + (wave * 16 + fr) * (16 * NT) + 16 * n + 4 * fq) = acc; }
        __syncthreads();
        for (int o = tid; o < 16 * 16 * NT; o += NTHR) { const int r = o / (16 * NT), cidx = o - r * (16 * NT); float a = 0.f;
#pragma unroll
            for (int w = 0; w < 8; ++w) a += PART[(w * 16 + r) * (16 * NT) + cidx];
            if (cidx < NOUT) OUT[(size_t)(rt * 16 + r) * NOUT + cidx] = a; }
        __syncthreads();
    }
}
struct Params { const float* in[28]; float* out; unsigned char* ws; int layer_lo, layer_hi, st_lo, st_hi, bar_region, pad; };
constexpr int N_STEPS = 13;
#ifndef MK_ONE_LAUNCH
#define MK_ONE_LAUNCH 1
#endif
__host__ __device__ constexpr bool step_active(int layer, int k) {
    if (k == 5 || k == 6 || k == 9) return false;
    return (layer & 1) ? true : k != 4;
}
#define VB_LOOP(n) for (size_t vb = blockIdx.x; vb < (size_t)(n); vb += gridDim.x)
#ifndef PROBE_REP_MASK
#define PROBE_REP_MASK 0
#endif
#define REPS(k) _Pragma("unroll 1") for (int rep_ = 0; rep_ < (((PROBE_REP_MASK >> (k)) & 1) ? 2 : 1); ++rep_)
__global__ void __launch_bounds__(NTHR, 2) mk_fwd(Params args) {
    extern __shared__ __attribute__((aligned(16))) unsigned char lds_raw[];
    Ctx F;
    F.lds = (LAS unsigned char*)lds_raw; F.MISC = (volatile LAS unsigned*)(F.lds + MISC_OFF);
    F.wave = __builtin_amdgcn_readfirstlane((int)threadIdx.x >> 6); F.tid = fresh_tid(F.wave); F.lane = F.tid & 63;
    F.G = gridDim.x; { const int bx = blockIdx.x; F.vcu = (F.G % 8 == 0) ? (bx % 8) * (F.G / 8) + bx / 8 : bx; }
#pragma unroll
    for (int i = 0; i < 28; ++i) F.in[i] = args.in[i];
    F.out = args.out; F.ws = args.ws; F.ctl = (gu32*)(args.ws + WS_CTL);
    for (int u = F.tid; u < (LDS_BYTES - LDSCTL_OFF) / 4; u += NTHR) ((LAS unsigned*)(F.lds + LDSCTL_OFF))[u] = 0u;
    __syncthreads();
    XcdBarrier bar; bar.bar = (unsigned*)(F.ctl + CW_BAR); bar.x = 0; bar.st = nullptr;
    const bool has_bar = args.bar_region >= 0;
    if (has_bar) bar = xcd_barrier_post((unsigned*)(F.ctl + CW_BAR) + args.bar_region * XCD_BAR_WORDS, F.MISC + 8, F.tid);
    const int lo = args.st_lo, hi = args.st_hi;
#ifdef STEP_MASK
#define IN(k) (((STEP_MASK >> (k)) & 1) && lo <= (k) && (k) < hi && step_active(layer, (k)))
#else
#define IN(k) (lo <= (k) && (k) < hi && step_active(layer, (k)))
#endif
#define SEAM(k) do { bool more_ = layer + 1 < args.layer_hi; for (int k2 = (k) + 1; k2 < hi; ++k2) more_ = more_ || step_active(layer, k2); if (has_bar && more_) { const int bt_ = fresh_tid(F.wave); xcd_barrier(bar, bt_); if ((PROBE_REP_MASK >> 13) & 1) xcd_barrier(bar, bt_); } } while (0)
#define FRESH() do { F.tid = fresh_tid(F.wave); F.lane = F.tid & 63; } while (0)
    for (int layer = args.layer_lo; layer < args.layer_hi; ++layer) {
        const int j = layer >> 1; const bool even = (layer & 1) == 0;
        if (IN(0)) { FRESH(); REPS(0) s0_convert(F, layer); if (layer == 0 || hi <= 1) SEAM(0); else __syncthreads(); }
        if (IN(1)) {
            if (even ? F8_HY_IN : F8_SS_IN) {
                pg8::Gemm g{(const pg8::bf16_t*)(F.ws + WS_XIN8), even ? (const pg8::bf16_t*)(F.ws + WS_WHYIN8 + (size_t)j * 5120 * 2048) : (const pg8::bf16_t*)(F.ws + WS_WSSIN8 + (size_t)j * 10240 * 2048), T, even ? 5120 : 10240, D / 2};
                pg8::StaticOrder S; S.init(T, g.N, F.G, (int)blockIdx.x);
                pg8::EpiBf16P8 E{(pg8::bf16_t*)(F.ws + WS_PROJ), even ? HY_NP : SS_NP, 1.0f / 512.0f};
                REPS(1) pg8::gemm_phase<pg8::EpiBf16P8, pg8::StaticOrder, PG8_ALIGN, PG8_SP2>(F.lds + RING_OFF, g, S, E, F.wave);
            } else {
                pg8::Gemm g{(const pg8::bf16_t*)(F.ws + WS_XB), even ? (const pg8::bf16_t*)(F.ws + WS_WHYIN) + (size_t)j * HY_NP * 2048 : (const pg8::bf16_t*)(F.ws + WS_WSSIN) + (size_t)j * SS_NP * 2048, T, even ? 5120 : 10240, D};
                pg8::StaticOrder S; S.init(T, g.N, F.G, (int)blockIdx.x);
                pg8::EpiBf16P E{(pg8::bf16_t*)(F.ws + WS_PROJ), even ? HY_NP : SS_NP, 1.0f};
                REPS(1) pg8::gemm_phase<pg8::EpiBf16P, pg8::StaticOrder, PG8_ALIGN, PG8_SP2>(F.lds + RING_OFF, g, S, E, F.wave);
            }
            if (even) skinny_proj<1>(F, (const bf16_t*)(F.ws + WS_WHYIN) + ((size_t)j * HY_NP + 5120) * 2048, (float*)(F.ws + WS_FCUM), 8);
            else skinny_proj<4>(F, (const bf16_t*)(F.ws + WS_WSSIN) + ((size_t)j * SS_NP + 10240) * 2048, (float*)(F.ws + WS_DTB), 64);
            SEAM(1);
        }
        if (IN(2)) { FRESH();
            if (even) { const bf16_t* PROJ = (const bf16_t*)(F.ws + WS_PROJ); bf16_t* YMIX = (bf16_t*)(F.ws + WS_YMIX);
                REPS(2) for (int item = F.vcu; item < 256; item += F.G) fox::attn_item((char*)lds_raw, PROJ, (const float*)(F.ws + WS_FCUM), YMIX, F.in[11] + (size_t)j * 8, item, fresh_tid(F.wave));
                { int hd_lds = -1; REPS(3) for (int item = F.vcu; item < 2048; item += F.G) lru_local_item(F, j, item, hd_lds); }
            } else { int g_lds = -1; for (int item = F.vcu; item < 1024; item += F.G) ssd_states_item(F, j, item, g_lds); }
            SEAM(2); }
        if (IN(3)) { FRESH();
            if (even) { REPS(4) for (int item = F.vcu; item < 256; item += F.G) lru_fix_item(F, item); }
            else { for (int item = F.vcu; item < 256; item += F.G) ssd_scan_item(F, item); }
            SEAM(3); }
        if (IN(4)) { FRESH();
            { int g_lds = -1; REPS(6) for (int item = F.vcu; item < 1024; item += F.G) ssd_y_item(F, j, item, g_lds); }
            SEAM(4); }
        if (IN(7)) {
            pg8::StaticOrder S; S.init(T, D, F.G, (int)blockIdx.x);
            if (even ? F8_HY_OUT : F8_SS_OUT) {
                pg8::Gemm g{even ? (const pg8::bf16_t*)(F.ws + WS_YMIX8) : (const pg8::bf16_t*)(F.ws + WS_YN8), even ? (const pg8::bf16_t*)(F.ws + WS_WHYOUT + (size_t)j * 2048 * 2048) : (const pg8::bf16_t*)(F.ws + WS_WSSOUT + (size_t)j * 2048 * 4096), T, D, even ? 1024 : 2048};
                pg8::EpiBf16P8 E{(pg8::bf16_t*)(F.ws + WS_MBUF), D, 1.0f / 512.0f};
                REPS(7) pg8::gemm_phase<pg8::EpiBf16P8, pg8::StaticOrder, PG8_ALIGN, PG8_SP2>(F.lds + RING_OFF, g, S, E, F.wave);
            } else {
                pg8::Gemm g{even ? (const pg8::bf16_t*)(F.ws + WS_YMIX) : (const pg8::bf16_t*)(F.ws + WS_YN), even ? (const pg8::bf16_t*)(F.ws + WS_WHYOUT) + (size_t)j * 2048 * 2048 : (const pg8::bf16_t*)(F.ws + WS_WSSOUT) + (size_t)j * 2048 * 4096, T, D, even ? 2048 : 4096};
                pg8::EpiBf16P E{(pg8::bf16_t*)(F.ws + WS_MBUF), D, 1.0f};
                REPS(7) pg8::gemm_phase<pg8::EpiBf16P, pg8::StaticOrder, PG8_ALIGN, PG8_SP2>(F.lds + RING_OFF, g, S, E, F.wave);
            }
            SEAM(7);
        }
        if (IN(8)) { FRESH(); if ((PROBE_REP_MASK >> 8) & 1) ln1_router<true>(F, layer); ln1_router<false>(F, layer); SEAM(8); }
        if (IN(10)) {
            pg8::MoeGatherOrder S; moe_tables(F, layer, S.tab); const int Gg = moe_gemm_wgs(F, S.tab[16], layer + 1 < DEPTH); S.G = Gg; S.c = (int)blockIdx.x < Gg ? (int)blockIdx.x : 8 * S.tab[16]; S.exptok = (const int*)(F.ws + WS_EXPTOK); S.cnt = (const unsigned*)(F.ctl + CW_CNT + layer * 16); S.cap = T;
            pg8::Gemm g{(const pg8::bf16_t*)(F.ws + WS_XB8), (const pg8::bf16_t*)(F.ws + ((layer & 1) ? WS_WGU_B : WS_WGU)), T, 2048, D / 2};
            pg8::EpiSwiglu E{F.ws + WS_HID, (const float*)(F.ws + WS_EXPW), S.cnt, T, MOE_FF};
            REPS(10) pg8::gemm_phase<pg8::EpiSwiglu, pg8::MoeGatherOrder, PG8_ALIGN, PG8_SP2>(F.lds + RING_OFF, g, S, E, F.wave);
            if (layer + 1 < DEPTH) moe_tail_convert(F, layer + 1, Gg, 0);
            SEAM(10);
        }
        if (IN(11)) {
            pg8::MoeOrder S; moe_tables(F, layer, S.tab); const int Gg = moe_gemm_wgs(F, S.tab[16], layer + 1 < DEPTH); S.G = Gg; S.c = (int)blockIdx.x < Gg ? (int)blockIdx.x : 8 * S.tab[16];
            pg8::Gemm g{(const pg8::bf16_t*)(F.ws + WS_HID), (const pg8::bf16_t*)(F.ws + ((layer & 1) ? WS_WD_B : WS_WD)), MOE_ROWS, 2048, MOE_FF / 2};
            pg8::EpiBf16P8 E{(pg8::bf16_t*)(F.ws + WS_YG), D, 1.0f / 512.0f};
            REPS(11) pg8::gemm_phase<pg8::EpiBf16P8, pg8::MoeOrder, PG8_ALIGN, PG8_SP2>(F.lds + RING_OFF, g, S, E, F.wave);
            if (layer + 1 < DEPTH) moe_tail_convert(F, layer + 1, Gg, 1);
            SEAM(11);
        }
        if (IN(12)) { FRESH(); if ((PROBE_REP_MASK >> 12) & 1) { ln2_phase<true>(F, layer); __syncthreads(); } ln2_phase<false>(F, layer); SEAM(12); }
    }
#undef IN
#undef SEAM
}
extern "C" void kernel_launch(void* const* d_in, const int* in_sizes, int n_in, void* d_out, int out_size, void* d_ws, size_t ws_size, hipStream_t stream) {
    static int grid = 0;
    if (grid == 0) {
        if (n_in != 28 || out_size != T * D || ws_size < WS_END) { fprintf(stderr, "kernel_launch: unexpected shapes (n_in %d out %d ws %zu need %zu)\n", n_in, out_size, ws_size, (size_t)WS_END); grid = -1; return; }
        int dev = 0, cus = 0; (void)hipGetDevice(&dev); (void)hipDeviceGetAttribute(&cus, hipDeviceAttributeMultiprocessorCount, dev);
        if (hipFuncSetAttribute((const void*)mk_fwd, hipFuncAttributeMaxDynamicSharedMemorySize, LDS_BYTES) != hipSuccess) { fprintf(stderr, "kernel_launch: hipFuncSetAttribute failed\n"); grid = -1; return; }
        int per_cu = 0; (void)hipOccupancyMaxActiveBlocksPerMultiprocessor(&per_cu, (const void*)mk_fwd, NTHR, LDS_BYTES); (void)hipGetLastError();
        grid = 256; if (cus != 256 || per_cu < 1) fprintf(stderr, "kernel_launch: built for 256 CUs x 1 workgroup (144 KiB LDS each); device has %d CUs, occupancy query says %d\n", cus, per_cu);
    }
    if (grid < 0) return;
    (void)hipMemsetAsync((char*)d_ws + WS_CTL, 0, CTL_ZERO_BYTES, stream);
    Params a{};
    for (int i = 0; i < 28; ++i) a.in[i] = (const float*)d_in[i];
    a.out = (float*)d_out; a.ws = (unsigned char*)d_ws;
#if MK_ONE_LAUNCH
    a.layer_lo = 0; a.layer_hi = DEPTH; a.st_lo = 0; a.st_hi = N_STEPS; a.bar_region = 0;
    hipLaunchKernelGGL(mk_fwd, dim3(grid), dim3(NTHR), LDS_BYTES, stream, a);
#else
    for (int layer = 0; layer < DEPTH; ++layer)
        for (int s = 0; s < N_STEPS; ++s) if (step_active(layer, s)) {
            a.layer_lo = layer; a.layer_hi = layer + 1; a.st_lo = s; a.st_hi = s + 1; a.bar_region = -1;
            hipLaunchKernelGGL(mk_fwd, dim3(grid), dim3(NTHR), LDS_BYTES, stream, a);
        }
#endif
}
```

```cpp
#include <hip/hip_runtime.h>
#include <cstdio>
#include <cstdint>
__device__ __forceinline__ float shfl_xor_l(float v, int o, int lane) { return __int_as_float(__builtin_amdgcn_ds_bpermute((lane ^ o) << 2, __float_as_int(v))); }
__device__ __forceinline__ float shfl_up_l(float v, int o, int lane) { return __int_as_float(__builtin_amdgcn_ds_bpermute((lane - o) << 2, __float_as_int(v))); }
__device__ __forceinline__ int lane_id() { return (int)__builtin_amdgcn_mbcnt_hi(~0u, __builtin_amdgcn_mbcnt_lo(~0u, 0u)); }
__device__ __forceinline__ int fresh_tid(int wave) { int t; asm volatile("v_mbcnt_lo_u32_b32 %0, -1, 0\n\tv_mbcnt_hi_u32_b32 %0, -1, %0\n\tv_lshl_add_u32 %0, %1, 6, %0" : "=&v"(t) : "s"(wave)); return t; }
namespace pg8 {
#define PG8_LAS __attribute__((address_space(3)))
typedef unsigned short bf16_t;
typedef short bf16x8 __attribute__((ext_vector_type(8)));
typedef float f32x4 __attribute__((ext_vector_type(4)));
typedef unsigned u32x4 __attribute__((ext_vector_type(4)));
typedef int v8i __attribute__((ext_vector_type(8)));
constexpr int BM = 256, BK = 64, HALF = 128, HTB = HALF * BK * 2  , STAGE_BYTES = 8 * HTB, NXCD = 8, WGM = 8;

__host__ __device__ __forceinline__ int lds_byte(int r, int c) { const int st = (r >> 4) * 2 + (c >> 5), rr = r & 15, cc = c & 31, ob = rr * 64 + cc * 2; return st * 1024 + (ob ^ (((ob >> 9) & 1) << 5)); }
__host__ __device__ __forceinline__ void stage_rc(int b, int& R, int& C) { const int st = b / 1024, sb = b % 1024, swz = sb ^ (((sb >> 9) & 1) << 5); R = (st >> 1) * 16 + swz / 64; C = (st & 1) * 32 + (swz % 64) / 2; }
__host__ __device__ __forceinline__ int perm32(int rho) { const int n = rho >> 4, i = rho & 15; return 8 * (i >> 2) + 4 * n + (i & 3); }

struct Unit { int pm, pn, pb, e, lt; };
struct Gemm { const bf16_t* A; const bf16_t* Bt; int M, N, K; };

struct StaticOrder {
    static constexpr bool GATHER = false;
    int nM, nN, nwg, G, c;
    __host__ __device__ void init(int M, int N, int G_, int c_) { nM = M / BM; nN = N / BM; nwg = nM * nN; G = G_; c = c_; }
    __host__ __device__ bool next(int i, Unit& u) const {
        const long L = (long)i * G + c; if (L >= nwg) return false;
        int wgid = (int)L; { const int q = nwg / NXCD, r = nwg % NXCD, xcd = wgid % NXCD, off = wgid / NXCD; wgid = (xcd < r ? xcd * (q + 1) : r * (q + 1) + (xcd - r) * q) + off; }
        const int nig = WGM * nN, gid = wgid / nig, fm = gid * WGM, gsz = (nM - fm) < WGM ? (nM - fm) : WGM;
        u.pm = fm + ((wgid % nig) % gsz); u.pn = (wgid % nig) / gsz; u.pb = u.pn; u.e = 0; u.lt = 0; return true;
    }
    __device__ __forceinline__ void a_ready(const Unit&) const {}
    __device__ __forceinline__ void done(const Unit&) const {}
};
struct MoeOrder {
    static constexpr bool GATHER = false;
    int tab[17]; int G, c;
    __device__ bool next(int i, Unit& u) const {
        const int nt = tab[16]; const int L = i * G + c; if (L >= nt * 8) return false;
        const int wgid = (L & 7) * nt + (L >> 3); const int t = wgid >> 3, pn = wgid & 7;
        int E = 0;
#pragma unroll
        for (int e = 1; e < 16; ++e) E += (t >= tab[e]) ? 1 : 0;
        int t0 = 0;
#pragma unroll
        for (int e = 1; e < 16; ++e) t0 = (E == e) ? tab[e] : t0;
        u.pm = t; u.pn = pn; u.pb = E * 8 + pn; u.e = E; u.lt = t - t0; return true;
    }
    __device__ __forceinline__ void a_ready(const Unit&) const {}
    __device__ __forceinline__ void done(const Unit&) const {}
};
struct MoeGatherOrder : MoeOrder {
    static constexpr bool GATHER = true;
    const int* exptok; const unsigned* cnt; int cap;
    __device__ __forceinline__ int row_of(const Unit& u, int r) const { const int i = u.lt * 256 + r; const int n = (int)__hip_atomic_load(cnt + u.e, __ATOMIC_RELAXED, __HIP_MEMORY_SCOPE_AGENT);
        return i < n ? exptok[(size_t)u.e * cap + i] : 0; }
};
__device__ __forceinline__ unsigned cvt_pk_bf16(float lo, float hi) { unsigned r; asm volatile("v_cvt_pk_bf16_f32 %0, %1, %2" : "=v"(r) : "v"(lo), "v"(hi)); return r; }

template <bool F8> struct EpiBf16PT {
    static constexpr bool PERM = true, AFTER_DRAIN = false, FP8 = F8;
    bf16_t* O; int ldc; float oscale;
    __device__ __forceinline__ void operator()(const f32x4 (&acc)[2][2][4][2], const Unit& u, int wr, int wc, int fr, int fq) const {
        const int row0 = u.pm * BM + wr * 64 + fr, col0 = u.pn * BM + wc * 32 + 8 * fq;
#pragma unroll
        for (int ai = 0; ai < 2; ++ai)
#pragma unroll
            for (int m = 0; m < 4; ++m) { bf16_t* rowp = O + (size_t)(row0 + ai * HALF + m * 16) * ldc + col0;
#pragma unroll
                for (int bj = 0; bj < 2; ++bj) { f32x4 v0 = acc[ai][bj][m][0], v1 = acc[ai][bj][m][1]; if (F8) { v0 = v0 * oscale; v1 = v1 * oscale; }
                    u32x4 w; w.x = cvt_pk_bf16(v0[0], v0[1]); w.y = cvt_pk_bf16(v0[2], v0[3]); w.z = cvt_pk_bf16(v1[0], v1[1]); w.w = cvt_pk_bf16(v1[2], v1[3]);
                    *(u32x4*)(rowp + bj * HALF) = w; } }
    }
};
typedef EpiBf16PT<false> EpiBf16P;
typedef EpiBf16PT<true> EpiBf16P8;
__device__ __forceinline__ float silu_fast(float x) { return x * __builtin_amdgcn_rcpf(1.0f + __expf(-x)); }
struct EpiSwiglu {
    static constexpr bool PERM = true, AFTER_DRAIN = false, FP8 = true;
    unsigned char* H; const float* expw; const unsigned* cnt; int cap, ldc;
    __device__ __forceinline__ void operator()(const f32x4 (&acc)[2][2][4][2], const Unit& u, int wr, int wc, int fr, int fq) const {
        const int row0 = u.pm * BM + wr * 64 + fr, col0 = u.pn * HALF + wc * 32 + 8 * fq; const int nvalid = (int)__hip_atomic_load(cnt + u.e, __ATOMIC_RELAXED, __HIP_MEMORY_SCOPE_AGENT);
        float gtv[8];
#pragma unroll
        for (int k = 0; k < 8; ++k) { const int li = wr * 64 + fr + (k >> 2) * HALF + (k & 3) * 16 + u.lt * BM; gtv[k] = expw[(size_t)u.e * cap + li]; }
        asm volatile("" : "+v"(gtv[0]), "+v"(gtv[1]), "+v"(gtv[2]), "+v"(gtv[3]), "+v"(gtv[4]), "+v"(gtv[5]), "+v"(gtv[6]), "+v"(gtv[7]));
#pragma unroll
        for (int ai = 0; ai < 2; ++ai)
#pragma unroll
            for (int m = 0; m < 4; ++m) { const int row = row0 + ai * HALF + m * 16; const int li = row - u.pm * BM + u.lt * BM; const float gt = li < nvalid ? gtv[ai * 4 + m] : 0.f;
                const f32x4 g0 = acc[ai][0][m][0], g1 = acc[ai][0][m][1], u0 = acc[ai][1][m][0], u1 = acc[ai][1][m][1];
                float h[8]; const float ds = 1.0f / 512.0f, gs = gt * (4.0f / 512.0f);
#pragma unroll
                for (int i = 0; i < 4; ++i) { h[i] = __builtin_amdgcn_fmed3f(silu_fast(g0[i] * ds) * u0[i] * gs, -448.f, 448.f); h[4 + i] = __builtin_amdgcn_fmed3f(silu_fast(g1[i] * ds) * u1[i] * gs, -448.f, 448.f); }
                int w0 = __builtin_amdgcn_cvt_pk_fp8_f32(h[0], h[1], 0, false); w0 = __builtin_amdgcn_cvt_pk_fp8_f32(h[2], h[3], w0, true);
                int w1 = __builtin_amdgcn_cvt_pk_fp8_f32(h[4], h[5], 0, false); w1 = __builtin_amdgcn_cvt_pk_fp8_f32(h[6], h[7], w1, true);
                typedef int i32x2 __attribute__((ext_vector_type(2)));
                *(i32x2*)(H + (size_t)row * ldc + col0) = (i32x2){w0, w1}; }
    }
};
template <class Epi, class Sched, bool ALIGN_EPI = false, bool SP2 = true>
__device__ __forceinline__ void gemm_phase(PG8_LAS unsigned char* lds, const Gemm g, const Sched& S, const Epi& E, int wave_in) {
    static_assert(SP2, "only the two-super-phase K-loop is kept in this file");
    const int tid_ = fresh_tid(wave_in);
    const int tid = tid_, wid = __builtin_amdgcn_readfirstlane(tid >> 6), lane = tid & 63, wr = wid >> 2, wc = wid & 3, fr = lane & 15, fq = lane >> 4;
    const int K = g.K, nt = K / BK;
    constexpr bool GATHER = Sched::GATHER;
    unsigned voffB[2]; int RA[2], CA[2];
#pragma unroll
    for (int i = 0; i < 2; ++i) { int R, C; stage_rc(tid * 16 + i * 8192, R, C); const int Rb = Epi::PERM ? ((R & ~31) + perm32(R & 31)) : R; RA[i] = R; CA[i] = C; voffB[i] = (unsigned)(Rb * K + C) * 2u; }
    const size_t kstep = (size_t)(BK * 2);
    const size_t hstep = (size_t)HALF * K * 2;
    const size_t tstep = 2 * hstep;
    const unsigned ldsw = (unsigned)wid * 1024u;
    PG8_LAS int* IDX = (PG8_LAS int*)(lds + STAGE_BYTES);
    unsigned vc[2][2], vn[2][2];
#pragma unroll
    for (int h = 0; h < 2; ++h)
#pragma unroll
        for (int i = 0; i < 2; ++i) { vc[h][i] = (unsigned)((h * HALF + RA[i]) * K + CA[i]) * 2u; vn[h][i] = vc[h][i]; }
    const int aoff = lds_byte(wr * 64 + fr, fq * 8), boff = lds_byte(wc * 32 + fr, fq * 8);
#define PG8_SA(b, h) (((b) * 2 + (h)) * HTB)
#define PG8_SB(b, h) ((4 + (b) * 2 + (h)) * HTB)
#define PG8_STAGE(bufoff, gbase, voff) do { _Pragma("unroll") for (int _i = 0; _i < 2; ++_i) \
        __builtin_amdgcn_global_load_lds((const unsigned*)((const char*)(gbase) + (voff)[_i]), (PG8_LAS unsigned*)(lds + (bufoff) + ldsw + _i * 8192), 16, 0, 0); } while (0)
#define PG8_LDA(dst, b, h) do { _Pragma("unroll") for (int m = 0; m < 4; ++m) _Pragma("unroll") for (int k = 0; k < 2; ++k) dst[m][k] = *(const PG8_LAS bf16x8*)(lds + PG8_SA(b, h) + aoff + m * 2048 + k * 1024); } while (0)
#define PG8_LDB(dst, b, h) do { _Pragma("unroll") for (int n = 0; n < 2; ++n) _Pragma("unroll") for (int k = 0; k < 2; ++k) dst[n][k] = *(const PG8_LAS bf16x8*)(lds + PG8_SB(b, h) + boff + n * 2048 + k * 1024); } while (0)
#define PG8_MMA(ai, bj, At, Bt) do { __builtin_amdgcn_s_setprio(1); _Pragma("unroll") for (int m = 0; m < 4; ++m) _Pragma("unroll") for (int n = 0; n < 2; ++n) { \
        if constexpr (Epi::FP8) { v8i a8_, b8_; { const u32x4 x0_ = __builtin_bit_cast(u32x4, At[m][0]), x1_ = __builtin_bit_cast(u32x4, At[m][1]), y0_ = __builtin_bit_cast(u32x4, Bt[n][0]), y1_ = __builtin_bit_cast(u32x4, Bt[n][1]); \
                a8_ = (v8i){(int)x0_.x, (int)x0_.y, (int)x0_.z, (int)x0_.w, (int)x1_.x, (int)x1_.y, (int)x1_.z, (int)x1_.w}; b8_ = (v8i){(int)y0_.x, (int)y0_.y, (int)y0_.z, (int)y0_.w, (int)y1_.x, (int)y1_.y, (int)y1_.z, (int)y1_.w}; } \
            acc[ai][bj][m][n] = __builtin_amdgcn_mfma_scale_f32_16x16x128_f8f6f4(b8_, a8_, acc[ai][bj][m][n], 0, 0, 0, 0x7f7f7f7f, 0, 0x7f7f7f7f); asm volatile("" : "+v"(acc[ai][bj][m][n])); } \
        else { _Pragma("unroll") for (int k = 0; k < 2; ++k) acc[ai][bj][m][n] = __builtin_amdgcn_mfma_f32_16x16x32_bf16(Bt[n][k], At[m][k], acc[ai][bj][m][n], 0, 0, 0); } } \
        __builtin_amdgcn_s_setprio(0); } while (0)
#define PG8_WAIT_V(n) asm volatile("s_waitcnt vmcnt(" #n ")" ::: "memory")
#define PG8_WAIT_L(n) asm volatile("s_waitcnt lgkmcnt(" #n ")" ::: "memory")
#define PG8_BAR __builtin_amdgcn_s_barrier()
#define PG8_SCHED __builtin_amdgcn_sched_barrier(0)
#define PG8_FETCH_ROWS(u_, slot_) do { if (wid == 7) { int r4_[4]; _Pragma("unroll") for (int q_ = 0; q_ < 4; ++q_) r4_[q_] = S.row_of((u_), lane + 64 * q_); \
        asm volatile("s_waitcnt vmcnt(0)" ::: "memory"); _Pragma("unroll") for (int q_ = 0; q_ < 4; ++q_) IDX[(slot_) * 256 + lane + 64 * q_] = r4_[q_]; } } while (0)
#define PG8_ROW_OFFS(dst_, slot_) do { _Pragma("unroll") for (int h_ = 0; h_ < 2; ++h_) _Pragma("unroll") for (int i_ = 0; i_ < 2; ++i_) \
        dst_[h_][i_] = (unsigned)(IDX[(slot_) * 256 + h_ * HALF + RA[i_]] * K + CA[i_]) * 2u; } while (0)
    Unit cur, nxt; int ui = 0;
    if (!S.next(0, cur)) return;
    f32x4 acc[2][2][4][2];
#pragma unroll
    for (int a = 0; a < 2; ++a)
#pragma unroll
        for (int b = 0; b < 2; ++b)
#pragma unroll
            for (int m = 0; m < 4; ++m)
#pragma unroll
                for (int n = 0; n < 2; ++n) acc[a][b][m][n] = (f32x4){0.f, 0.f, 0.f, 0.f};
    bf16x8 At[4][2], B0[2][2], B1[2][2];
    const char* cA = GATHER ? (const char*)g.A : (const char*)g.A + (size_t)cur.pm * tstep; const char* cB = (const char*)g.Bt + (size_t)cur.pb * tstep;
    S.a_ready(cur);
    if constexpr (GATHER) { PG8_FETCH_ROWS(cur, 0); PG8_WAIT_L(0); PG8_BAR; asm volatile("" ::: "memory"); PG8_ROW_OFFS(vc, 0); }
    PG8_STAGE(PG8_SB(0, 0), cB, voffB); PG8_STAGE(PG8_SB(0, 1), cB + hstep, voffB); PG8_STAGE(PG8_SA(0, 0), cA, vc[0]); PG8_STAGE(PG8_SA(0, 1), cA, vc[1]);
    if (wr == 1) PG8_BAR;
    PG8_WAIT_V(2); PG8_BAR;
    PG8_STAGE(PG8_SB(1, 0), cB + kstep, voffB); PG8_STAGE(PG8_SA(1, 0), cA + kstep, vc[0]); PG8_STAGE(PG8_SB(1, 1), cB + hstep + kstep, voffB);
    PG8_WAIT_V(6); PG8_BAR;
    for (;;) {
        const bool has_next = S.next(ui + 1, nxt);
        const char* nA = GATHER ? (const char*)g.A : (has_next ? (const char*)g.A + (size_t)nxt.pm * tstep : cA); const char* nB = has_next ? (const char*)g.Bt + (size_t)nxt.pb * tstep : cB;
        if constexpr (GATHER) { if (has_next) PG8_FETCH_ROWS(nxt, (ui + 1) & 1); }
        for (int t = 0; t < nt; t += 2) {
            const bool last = (t == nt - 2);
            const char* a1 = cA + (size_t)(t + 1) * kstep;
            const char* a2 = last ? nA : cA + (size_t)(t + 2) * kstep; const char* b2 = last ? nB : cB + (size_t)(t + 2) * kstep;
            const char* a3 = a2 + kstep; const char* b3 = b2 + kstep;
            if (last && has_next) { S.a_ready(nxt); if constexpr (GATHER) { PG8_ROW_OFFS(vn, (ui + 1) & 1); } }
            unsigned v2[2][2];
#pragma unroll
            for (int h = 0; h < 2; ++h)
#pragma unroll
                for (int i = 0; i < 2; ++i) v2[h][i] = (GATHER && last && has_next) ? vn[h][i] : vc[h][i];
            PG8_LDB(B0, 0, 0); PG8_LDB(B1, 0, 1); PG8_SCHED; PG8_LDA(At, 0, 0); PG8_STAGE(PG8_SA(1, 1), a1, vc[1]);
            PG8_WAIT_V(8); PG8_WAIT_L(0); PG8_BAR; PG8_MMA(0, 0, At, B0); PG8_MMA(0, 1, At, B1); PG8_BAR; PG8_SCHED;
            PG8_LDA(At, 0, 1); PG8_STAGE(PG8_SB(0, 0), b2, voffB); PG8_STAGE(PG8_SB(0, 1), b2 + hstep, voffB); PG8_STAGE(PG8_SA(0, 0), a2, v2[0]);
            PG8_WAIT_V(8); PG8_WAIT_L(0); PG8_BAR; PG8_MMA(1, 0, At, B0); PG8_MMA(1, 1, At, B1); PG8_BAR; PG8_SCHED;
            PG8_LDB(B0, 1, 0); PG8_LDB(B1, 1, 1); PG8_SCHED; PG8_LDA(At, 1, 0); PG8_STAGE(PG8_SA(0, 1), a2, v2[1]);
            PG8_WAIT_V(8); PG8_WAIT_L(0); PG8_BAR; PG8_MMA(0, 0, At, B0); PG8_MMA(0, 1, At, B1); PG8_BAR; PG8_SCHED;
            PG8_LDA(At, 1, 1); PG8_STAGE(PG8_SB(1, 0), b3, voffB); PG8_STAGE(PG8_SB(1, 1), b3 + hstep, voffB); PG8_STAGE(PG8_SA(1, 0), a3, v2[0]);
            PG8_WAIT_V(8); PG8_WAIT_L(0); PG8_BAR; PG8_MMA(1, 0, At, B0); PG8_MMA(1, 1, At, B1); PG8_BAR; PG8_SCHED;
        }
        if constexpr (ALIGN_EPI) { if (wr == 0) PG8_BAR; }
        if constexpr (!Epi::AFTER_DRAIN) { E(acc, cur, wr, wc, fr, fq); S.done(cur); }
        if (!has_next) break;
#pragma unroll
        for (int a = 0; a < 2; ++a)
#pragma unroll
            for (int b = 0; b < 2; ++b)
#pragma unroll
                for (int m = 0; m < 4; ++m)
#pragma unroll
                    for (int n = 0; n < 2; ++n) acc[a][b][m][n] = (f32x4){0.f, 0.f, 0.f, 0.f};
        cur = nxt; cA = nA; cB = nB; ++ui;
        if constexpr (GATHER) {
#pragma unroll
            for (int h = 0; h < 2; ++h)
#pragma unroll
                for (int i = 0; i < 2; ++i) vc[h][i] = vn[h][i]; }
        if constexpr (ALIGN_EPI) { if (wr == 1) PG8_BAR; }
    }
    PG8_WAIT_V(0);
    if constexpr (!ALIGN_EPI) { if (wr == 0) PG8_BAR; }
    PG8_BAR;
    if constexpr (Epi::AFTER_DRAIN) { E.fused(acc, cur, wr, wc, fr, fq, lds, wid, lane); S.done(cur); }
#undef PG8_SA
#undef PG8_SB
#undef PG8_STAGE
#undef PG8_LDA
#undef PG8_LDB
#undef PG8_MMA
#undef PG8_WAIT_V
#undef PG8_WAIT_L
#undef PG8_BAR
#undef PG8_SCHED
#undef PG8_FETCH_ROWS
#undef PG8_ROW_OFFS
}
}
#ifndef PG8_SP2
#define PG8_SP2 true
#endif
#ifndef PG8_ALIGN
#define PG8_ALIGN true
#endif
constexpr int BATCH = 4, SEQ = 4096, T = BATCH * SEQ, D = 2048, DEPTH = 4;
constexpr int HY_N = 5128, HY_NP = 5376;
constexpr int SS_N = 10304, SS_NP = 10496;
constexpr int LRU_W = 1024;
constexpr int SSD_INNER = 4096, SSD_CONV = 6144, SSD_H = 64, SSD_P = 64, SSD_G = 8, SSD_NS = 128, SSD_L = 128, SSD_NC = SEQ / SSD_L;
constexpr int MOE_FF = 1024, MOE_E = 16, MOE_ROWS = 2 * T + MOE_E * 256;
constexpr float ALPHA = 1.6817928305074290f;
constexpr float LN_EPS = 1e-5f, RMS_EPS = 1e-5f;
constexpr int NWAVES = 8, NTHR = 512;
constexpr size_t MiB = 1u << 20;
constexpr size_t WS_CTL = 0, CTL_ZERO_BYTES = 1 * MiB;
constexpr size_t WS_TOKSLOT = 1 * MiB;
constexpr size_t WS_TOKPOS = WS_TOKSLOT + 512 * 1024;
constexpr size_t WS_ROWGATE = WS_TOKPOS + 128 * 1024;
constexpr size_t WS_WRT = 2 * MiB;
constexpr size_t WS_WRI = 3 * MiB;
constexpr size_t WS_WHYIN = 4 * MiB;
constexpr size_t WS_WHYOUT = 46 * MiB;
constexpr size_t WS_WSSIN = 62 * MiB;
constexpr size_t WS_WSSOUT = 144 * MiB;
constexpr size_t WS_WGU = 176 * MiB;
constexpr size_t WS_WD = 304 * MiB;
constexpr size_t WS_X = 368 * MiB;
#ifndef F8_HY_IN
#define F8_HY_IN 1
#endif
#ifndef F8_SS_IN
#define F8_SS_IN 0
#endif
#ifndef F8_HY_OUT
#define F8_HY_OUT 1
#endif
#ifndef F8_SS_OUT
#define F8_SS_OUT 0
#endif
constexpr size_t WS_YN8 = 420 * MiB;
constexpr size_t WS_XIN8 = 368 * MiB;
constexpr size_t WS_WHYIN8 = 400 * MiB;
constexpr size_t WS_WSSIN8 = 420 * MiB;
constexpr size_t WS_XB = 496 * MiB;
constexpr size_t WS_MBUF = 560 * MiB;
constexpr size_t WS_ARENA = 624 * MiB;
constexpr size_t WS_PROJ = WS_ARENA;
constexpr size_t WS_HLOC = WS_ARENA + 168 * MiB;
constexpr size_t WS_CUMA = WS_ARENA + 232 * MiB;
constexpr size_t WS_LSUM = WS_ARENA + 296 * MiB;
constexpr size_t WS_YMIX = WS_ARENA + 298 * MiB;
constexpr size_t WS_FCUM = WS_ARENA + 362 * MiB;
constexpr size_t WS_STATES = WS_ARENA + 328 * MiB;
constexpr size_t WS_YN = WS_ARENA + 456 * MiB;
constexpr size_t WS_YMIX8 = WS_ARENA + 298 * MiB;
constexpr size_t WS_DTB = WS_ARENA + 584 * MiB;
constexpr size_t WS_ACSB = WS_ARENA + 588 * MiB;
constexpr size_t WS_XS = WS_ARENA + 592 * MiB;
constexpr size_t WS_BS = WS_ARENA + 720 * MiB;
constexpr size_t WS_WGU_B = WS_ARENA + 752 * MiB;
constexpr size_t WS_WD_B = WS_ARENA + 880 * MiB;
constexpr size_t WS_EXPTOK = WS_ARENA;
constexpr size_t WS_EXPW = WS_ARENA + 1 * MiB;
constexpr size_t WS_XB8 = WS_ARENA + 4 * MiB;
constexpr size_t WS_XG = WS_ARENA;
constexpr size_t WS_HID = WS_ARENA + 144 * MiB;
constexpr size_t WS_YG = WS_ARENA + 216 * MiB;
constexpr size_t WS_NAIVE = WS_ARENA + 600 * MiB;
constexpr size_t WS_END = WS_ARENA + 1060 * MiB;
constexpr int CW_TMO = 0, CW_CODE = 1, CW_CNT = 64  , CW_CVTHEAD = 256  , CW_DONE = 512  , CW_BAR = 4096;
constexpr int N_BAR_REGIONS = 8;
constexpr int RING_OFF = 0, RING_BYTES = 159744, LDSCTL_OFF = RING_BYTES, MISC_OFF = LDSCTL_OFF + 320, LDS_BYTES = 163840;
constexpr int TAB_OFF = LDSCTL_OFF;

#define GAS __attribute__((address_space(1)))
#define LAS __attribute__((address_space(3)))
typedef unsigned short bf16_t;
typedef unsigned v4u __attribute__((ext_vector_type(4)));
typedef unsigned v2u __attribute__((ext_vector_type(2)));
typedef float f32x4 __attribute__((ext_vector_type(4)));
typedef short bf16x8 __attribute__((ext_vector_type(8)));
typedef GAS unsigned gu32;
#define RLX_AGENT __ATOMIC_RELAXED, __HIP_MEMORY_SCOPE_AGENT
#define LDS_WAIT() asm volatile("s_waitcnt lgkmcnt(0)" ::: "memory")
#define VM_WAIT() asm volatile("s_waitcnt vmcnt(0)" ::: "memory")
__device__ __forceinline__ unsigned f2bf(float f) { unsigned u = __builtin_bit_cast(unsigned, f); return (u + 0x7fffu + ((u >> 16) & 1u)) >> 16; }
typedef float f32x2_t __attribute__((ext_vector_type(2))); typedef __bf16 bf16x2_t __attribute__((ext_vector_type(2)));
__device__ __forceinline__ unsigned pk2(float lo, float hi) { f32x2_t v = {lo, hi}; bf16x2_t b = __builtin_convertvector(v, bf16x2_t); return __builtin_bit_cast(unsigned, b); }
__device__ __forceinline__ float bf2f(unsigned short v) { return __uint_as_float(((unsigned)v) << 16); }
__device__ __forceinline__ float bflo(unsigned w) { return __uint_as_float(w << 16); }
__device__ __forceinline__ float bfhi(unsigned w) { return __uint_as_float(w & 0xffff0000u); }
__device__ __forceinline__ float sigmoid_(float x) { return __builtin_amdgcn_rcpf(1.0f + __expf(-x)); }
__device__ __forceinline__ float silu_(float x) { return x / (1.0f + __expf(-x)); }
__device__ __forceinline__ int pk_fp8x4(f32x4 v, float sc) { v = v * sc;
    const float a = __builtin_amdgcn_fmed3f(v.x, -448.f, 448.f), b = __builtin_amdgcn_fmed3f(v.y, -448.f, 448.f), c = __builtin_amdgcn_fmed3f(v.z, -448.f, 448.f), d = __builtin_amdgcn_fmed3f(v.w, -448.f, 448.f);
    int w = __builtin_amdgcn_cvt_pk_fp8_f32(a, b, 0, false); return __builtin_amdgcn_cvt_pk_fp8_f32(c, d, w, true); }
__device__ __forceinline__ float silu_fast2(float x) { return x * __builtin_amdgcn_rcpf(1.0f + __expf(-x)); }
__device__ __forceinline__ float log1p_fast(float e) { return e < 0.06f ? e * (1.0f - e * (0.5f - e * (0.33333333f - e * 0.25f))) : __logf(1.0f + e); }
__device__ __forceinline__ float softplus_(float x) { return fmaxf(x, 0.f) + log1p_fast(__expf(-fabsf(x))); }
__device__ __forceinline__ float gelu_tanh_(float x) { const float u = 0.7978845608028654f * (x + 0.044715f * x * x * x); return 0.5f * x * (1.0f + tanhf(u)); }
#define XB_TMO      128
#define XB_XCNT(j)  (256  + 64 * (j))
#define XB_XSUB(j)  (1280 + 64 * (j))
#define XB_XGEN(j)  (2304 + 64 * (j))
#define XB_TOP      3328
#define XB_TOPGEN   3392
#define XCD_BAR_WORDS 3456
#define XB_SPIN_CAP (1u << 18)

__device__ __forceinline__ unsigned xb_ld(unsigned* p)              { return __hip_atomic_load(p, __ATOMIC_RELAXED, __HIP_MEMORY_SCOPE_AGENT); }
__device__ __forceinline__ unsigned xb_add(unsigned* p, unsigned v) { return __hip_atomic_fetch_add(p, v, __ATOMIC_RELAXED, __HIP_MEMORY_SCOPE_AGENT); }
__device__ __forceinline__ unsigned xb_xcc_id() { return (unsigned)__builtin_amdgcn_s_getreg((3 << 11) | 20) & 0xFu; }
#define XB_SPIN(cond, bar) do { unsigned _sp = 0; while (cond) { __builtin_amdgcn_s_sleep(1); \
    if ((++_sp & 255u) == 0u) { if (xb_ld(&(bar)[XB_TMO])) break; if (_sp > XB_SPIN_CAP) { atomicAdd(&(bar)[XB_TMO], 1u); break; } } } } while (0)

struct XcdBarrier {
    unsigned* bar; unsigned x;
    volatile LAS unsigned* st;
};

__device__ __forceinline__ XcdBarrier xcd_barrier_post(unsigned* bar, volatile LAS unsigned* st, int tid) {
    XcdBarrier b; b.bar = bar; b.x = xb_xcc_id(); b.st = st;
    if (tid == 0) (void)xb_add(&bar[XB_XCNT(b.x)], 1u);
    return b;
}
__device__ __forceinline__ void xcd_barrier_complete(unsigned* bar, unsigned x, unsigned& nloc, unsigned& nx) {
    const unsigned G = gridDim.x * gridDim.y * gridDim.z;
    unsigned sum, cnt, mine, sp = 0u;
    for (;;) {
        sum = 0u; cnt = 0u; mine = 0u;
#pragma unroll
        for (unsigned j = 0; j < 16; ++j) { const unsigned c = xb_ld(&bar[XB_XCNT(j)]); sum += c; cnt += (c > 0u) ? 1u : 0u; mine = (j == x) ? c : mine; }
        if (sum == G) break;
        __builtin_amdgcn_s_sleep(1);
        if ((++sp & 255u) == 0u) { if (xb_ld(&bar[XB_TMO])) break; if (sp > XB_SPIN_CAP) { atomicAdd(&bar[XB_TMO], 1u); break; } }
    }
    nloc = mine > 0u ? mine : 1u; nx = cnt > 0u ? cnt : 1u;
}

__device__ __forceinline__ void xcd_barrier(const XcdBarrier& b, int tid) {
    asm volatile("s_waitcnt vmcnt(0)" ::: "memory");
    __syncthreads();
    if (tid == 0) {
        unsigned* bar = b.bar;
        __builtin_amdgcn_s_waitcnt(0);
        unsigned nloc = b.st[0], nx = b.st[1];
        if (nloc == 0u) { xcd_barrier_complete(bar, b.x, nloc, nx); b.st[0] = nloc; b.st[1] = nx; }
        const unsigned old = xb_add(&bar[XB_XSUB(b.x)], 1u);
        const unsigned gen = old / nloc;
        if (old + 1u == (gen + 1u) * nloc) {
            __builtin_amdgcn_fence(__ATOMIC_RELEASE, "agent");
            asm volatile("s_waitcnt vmcnt(0)" ::: "memory");
            const unsigned og = xb_add(&bar[XB_TOP], 1u);
            const unsigned tg = og / nx;
            if (og + 1u == (tg + 1u) * nx) xb_add(&bar[XB_TOPGEN], 1u);
            else XB_SPIN(xb_ld(&bar[XB_TOPGEN]) == tg, bar);
            __builtin_amdgcn_fence(__ATOMIC_ACQUIRE, "agent");
            xb_add(&bar[XB_XGEN(b.x)], 1u);
            asm volatile("s_waitcnt vmcnt(0)" ::: "memory");
        } else {
            XB_SPIN(xb_ld(&bar[XB_XGEN(b.x)]) == gen, bar);
            __builtin_amdgcn_fence(__ATOMIC_ACQUIRE, "agent");
            asm volatile("s_waitcnt vmcnt(0)" ::: "memory");
        }
    }
    __syncthreads();
}
namespace fox {
using bf16 = unsigned short;
constexpr int D = 128, QPITCH = 5376, KVPITCH = 5376, OPITCH = 2048;
constexpr bool WSKIP = false;
constexpr float THR = 8.f;
constexpr float SCALE = 0.08838834764831845f;
constexpr int NW = 8, QBLK = 32, KVBLK = 64, QB = NW * QBLK;
constexpr int SHM_V = KVBLK * D * 2, SHM_K = KVBLK * D * 2;
constexpr int ATT_LDS = 2 * SHM_V + 2 * SHM_K + NW * 64 * 4;
constexpr int FB_OFF = ATT_LDS;
constexpr int ATT_LDS_TOTAL = FB_OFF + 4096 * 8;
typedef short bf16x8 __attribute__((ext_vector_type(8)));
typedef short s16x4 __attribute__((ext_vector_type(4)));
typedef float f32x16 __attribute__((ext_vector_type(16)));
typedef float f32x4 __attribute__((ext_vector_type(4)));
typedef unsigned u32x4 __attribute__((ext_vector_type(4)));
template <class A, class Bt> struct same_t { static constexpr bool v = false; };
template <class A> struct same_t<A, A> { static constexpr bool v = true; };

#define KSWZ(row, colB) ((row) * 256 + ((colB) ^ (((row) & 7) << 4)))
#define SBAR() __builtin_amdgcn_sched_barrier(0)
__device__ __forceinline__ int v_st(int k, int c) { const int kk = (k & ~0xC) | ((k & 4) << 1) | ((k & 8) >> 1); return ((kk >> 3) * 4 + (c >> 5)) * 512 + ((kk & 7) * 32 + (c & 31)) * 2; }
__device__ __forceinline__ int v_rd_base(int lane) { return ((lane & 3) << 3) | (((lane >> 2) & 3) << 6) | (((lane >> 4) & 1) << 5) | (((lane >> 5) & 1) << 8); }
constexpr int v_rd_off(int d0, int ks, int half) { return d0 * 512 + ks * 4096 + half * 2048; }
__device__ __forceinline__ int crow(int r, int hi) { return (r & 3) + 8 * (r >> 2) + 4 * hi; }
__device__ __forceinline__ unsigned cvtpk(float lo, float hi) {
    unsigned r; asm volatile("v_cvt_pk_bf16_f32 %0, %1, %2" : "=v"(r) : "v"(lo), "v"(hi)); return r;
}
__device__ __forceinline__ bf16x8 pack8(f32x4 a, f32x4 b) {
    u32x4 w = {cvtpk(a[0], a[1]), cvtpk(a[2], a[3]), cvtpk(b[0], b[1]), cvtpk(b[2], b[3])};
    return *reinterpret_cast<bf16x8*>(&w);
}
template <class T> __device__ __forceinline__ bf16x8 load8(const T* p) {
    if constexpr (same_t<T, float>::v) { return pack8(*(const f32x4*)p, *(const f32x4*)(p + 4)); }
    else { return *reinterpret_cast<const bf16x8*>(p); }
}
__device__ __forceinline__ void mask_tile(f32x16& p0, f32x16& p1, int dq, unsigned W) {
    const float NEG = -__builtin_inff();
#pragma unroll
    for (int r = 0; r < 16; ++r) {
        const int c = (r & 3) + 8 * (r >> 2);
        if ((unsigned)(dq - c) >= W) p0[r] = NEG;
        if ((unsigned)(dq - c - 32) >= W) p1[r] = NEG;
    }
}
__device__ __forceinline__ void partialSM(f32x16& p0, f32x16& p1, float& m_reg, float& mn, float& alpha) {
    float pmax = p0[0]; for (int r = 1; r < 16; ++r) pmax = fmaxf(pmax, p0[r]); for (int r = 0; r < 16; ++r) pmax = fmaxf(pmax, p1[r]);
    { auto rr = __builtin_amdgcn_permlane32_swap(__float_as_uint(pmax), __float_as_uint(pmax), false, false);
      pmax = fmaxf(__uint_as_float(rr[0]), __uint_as_float(rr[1])); }
    constexpr float C2 = 1.4426950408889634f * SCALE;
    if (__builtin_expect(__all((pmax - m_reg) * SCALE <= THR), 1)) { mn = m_reg; alpha = 1.f; }
    else { mn = fmaxf(m_reg, pmax); alpha = __builtin_amdgcn_exp2f((m_reg - mn) * C2); m_reg = mn; }
    const float mnL = -mn * C2;
    for (int r = 0; r < 16; ++r) p0[r] = fmaf(p0[r], C2, mnL); for (int r = 0; r < 16; ++r) p1[r] = fmaf(p1[r], C2, mnL);
    for (int r = 0; r < 16; ++r) p0[r] = __builtin_amdgcn_exp2f(p0[r]);
}
__device__ __forceinline__ void finishSM(f32x16& p0, f32x16& p1, float alpha, float& l_reg, bf16x8& pa0, bf16x8& pa1, bf16x8& pa2, bf16x8& pa3) {
    for (int r = 0; r < 16; ++r) p1[r] = __builtin_amdgcn_exp2f(p1[r]);
    float ps = 0; for (int r = 0; r < 16; ++r) ps += p0[r]; for (int r = 0; r < 16; ++r) ps += p1[r];
    { auto rr = __builtin_amdgcn_permlane32_swap(__float_as_uint(ps), __float_as_uint(ps), false, false);
      ps = __uint_as_float(rr[0]) + __uint_as_float(rr[1]); }
    l_reg = l_reg * alpha + ps;
#define PK4(P, B_, OUT) do { unsigned a0 = cvtpk(P[B_+0], P[B_+1]), a1 = cvtpk(P[B_+2], P[B_+3]);                          \
        unsigned b0 = cvtpk(P[B_+4], P[B_+5]), b1 = cvtpk(P[B_+6], P[B_+7]);                                             \
        auto r0 = __builtin_amdgcn_permlane32_swap(a0, b0, false, false); auto r1 = __builtin_amdgcn_permlane32_swap(a1, b1, false, false); \
        u32x4 w = {r0[0], r1[0], r0[1], r1[1]}; OUT = *reinterpret_cast<bf16x8*>(&w); } while (0)
    PK4(p0, 0, pa0); PK4(p0, 8, pa1); PK4(p1, 0, pa2); PK4(p1, 8, pa3);
#undef PK4
}
template <int KB, bool SK>
__device__ __forceinline__ void qkt(f32x16& p0, f32x16& p1, const char* K_lds, int r32, int hi, const bf16x8* qr, bool act, const char* fbp) {
    if (SK && !act) { const float NEG = -__builtin_inff();
#pragma unroll
        for (int r = 0; r < 16; ++r) { p0[r] = NEG; p1[r] = NEG; } return; }
    p0 = f32x16{}; p1 = f32x16{};
    const char* kb[4];
#pragma unroll
    for (int dd = 0; dd < 4; ++dd) kb[dd] = K_lds + KB * SHM_K + KSWZ(r32, (dd * 16 + hi * 8) * 2);
#pragma unroll
    for (int d0 = 0; d0 < 8; ++d0) { const char* a = kb[d0 & 3] + (d0 >> 2) * 128;
        bf16x8 b0 = *reinterpret_cast<const bf16x8*>(a);
        bf16x8 b1 = *reinterpret_cast<const bf16x8*>(a + 32 * 256);
        p0 = __builtin_amdgcn_mfma_f32_32x32x16_bf16(b0, qr[d0], p0, 0, 0, 0);
        p1 = __builtin_amdgcn_mfma_f32_32x32x16_bf16(b1, qr[d0], p1, 0, 0, 0); }
#ifndef FOX_NO_BIAS
    { typedef unsigned u32x2 __attribute__((ext_vector_type(2)));
      const u32x2 f0 = *reinterpret_cast<const u32x2*>(fbp), f1 = *reinterpret_cast<const u32x2*>(fbp + 32 * 8);
      const unsigned m = hi ? 0u : 0xffffffffu;
      u32x4 a0 = {f0.x & m, f0.y & m, 0u, 0u}, a1 = {f1.x & m, f1.y & m, 0u, 0u}; u32x4 qa = {0x3f803f80u, 0x00003f80u, 0u, 0u};
      p0 = __builtin_amdgcn_mfma_f32_32x32x16_bf16(*reinterpret_cast<bf16x8*>(&a0), *reinterpret_cast<bf16x8*>(&qa), p0, 0, 0, 0);
      p1 = __builtin_amdgcn_mfma_f32_32x32x16_bf16(*reinterpret_cast<bf16x8*>(&a1), *reinterpret_cast<bf16x8*>(&qa), p1, 0, 0, 0); }
#endif
}
template <int VB, bool SK>
__device__ __forceinline__ void pv_tile(f32x16* o, int vb0, bf16x8 pa0, bf16x8 pa1, bf16x8 pa2, bf16x8 pa3, bool act) {
    if (SK && !act) return;
#define TRRD(dst, off) asm volatile("ds_read_b64_tr_b16 %0, %1 offset:%2" : "=&v"(dst) : "v"(vb0), "i"(off) : "memory")
#define PV_D0(d0) do { s16x4 l0, l1, l2, l3, h0, h1, h2, h3; constexpr int b_ = VB * SHM_V + v_rd_off(d0, 0, 0);     \
        TRRD(l0, b_); TRRD(h0, b_ + 2048); TRRD(l1, b_ + 4096); TRRD(h1, b_ + 6144); TRRD(l2, b_ + 8192); TRRD(h2, b_ + 10240); TRRD(l3, b_ + 12288); TRRD(h3, b_ + 14336); \
        asm volatile("s_waitcnt lgkmcnt(0)" ::: "memory"); SBAR();                 \
        o[d0] = __builtin_amdgcn_mfma_f32_32x32x16_bf16(pa0, (bf16x8){l0[0], l0[1], l0[2], l0[3], h0[0], h0[1], h0[2], h0[3]}, o[d0], 0, 0, 0);   \
        o[d0] = __builtin_amdgcn_mfma_f32_32x32x16_bf16(pa1, (bf16x8){l1[0], l1[1], l1[2], l1[3], h1[0], h1[1], h1[2], h1[3]}, o[d0], 0, 0, 0);   \
        o[d0] = __builtin_amdgcn_mfma_f32_32x32x16_bf16(pa2, (bf16x8){l2[0], l2[1], l2[2], l2[3], h2[0], h2[1], h2[2], h2[3]}, o[d0], 0, 0, 0);   \
        o[d0] = __builtin_amdgcn_mfma_f32_32x32x16_bf16(pa3, (bf16x8){l3[0], l3[1], l3[2], l3[3], h3[0], h3[1], h3[2], h3[3]}, o[d0], 0, 0, 0); } while (0)
    PV_D0(0); PV_D0(1); PV_D0(2); PV_D0(3);
#undef PV_D0
#undef TRRD
}

template <class TIn, class TOut> struct BlockRef { const TIn* Q; const TIn* K; const TIn* V; TOut* O; int P0; };
template <class TIn> struct Seam {
    bf16x8 qr[8];
    bf16x8 st_v0, st_v1, st_k0, st_k1; f32x4 sf0, sf1, sf2, sf3;
    f32x4 tq[16];
};
__device__ __forceinline__ int swa_jlo(int P0, int W) { const int lowk = P0 - W + 1; return lowk > 0 ? lowk / KVBLK : 0; }
#define ROW(p, k0, rr) ((p) + (size_t)((k0) + (rr)) * KVPITCH + sc)
#define VMW() asm volatile("s_waitcnt vmcnt(0)" ::: "memory")
#define VMWN(n) asm volatile("s_waitcnt vmcnt(%0)" :: "i"(n) : "memory")
#define SLOAD_H(Kp, Vp, k0) do { S.st_v0 = load8<TIn>(ROW(Vp, k0, sr)); S.st_v1 = load8<TIn>(ROW(Vp, k0, 32 + sr));              \
                         S.st_k0 = load8<TIn>(ROW(Kp, k0, sr)); S.st_k1 = load8<TIn>(ROW(Kp, k0, 32 + sr)); } while (0)
#define SWRITE_HK(bf) do { *(bf16x8*)(K_lds + (bf) * SHM_K + kws) = S.st_k0; *(bf16x8*)(K_lds + (bf) * SHM_K + kws + 32 * 256) = S.st_k1; } while (0)
#define SWRITE_HV(bf) do { *(bf16x8*)(V_lds + (bf) * SHM_V + vst0) = S.st_v0; *(bf16x8*)(V_lds + (bf) * SHM_V + vst1) = S.st_v1; } while (0)
#define SWRITE_H(bf) do { SWRITE_HV(bf); SWRITE_HK(bf); } while (0)
#define SLOAD_F(p, k0) do { S.sf0 = *(const f32x4*)ROW(p, k0, sr); S.sf1 = *(const f32x4*)(ROW(p, k0, sr) + 4);                \
                            S.sf2 = *(const f32x4*)ROW(p, k0, 32 + sr); S.sf3 = *(const f32x4*)(ROW(p, k0, 32 + sr) + 4); } while (0)
#define SWRITE_KF(bf) do { *(bf16x8*)(K_lds + (bf) * SHM_K + kws) = pack8(S.sf0, S.sf1); *(bf16x8*)(K_lds + (bf) * SHM_K + kws + 32 * 256) = pack8(S.sf2, S.sf3); } while (0)
#define SWRITE_VF(bf) do { *(bf16x8*)(V_lds + (bf) * SHM_V + vst0) = pack8(S.sf0, S.sf1); *(bf16x8*)(V_lds + (bf) * SHM_V + vst1) = pack8(S.sf2, S.sf3); } while (0)
template <class TIn, class TOut>
__device__ __forceinline__ void causal_swa_prime(const BlockRef<TIn, TOut>& cur, int W, char* lds, Seam<TIn>& S, int tid_in) {
    constexpr bool F32 = same_t<TIn, float>::v;
    const int tid_ = fresh_tid(tid_in  ); const int tid = tid_, wid = __builtin_amdgcn_readfirstlane(tid >> 6), lane = tid & 63, r32 = lane & 31, hi = lane >> 5;
    const int sr = tid >> 4, sc = (tid & 15) * 8, kws = KSWZ(sr, sc * 2); char* K_lds = lds + 2 * SHM_V;
    const int kb0 = swa_jlo(cur.P0, W) * KVBLK;
    for (int d0 = 0; d0 < 8; ++d0) S.qr[d0] = load8<TIn>(cur.Q + (size_t)(wid * QBLK + r32) * QPITCH + d0 * 16 + hi * 8);
    if constexpr (F32) { SLOAD_F((const float*)cur.K, kb0); VMW(); SWRITE_KF(0); SBAR(); SLOAD_F((const float*)cur.V, kb0); }
    else { SLOAD_H(cur.K, cur.V, kb0); VMW(); SWRITE_HK(0); }
    __syncthreads();
}
template <class TIn, class TOut>
__device__ __forceinline__ void causal_swa_block(const BlockRef<TIn, TOut>& cur, const BlockRef<TIn, TOut>& nxt, int skv, int W, char* lds, Seam<TIn>& S, int tid_in) {
    constexpr bool F32 = same_t<TIn, float>::v;
    const int tid_ = fresh_tid(tid_in  ); const int tid = tid_, wid = __builtin_amdgcn_readfirstlane(tid >> 6), lane = tid & 63, r32 = lane & 31, hi = lane >> 5;
    const int j_lo = swa_jlo(cur.P0, W);
    int j_hi = (cur.P0 + QB - 1) / KVBLK + 1; if (j_hi > skv / KVBLK) j_hi = skv / KVBLK;
    const int NT = j_hi - j_lo;
    const int kbn = swa_jlo(nxt.P0, W) * KVBLK;
    const int qlo = cur.P0 + wid * QBLK, qm = qlo + r32 - 4 * hi;
    char* V_lds = lds; char* K_lds = lds + 2 * SHM_V; const char* fbl = lds + FB_OFF + r32 * 8;
    float* ws = (float*)(lds + 2 * SHM_V + 2 * SHM_K) + wid * 64; float* li_l = ws, * al_l = ws + 32;
    float m_reg = -1e30f, l_reg = 0; f32x16 o[4] = {};
    const int sr = tid >> 4, sc = (tid & 15) * 8, vst0 = v_st(sr, sc), vst1 = v_st(32 + sr, sc), kws = KSWZ(sr, sc * 2);
    const int vb0 = (int)(uintptr_t)V_lds + v_rd_base(lane);
    const TIn* Kh = cur.K; const TIn* Vh = cur.V;
#define RESC(a) do { if (__any((a) < 1.f)) { if (hi == 0) al_l[r32] = (a); asm volatile("s_waitcnt lgkmcnt(0)" ::: "memory");              \
                     for (int d_ = 0; d_ < 4; ++d_) for (int r = 0; r < 16; ++r) o[d_][r] *= al_l[crow(r, hi)]; } } while (0)
#define KBASE(t) ((j_lo + (t)) * KVBLK)
#define ACT(t) (KBASE(t) <= qlo + QBLK - 1 && KBASE(t) + KVBLK - 1 >= qlo - W + 1)
#define MASKT(P0_, P1_, t) do { const int kb_ = KBASE(t); if ((!SK || ACT(t)) && (kb_ + KVBLK - 1 > qlo || kb_ <= qlo + QBLK - 1 - W)) mask_tile(P0_, P1_, qm - kb_, (unsigned)W); } while (0)
    constexpr int NQL = F32 ? 16 : 8;
    constexpr bool SK = WSKIP && !F32;
#define SEAM_K0() do { VMWN(NQL); if constexpr (F32) { SWRITE_KF(0); SBAR(); SLOAD_F((const float*)nxt.V, kbn); } else { SWRITE_HK(0); } SBAR(); } while (0)
    f32x16 pA0, pA1, pB0, pB1; float mnA, mnB, alA, alB; bf16x8 pa0, pa1, pa2, pa3;
    if constexpr (F32) { VMW(); SWRITE_VF(0); SBAR(); } else { SWRITE_HV(0); SBAR(); }
    if (NT > 1) { if constexpr (F32) SLOAD_F((const float*)Kh, KBASE(1)); else SLOAD_H(Kh, Vh, KBASE(1)); }
    SBAR(); qkt<0, SK>(pA0, pA1, K_lds, r32, hi, S.qr, ACT(0), fbl + KBASE(0) * 8);
    if constexpr (F32) { if (NT > 1) { VMW(); SWRITE_KF(1); SBAR(); SLOAD_F((const float*)Vh, KBASE(1)); } }
    MASKT(pA0, pA1, 0); partialSM(pA0, pA1, m_reg, mnA, alA);
    if (NT > 1) { VMW(); if constexpr (F32) { SWRITE_VF(1); SBAR(); if (NT > 2) SLOAD_F((const float*)Kh, KBASE(2)); } else SWRITE_H(1); }
    __syncthreads();
#define HALF_STEP(PX0, PX1, mnX, alX, PY0, PY1, alY, t, KB, VB, SB) do {                                                      \
        SBAR(); qkt<KB, SK>(PX0, PX1, K_lds, r32, hi, S.qr, ACT(t), fbl + KBASE(t) * 8);                                             \
        finishSM(PY0, PY1, alY, l_reg, pa0, pa1, pa2, pa3); SBAR();                                                           \
        if ((t) + 1 < NT) { if constexpr (F32) { VMW(); SWRITE_KF(SB); SBAR(); SLOAD_F((const float*)Vh, KBASE((t) + 1)); }  \
                            else { SLOAD_H(Kh, Vh, KBASE((t) + 1)); } SBAR(); }                                               \
        pv_tile<VB, SK>(o, vb0, pa0, pa1, pa2, pa3, ACT((t) - 1)); MASKT(PX0, PX1, (t)); partialSM(PX0, PX1, m_reg, mnX, alX);                                        \
        __syncthreads();                                                                                                      \
        if ((t) + 1 < NT) { VMW(); if constexpr (F32) { SWRITE_VF(SB); SBAR(); if ((t) + 2 < NT) SLOAD_F((const float*)Kh, KBASE((t) + 2)); } \
                            else { SWRITE_H(SB); } }                                                                          \
        RESC(alX); __syncthreads(); } while (0)
    for (int t = 1; t + 1 < NT; t += 2) {
        HALF_STEP(pB0, pB1, mnB, alB, pA0, pA1, alA, t, 1, 0, 0);
        HALF_STEP(pA0, pA1, mnA, alA, pB0, pB1, alB, t + 1, 0, 1, 1);
    }
    const bool even = (NT & 1) == 0;
    if (even) { SBAR(); qkt<1, SK>(pB0, pB1, K_lds, r32, hi, S.qr, ACT(NT - 1), fbl + KBASE(NT - 1) * 8); SBAR(); }
#define QROW(e) (nxt.Q + (size_t)(wid * QBLK + r32) * QPITCH + ((e) >> 1) * 16 + hi * 8 + ((e) & 1) * 4)
    if constexpr (F32) { SLOAD_F((const float*)nxt.K, kbn); SBAR();
#pragma unroll
        for (int e = 0; e < 8; ++e) S.tq[e] = *(const f32x4*)QROW(e); }
    else { SLOAD_H(nxt.K, nxt.V, kbn); SBAR();
#pragma unroll
        for (int d0 = 0; d0 < 8; ++d0) S.qr[d0] = load8<TIn>(nxt.Q + (size_t)(wid * QBLK + r32) * QPITCH + d0 * 16 + hi * 8); }
    SBAR();
    finishSM(pA0, pA1, alA, l_reg, pa0, pa1, pa2, pa3); SBAR();
    if constexpr (F32) {
#pragma unroll
        for (int e = 8; e < 16; ++e) S.tq[e] = *(const f32x4*)QROW(e); SBAR(); }
#undef QROW
    pv_tile<0, SK>(o, vb0, pa0, pa1, pa2, pa3, ACT(even ? NT - 2 : NT - 1));
    if (even) { MASKT(pB0, pB1, NT - 1); partialSM(pB0, pB1, m_reg, mnB, alB); __syncthreads(); RESC(alB);
        finishSM(pB0, pB1, alB, l_reg, pa0, pa1, pa2, pa3); SBAR(); pv_tile<1, SK>(o, vb0, pa0, pa1, pa2, pa3, ACT(NT - 1)); }
    SBAR(); SEAM_K0();
    if (hi == 0) li_l[r32] = l_reg; asm volatile("s_waitcnt lgkmcnt(0)" ::: "memory");
    float rli[16];
#pragma unroll
    for (int r = 0; r < 16; ++r) rli[r] = __builtin_amdgcn_rcpf(li_l[crow(r, hi)]);
    TOut* Ow = cur.O + (size_t)(wid * QBLK) * OPITCH;
#pragma unroll
    for (int r = 0; r < 16; ++r) { const int orow = crow(r, hi);
#pragma unroll
        for (int d0 = 0; d0 < 4; ++d0) { const float v = o[d0][r] * rli[r];
            if constexpr (same_t<TOut, float>::v) { Ow[(size_t)orow * OPITCH + d0 * 32 + r32] = v; }
            else { const float vn = shfl_xor_l(v, 1, lane);
                   if ((r32 & 1) == 0) { if (F8_HY_OUT) *(unsigned short*)((unsigned char*)cur.O + (size_t)(wid * QBLK + orow) * OPITCH + d0 * 32 + r32) = (unsigned short)__builtin_amdgcn_cvt_pk_fp8_f32(__builtin_amdgcn_fmed3f(4.0f * v, -448.f, 448.f), __builtin_amdgcn_fmed3f(4.0f * vn, -448.f, 448.f), 0, false);
                                          else *(unsigned*)(Ow + (size_t)orow * OPITCH + d0 * 32 + r32) = cvtpk(v, vn); } } } }
    if constexpr (F32) {
#pragma unroll
        for (int d0 = 0; d0 < 8; ++d0) S.qr[d0] = pack8(S.tq[2 * d0], S.tq[2 * d0 + 1]); }
    __syncthreads();
#undef RESC
#undef KBASE
#undef ACT
#undef MASKT
#undef SEAM_K0
#undef HALF_STEP
}
#undef ROW
#undef VMW
#undef VMWN
#undef SLOAD_H
#undef SWRITE_HK
#undef SWRITE_HV
#undef SWRITE_H
#undef SLOAD_F
#undef SWRITE_KF
#undef SWRITE_VF

__device__ __forceinline__ void bias_table(char* lds, const float* fl  , float bf, int nkeys, int tid) {
    asm volatile("" : "+v"(tid));
    typedef unsigned u32x2 __attribute__((ext_vector_type(2)));
    float* wsum = (float*)(lds + FB_OFF + 4096 * 8); u32x2* FB = (u32x2*)(lds + FB_OFF);
    const int lane = tid & 63, wave = tid >> 6; float lf[8];
#pragma unroll
    for (int i = 0; i < 8; ++i) { const int s = 8 * tid + i; float v = 0.f;
        if (s < nkeys) { const float x = fl[(size_t)s * 8] + bf; const float e = __expf(-x); v = -(x < -20.f ? -x : (e < 0.06f ? e * (1.0f - e * (0.5f - e * (0.33333333f - e * 0.25f))) : __logf(1.0f + e))); }
        lf[i] = v; }
#pragma unroll
    for (int i = 1; i < 8; ++i) lf[i] += lf[i - 1];
    const float tot = lf[7]; float sc = tot;
#pragma unroll
    for (int o = 1; o < 64; o <<= 1) { const float u = shfl_up_l(sc, o, lane); if (lane >= o) sc += u; }
    if (lane == 63) wsum[wave] = sc;
    __syncthreads();
    float base = sc - tot;
    for (int w = 0; w < wave; ++w) base += wsum[w];
#pragma unroll
    for (int i = 0; i < 8; ++i) { const int s = 8 * tid + i; const float G = -(base + lf[i]) * (1.0f / SCALE);
        unsigned u = __float_as_uint(G); const unsigned h16 = (u + 0x7fffu + ((u >> 16) & 1u)) >> 16; const float r1 = G - __uint_as_float(h16 << 16);
        u = __float_as_uint(r1); const unsigned m16 = (u + 0x7fffu + ((u >> 16) & 1u)) >> 16; const float r2 = r1 - __uint_as_float(m16 << 16);
        u = __float_as_uint(r2); const unsigned l16 = (u + 0x7fffu + ((u >> 16) & 1u)) >> 16;
        FB[s] = (u32x2){h16 | (m16 << 16), l16}; }
    __syncthreads();
}
__device__ __forceinline__ void attn_item(char* lds, const unsigned short* PROJ, const float* FLB, unsigned short* YMIX, const float* b_f, int item, int tid) {
    const int bh = item >> 3, x = item & 7, b = bh >> 3, h = bh & 7;
    const unsigned short* base = PROJ + (size_t)b * 4096 * KVPITCH + h * 128;
    bias_table(lds, FLB + (size_t)b * 4096 * 8 + h, b_f[h], (16 - x) * QB, tid);
    typedef BlockRef<bf16, bf16> Ref;
    Ref r0, r1;
    r0.Q = base + 2048 + (size_t)(x * QB) * QPITCH; r0.K = base + 3072; r0.V = base + 4096; r0.O = F8_HY_OUT ? (unsigned short*)((unsigned char*)YMIX + ((size_t)b * 4096 + x * QB) * OPITCH + 1024 + h * 128) : YMIX + ((size_t)b * 4096 + x * QB) * OPITCH + 1024 + h * 128; r0.P0 = x * QB;
    r1 = r0; r1.Q = base + 2048 + (size_t)((15 - x) * QB) * QPITCH; r1.O = F8_HY_OUT ? (unsigned short*)((unsigned char*)YMIX + ((size_t)b * 4096 + (15 - x) * QB) * OPITCH + 1024 + h * 128) : YMIX + ((size_t)b * 4096 + (15 - x) * QB) * OPITCH + 1024 + h * 128; r1.P0 = (15 - x) * QB;
    Seam<bf16> S; const int wv = __builtin_amdgcn_readfirstlane(tid >> 6);
    causal_swa_prime<bf16, bf16>(r0, 4096, lds, S, wv);
    Ref cur = r0;
    for (int pass = 0; pass < 2; ++pass) {
        causal_swa_block<bf16, bf16>(cur, r1, 4096, 4096, lds, S, wv);
        cur = r1;
    }
    asm volatile("s_waitcnt vmcnt(0)" ::: "memory");
    __syncthreads();
}
}
struct Ctx {
    LAS unsigned char* lds;
    volatile LAS unsigned* MISC;
    gu32* ctl;
    int tid, lane, wave, vcu, G;
    const float* in[28];
    float* out; unsigned char* ws;
};
__device__ __forceinline__ float wave_max(float v) {
#pragma unroll
    for (int o = 1; o < 64; o <<= 1) v = fmaxf(v, __shfl_xor(v, o));
    return v;
}
__device__ __forceinline__ float wave_sum_dpp(float v) {
    v += __builtin_bit_cast(float, __builtin_amdgcn_update_dpp(0, __builtin_bit_cast(int, v), 0x111, 0xf, 0xf, true));
    v += __builtin_bit_cast(float, __builtin_amdgcn_update_dpp(0, __builtin_bit_cast(int, v), 0x112, 0xf, 0xf, true));
    v += __builtin_bit_cast(float, __builtin_amdgcn_update_dpp(0, __builtin_bit_cast(int, v), 0x114, 0xf, 0xf, true));
    v += __builtin_bit_cast(float, __builtin_amdgcn_update_dpp(0, __builtin_bit_cast(int, v), 0x118, 0xf, 0xf, true));
    v += __builtin_bit_cast(float, __builtin_amdgcn_update_dpp(0, __builtin_bit_cast(int, v), 0x142, 0xa, 0xf, false));
    v += __builtin_bit_cast(float, __builtin_amdgcn_update_dpp(0, __builtin_bit_cast(int, v), 0x143, 0xc, 0xf, false));
    return __builtin_bit_cast(float, __builtin_amdgcn_readlane(__builtin_bit_cast(int, v), 63));
}
__device__ __forceinline__ float wave_sum(float v, int lane) {
#pragma unroll
    for (int o = 1; o < 64; o <<= 1) v += shfl_xor_l(v, o, lane);
    return v;
}
__device__ __forceinline__ float wave_sum(float v) {
#pragma unroll
    for (int o = 1; o < 64; o <<= 1) v += __shfl_xor(v, o);
    return v;
}
struct CvtJob { const float* W; bf16_t* WT; int K, N, mode, row_off, nblk, item, f8; };
__device__ __forceinline__ void cvt_load(const CvtJob& j, int lane, f32x4 (&v)[8]) {
    const int kb = j.item / j.nblk, nb = j.item - kb * j.nblk, k0 = 64 * kb, n0 = 32 * nb;
    const int c4 = (lane & 7) * 4, nn = n0 + c4; const bool ok = nn < j.N;
#pragma unroll
    for (int i = 0; i < 8; ++i) { const int kk = 8 * i + (lane >> 3); v[i] = ok ? __builtin_nontemporal_load((const GAS f32x4*)(j.W + (size_t)(k0 + kk) * j.N + nn)) : (f32x4){0.f, 0.f, 0.f, 0.f}; }
}
__device__ __forceinline__ void cvt_finish(const CvtJob& j, const f32x4 (&v)[8], LAS float* scr, int lane) {
    const int kb = j.item / j.nblk, nb = j.item - kb * j.nblk, k0 = 64 * kb, n0 = 32 * nb; const int c4 = (lane & 7) * 4;
#pragma unroll
    for (int i = 0; i < 8; ++i) { const int kk = 8 * i + (lane >> 3); LAS float* d = scr + kk * 33 + c4; d[0] = v[i].x; d[1] = v[i].y; d[2] = v[i].z; d[3] = v[i].w; }
    LDS_WAIT(); asm volatile("" ::: "memory");
    if (j.f8) {
        const int n = lane >> 1, hf = lane & 1; const LAS float* sp = scr + (32 * hf) * 33 + n; v4u o[2];
#pragma unroll
        for (int q = 0; q < 8; ++q) { int w = __builtin_amdgcn_cvt_pk_fp8_f32(__builtin_amdgcn_fmed3f(sp[(4 * q) * 33] * 128.0f, -448.f, 448.f), __builtin_amdgcn_fmed3f(sp[(4 * q + 1) * 33] * 128.0f, -448.f, 448.f), 0, false);
            w = __builtin_amdgcn_cvt_pk_fp8_f32(__builtin_amdgcn_fmed3f(sp[(4 * q + 2) * 33] * 128.0f, -448.f, 448.f), __builtin_amdgcn_fmed3f(sp[(4 * q + 3) * 33] * 128.0f, -448.f, 448.f), w, true);
            o[q >> 2][q & 3] = (unsigned)w; }
        const int ns = n0 + n; const int drow = j.mode == 0 ? j.row_off + ns : ((ns >> 7) * 256 + (ns & 127) + (j.mode == 2 ? 128 : 0));
        GAS v4u* dst = (GAS v4u*)((unsigned char*)j.WT + (size_t)drow * j.K + k0 + 32 * hf); dst[0] = o[0]; dst[1] = o[1];
        LDS_WAIT(); asm volatile("" ::: "memory"); return; }
    const int c = lane & 7;
#pragma unroll
    for (int q = 0; q < 4; ++q) { const int n = (lane >> 3) + 8 * q; const LAS float* sp = scr + (8 * c) * 33 + n;
        v4u o; o.x = pk2(sp[0 * 33], sp[1 * 33]); o.y = pk2(sp[2 * 33], sp[3 * 33]); o.z = pk2(sp[4 * 33], sp[5 * 33]); o.w = pk2(sp[6 * 33], sp[7 * 33]);
        const int ns = n0 + n; const int drow = j.mode == 0 ? j.row_off + ns : ((ns >> 7) * 256 + (ns & 127) + (j.mode == 2 ? 128 : 0));
        *(GAS v4u*)(j.WT + (size_t)drow * j.K + k0 + 8 * c) = o; }
    LDS_WAIT(); asm volatile("" ::: "memory");
}
__device__ __forceinline__ void cvt_item(const float* W, int K, int N, bf16_t* WT, int mode, int row_off, LAS float* scr, int item, int nblk, int lane, int f8 = 0) {
    const CvtJob j{W, WT, K, N, mode, row_off, nblk, item, f8}; f32x4 v[8]; cvt_load(j, lane, v); cvt_finish(j, v, scr, lane);
}
constexpr int MOE_CVT_ITEMS = 48 * 1024;
__device__ __forceinline__ CvtJob moe_cvt_job(Ctx& F, int layer, int it) {
    unsigned char* WGU = F.ws + ((layer & 1) ? WS_WGU_B : WS_WGU); unsigned char* WD = F.ws + ((layer & 1) ? WS_WD_B : WS_WD);
    const float* wg = F.in[25] + (size_t)layer * 16 * 2048 * 1024; const float* wu = F.in[26] + (size_t)layer * 16 * 2048 * 1024; const float* wd = F.in[27] + (size_t)layer * 16 * 1024 * 2048;
    const int mat = it >> 10, r0 = it & 1023, E = mat / 3, which = mat - 3 * E;
    const int nblk_ = which == 2 ? 64 : 32, p_ = r0 >> 1, r = (2 * (p_ / nblk_) + (r0 & 1)) * nblk_ + (p_ % nblk_);
    if (which == 0) return CvtJob{wg + (size_t)E * 2048 * 1024, (bf16_t*)(WGU + (size_t)E * 2048 * 2048), 2048, 1024, 1, 0, 32, r, 1};
    if (which == 1) return CvtJob{wu + (size_t)E * 2048 * 1024, (bf16_t*)(WGU + (size_t)E * 2048 * 2048), 2048, 1024, 2, 0, 32, r, 1};
    return CvtJob{wd + (size_t)E * 1024 * 2048, (bf16_t*)(WD + (size_t)E * 2048 * 1024), 1024, 2048, 0, 0, 64, r, 1};
}
__device__ __forceinline__ void moe_cvt_pair(Ctx& F, int layer, int itA, int itB, LAS float* scr) {
    const bool hasB = itB < MOE_CVT_ITEMS; const CvtJob ja = moe_cvt_job(F, layer, itA), jb = moe_cvt_job(F, layer, hasB ? itB : itA);
    f32x4 va[8], vb[8]; cvt_load(ja, F.lane, va); cvt_load(jb, F.lane, vb);
    cvt_finish(ja, va, scr, F.lane); if (hasB) cvt_finish(jb, vb, scr, F.lane);
}
__device__ __forceinline__ void moe_cvt_item(Ctx& F, int layer, int it, LAS float* scr) { const CvtJob j = moe_cvt_job(F, layer, it); f32x4 v[8]; cvt_load(j, F.lane, v); cvt_finish(j, v, scr, F.lane); }
__device__ __forceinline__ int moe_ntiles(Ctx& F, int layer) { int acc = 0;
#pragma unroll
    for (int e = 0; e < 16; ++e) { const unsigned c = __hip_atomic_load((unsigned*)(F.ctl + CW_CNT + layer * 16 + e), RLX_AGENT); acc += (int)((c + 255u) >> 8); }
    return __builtin_amdgcn_readfirstlane(acc); }
__device__ __forceinline__ int moe_cvt_done(Ctx& F, int layer) {
    if (layer == 0) return 0;
    const int h = (int)__hip_atomic_load((unsigned*)(F.ctl + CW_CVTHEAD + layer * 64), RLX_AGENT); return __builtin_amdgcn_readfirstlane(h < MOE_CVT_ITEMS ? h : MOE_CVT_ITEMS);
}
__device__ __forceinline__ int moe_gemm_wgs(Ctx& F, int ntiles, bool has_next) {
    const int U = 8 * ntiles; if (!has_next || U == 0) return F.G;
    const int rounds = (U + F.G - 1) / F.G; return (U + rounds - 1) / rounds; }
__device__ __forceinline__ void moe_tail_convert(Ctx& F, int next_layer, int Gg, int which) {
    const int rem = Gg; if (rem >= F.G) return;
    F.tid = fresh_tid(F.wave); F.lane = F.tid & 63;
    unsigned* done = (unsigned*)(F.ctl + CW_DONE + ((next_layer - 1) * 2 + which) * 64); unsigned* head = (unsigned*)(F.ctl + CW_CVTHEAD + next_layer * 64);
    if ((int)blockIdx.x < rem) { if (F.tid == 0) (void)__hip_atomic_fetch_add(done, 1u, RLX_AGENT); return; }
    LAS float* scr = (LAS float*)(F.lds + RING_OFF + F.wave * 16384); volatile LAS int* slot = (volatile LAS int*)(F.lds + RING_OFF + 8 * 16384);
    for (;;) {
        if (F.tid == 0) { int c = -1; if ((int)__hip_atomic_load(done, RLX_AGENT) < rem) c = (int)__hip_atomic_fetch_add(head, 16u, RLX_AGENT); *slot = c; }
        __syncthreads();
        const int c = *slot;
        if (c < 0 || c >= MOE_CVT_ITEMS) break;
        moe_cvt_pair(F, next_layer, c + 2 * F.wave, c + 2 * F.wave + 1, scr);
        __syncthreads();
    }
}
__device__ __forceinline__ void s0_convert(Ctx& F, int layer) {
    LAS float* scr = (LAS float*)(F.lds + RING_OFF + F.wave * 16384);
    const int gw = F.vcu * NWAVES + F.wave, NGW = F.G * NWAVES;
    for (int it = moe_cvt_done(F, layer) + 2 * gw; it < MOE_CVT_ITEMS; it += 2 * NGW) moe_cvt_pair(F, layer, it, it + 1, scr);
    if (layer == 0) {
        constexpr int I_HI = 32 * (HY_NP / 32), I_HO = 32 * 64, I_SI = 32 * (SS_NP / 32), I_SO = 64 * 64, I_RI = 2 * 4;
        constexpr int NIT = 2 * I_HI + 2 * I_HO + 2 * I_SI + 2 * I_SO + 32 * I_RI;
        for (int it = gw; it < NIT; it += NGW) {
            int r = it;
            if (r < 2 * I_HI) { const int j = r / I_HI; r -= j * I_HI; const bool f8 = F8_HY_IN && (r % (HY_NP / 32)) * 32 < 5120;
                cvt_item(F.in[3] + (size_t)j * 2048 * HY_N, 2048, HY_N, f8 ? (bf16_t*)(F.ws + WS_WHYIN8 + (size_t)j * 5120 * 2048) : (bf16_t*)(F.ws + WS_WHYIN) + (size_t)j * HY_NP * 2048, 0, 0, scr, r, HY_NP / 32, F.lane, f8); continue; } r -= 2 * I_HI;
            if (r < 2 * I_HO) { const int j = r / I_HO; r -= j * I_HO; cvt_item(F.in[12] + (size_t)j * 2048 * 2048, 2048, 2048, F8_HY_OUT ? (bf16_t*)(F.ws + WS_WHYOUT + (size_t)j * 2048 * 2048) : (bf16_t*)(F.ws + WS_WHYOUT) + (size_t)j * 2048 * 2048, 0, 0, scr, r, 64, F.lane, F8_HY_OUT); continue; } r -= 2 * I_HO;
            if (r < 2 * I_SI) { const int j = r / I_SI; r -= j * I_SI; const bool f8 = F8_SS_IN && (r % (SS_NP / 32)) * 32 < 10240;
                cvt_item(F.in[13] + (size_t)j * 2048 * SS_N, 2048, SS_N, f8 ? (bf16_t*)(F.ws + WS_WSSIN8 + (size_t)j * 10240 * 2048) : (bf16_t*)(F.ws + WS_WSSIN) + (size_t)j * SS_NP * 2048, 0, 0, scr, r, SS_NP / 32, F.lane, f8); continue; } r -= 2 * I_SI;
            if (r < 2 * I_SO) { const int j = r / I_SO; r -= j * I_SO; cvt_item(F.in[20] + (size_t)j * 4096 * 2048, 4096, 2048, F8_SS_OUT ? (bf16_t*)(F.ws + WS_WSSOUT + (size_t)j * 2048 * 4096) : (bf16_t*)(F.ws + WS_WSSOUT) + (size_t)j * 2048 * 4096, 0, 0, scr, r, 64, F.lane, F8_SS_OUT); continue; } r -= 2 * I_SO;
            { const int m = r / I_RI; r -= m * I_RI; const int jh = m >> 1, which = m & 1;
              cvt_item((which ? F.in[8] : F.in[6]) + (size_t)jh * 128 * 128, 128, 128, (bf16_t*)(F.ws + WS_WRI) + (size_t)jh * 256 * 128, 0, which * 128, scr, r, 4, F.lane); }
        }
        { bf16_t* WH = (bf16_t*)(F.ws + WS_WRT); bf16_t* WL = WH + 4 * 32 * 2048;
          for (int i = blockIdx.x * NTHR + F.tid; i < 4 * 32 * 2048; i += F.G * NTHR) { const int k = i & 2047, n = (i >> 11) & 31, L = i >> 16;
              const float v = n < 4 ? F.in[21][((size_t)L * 2048 + k) * 4 + n] : n < 20 ? F.in[23][(((size_t)L * 4 + ((n - 4) >> 2)) * 2048 + k) * 4 + ((n - 4) & 3)] : 0.f;
              const unsigned h = f2bf(v); WH[i] = (bf16_t)h; WL[i] = (bf16_t)f2bf(v - __uint_as_float(h << 16)); } }
        { float* LK = (float*)(F.ws + WS_TOKPOS); for (int i = blockIdx.x * NTHR + F.tid; i < 2 * 1024; i += F.G * NTHR) LK[i] = -8.0f * softplus_(-F.in[10][i]); }
        const float* x = F.in[0]; bf16_t* XB = (bf16_t*)(F.ws + WS_XB);
        for (int m = gw; m < T; m += NGW) { const GAS f32x4* xr = (const GAS f32x4*)(x + (size_t)m * D) + F.lane; GAS v2u* o = (GAS v2u*)(XB + (size_t)m * D) + F.lane;
#pragma unroll
            for (int j = 0; j < 8; ++j) { const f32x4 v = xr[64 * j]; v2u w; w.x = pk2(v.x, v.y); w.y = pk2(v.z, v.w); o[64 * j] = w;
                ((GAS int*)(F.ws + WS_XIN8 + (size_t)m * D))[F.lane + 64 * j] = pk_fp8x4(v, 4.0f); } }
    }
}
template <bool DRY = false> __device__ __forceinline__ void ln1_router(Ctx& F, int layer) {
    const int tid = fresh_tid(F.wave);
    const int lane = tid & 63, wave = __builtin_amdgcn_readfirstlane(tid >> 6), fr = lane & 15, fq = lane >> 4;
    const float* xin = F.in[0]; bf16_t* XB = (bf16_t*)(F.ws + WS_XB); bf16_t* XBO = DRY ? (bf16_t*)(F.ws + WS_ARENA + 944 * MiB) : XB;
    const float* gam = F.in[1] + (size_t)(layer * 2) * D; const float* bet = F.in[2] + (size_t)(layer * 2) * D;
    const bf16_t* MB = (const bf16_t*)(F.ws + WS_MBUF);
    LAS unsigned char* XH = F.lds + RING_OFF; LAS unsigned char* XL = F.lds + RING_OFF + 65536;
    LAS float* PART = (LAS float*)(F.lds + RING_OFF);
    LAS float* LG = (LAS float*)(F.lds + RING_OFF + 131072);
    LAS int* hist = (LAS int*)(F.lds + MISC_OFF + 256); LAS int* hbase = hist + 16; LAS int* sE = hist + 32; LAS int* sI = sE + 128; LAS float* sW = (LAS float*)(sI + 128);
    if (tid < 16) hist[tid] = 0;
    LAS f32x4* GL = (LAS f32x4*)(F.lds + RING_OFF + 135168); LAS f32x4* BL = GL + 512;
    GL[tid] = ((const GAS f32x4*)gam)[tid]; BL[tid] = ((const GAS f32x4*)bet)[tid];
    __syncthreads();
    const bf16_t* WH = (const bf16_t*)(F.ws + WS_WRT) + (size_t)layer * 32 * 2048; const bf16_t* WL = WH + 4 * 32 * 2048;
    const int rbase = blockIdx.x * 64;
    const int nb_ = tid & 31; const float lbias = nb_ < 4 ? F.in[22][layer * 4 + nb_] : nb_ < 20 ? F.in[24][layer * 16 + nb_ - 4] : 0.f;
    v2u xh[2][8], mh[2][8];
#define LN1_LOAD(bt_) do { _Pragma("unroll") for (int rr_ = 0; rr_ < 2; ++rr_) { const int row_ = rbase + (bt_) * 16 + 2 * wave + rr_; \
        const GAS v2u* xb_ = (const GAS v2u*)(XB + (size_t)row_ * D) + lane; const GAS v2u* mr_ = (const GAS v2u*)(MB + (size_t)row_ * D) + lane; \
        _Pragma("unroll") for (int j_ = 0; j_ < 8; ++j_) { xh[rr_][j_] = xb_[64 * j_]; mh[rr_][j_] = __builtin_nontemporal_load(mr_ + 64 * j_); } } } while (0)
#define LN1_BAR() do { asm volatile("s_waitcnt lgkmcnt(0)" ::: "memory"); __builtin_amdgcn_s_barrier(); asm volatile("" ::: "memory"); } while (0)
    LN1_LOAD(0);
#pragma unroll 1
    for (int bt = 0; bt < 4; ++bt) {
        f32x4 v[2][8];
#pragma unroll
        for (int rr = 0; rr < 2; ++rr) { const int row = rbase + bt * 16 + 2 * wave + rr;
            {
#pragma unroll
                for (int j = 0; j < 8; ++j) { const v2u xw = xh[rr][j]; const v2u mw = mh[rr][j];
                    v[rr][j].x = ALPHA * bflo(xw.x) + bflo(mw.x); v[rr][j].y = ALPHA * bfhi(xw.x) + bfhi(mw.x); v[rr][j].z = ALPHA * bflo(xw.y) + bflo(mw.y); v[rr][j].w = ALPHA * bfhi(xw.y) + bfhi(mw.y); }
            } (void)row; }
#pragma unroll
        for (int rr = 0; rr < 2; ++rr) { const int lr = 2 * wave + rr, row = rbase + bt * 16 + lr; float s = 0.f;
#pragma unroll
            for (int j = 0; j < 8; ++j) s += (v[rr][j].x + v[rr][j].y) + (v[rr][j].z + v[rr][j].w);
            const float mean = wave_sum_dpp(s) * (1.f / D); float s2 = 0.f;
#pragma unroll
            for (int j = 0; j < 8; ++j) { v[rr][j] = v[rr][j] - mean; s2 += (v[rr][j].x * v[rr][j].x + v[rr][j].y * v[rr][j].y) + (v[rr][j].z * v[rr][j].z + v[rr][j].w * v[rr][j].w); }
            const float rstd = 1.f / sqrtf(wave_sum_dpp(s2) * (1.f / D) + LN_EPS);
            GAS v2u* bo = (GAS v2u*)(XBO + (size_t)row * D) + lane;
#pragma unroll
            for (int j = 0; j < 8; ++j) { const f32x4 gj = GL[lane + 64 * j], bj = BL[lane + 64 * j]; const f32x4 y = v[rr][j] * rstd * gj + bj;
                const unsigned h0 = f2bf(y.x), h1 = f2bf(y.y), h2 = f2bf(y.z), h3 = f2bf(y.w); v2u hw; hw.x = h0 | (h1 << 16); hw.y = h2 | (h3 << 16); bo[64 * j] = hw;
                ((GAS int*)(F.ws + WS_XB8 + (size_t)row * D))[lane + 64 * j] = pk_fp8x4(y, 4.0f);
                v2u lw; lw.x = pk2(y.x - __uint_as_float(h0 << 16), y.y - __uint_as_float(h1 << 16)); lw.y = pk2(y.z - __uint_as_float(h2 << 16), y.w - __uint_as_float(h3 << 16));
                const int cidx = (lane >> 1) + 32 * j; const int off = lr * 4096 + ((cidx ^ lr) << 4) + (lane & 1) * 8;
                *(LAS v2u*)(XH + off) = hw; *(LAS v2u*)(XL + off) = lw; } }
        LN1_BAR();
        f32x4 acc[2] = {(f32x4){0.f, 0.f, 0.f, 0.f}, (f32x4){0.f, 0.f, 0.f, 0.f}};
        int wofs = fr * 2048 + 256 * wave + 8 * fq; asm volatile("" : "+v"(wofs));
#pragma unroll
        for (int ks = 0; ks < 8; ++ks) { const int k0 = 256 * wave + 32 * ks + 8 * fq; const int off = fr * 4096 + ((((k0 >> 3)) ^ fr) << 4);
            const bf16x8 xh = *(const LAS bf16x8*)(XH + off), xl = *(const LAS bf16x8*)(XL + off);
#pragma unroll
            for (int nt = 0; nt < 2; ++nt) { const bf16x8 wh = *(const GAS bf16x8*)(WH + wofs + nt * 16 * 2048 + 32 * ks), wl = *(const GAS bf16x8*)(WL + wofs + nt * 16 * 2048 + 32 * ks);
                acc[nt] = __builtin_amdgcn_mfma_f32_16x16x32_bf16(wh, xh, acc[nt], 0, 0, 0);
                acc[nt] = __builtin_amdgcn_mfma_f32_16x16x32_bf16(wl, xh, acc[nt], 0, 0, 0);
                acc[nt] = __builtin_amdgcn_mfma_f32_16x16x32_bf16(wh, xl, acc[nt], 0, 0, 0); } }
        if (bt < 3) LN1_LOAD(bt + 1);
        LN1_BAR();
        *(LAS f32x4*)(PART + (wave * 16 + fr) * 32 + 4 * fq) = acc[0]; *(LAS f32x4*)(PART + (wave * 16 + fr) * 32 + 16 + 4 * fq) = acc[1];
        LN1_BAR();
        {
            const int r = tid >> 5, n = tid & 31; float a = 0.f;
#pragma unroll
            for (int w = 0; w < 8; ++w) a += PART[(w * 16 + r) * 32 + n];
            a += lbias;
            LG[r * 32 + n] = a; }
        LN1_BAR();
        if (tid < 16) {
            float lg[20];
#pragma unroll
            for (int n = 0; n < 20; ++n) lg[n] = LG[tid * 32 + n];
            int gi = 0; float lm = lg[0];
#pragma unroll
            for (int k = 1; k < 4; ++k) if (lg[k] > lm) { lm = lg[k]; gi = k; }
            float den = 0.f;
#pragma unroll
            for (int k = 0; k < 4; ++k) den += __expf(lg[k] - lm);
            const float pg = 1.0f / den; float l2[4];
#pragma unroll
            for (int e = 0; e < 4; ++e) l2[e] = gi == 0 ? lg[4 + e] : gi == 1 ? lg[8 + e] : gi == 2 ? lg[12 + e] : lg[16 + e];
            int e1 = 0; float v1 = l2[0];
#pragma unroll
            for (int e = 1; e < 4; ++e) if (l2[e] > v1) { v1 = l2[e]; e1 = e; }
            int e2 = -1; float v2 = 0.f;
#pragma unroll
            for (int e = 0; e < 4; ++e) if (e != e1 && (e2 < 0 || l2[e] > v2)) { v2 = l2[e]; e2 = e; }
            const float t = __expf(v2 - v1); const float p1 = 1.0f / (1.0f + t), p2 = t / (1.0f + t);
            const int E1 = gi * 4 + e1, E2 = gi * 4 + e2, it = bt * 16 + tid;
            const int i1 = __hip_atomic_fetch_add(&hist[E1], 1, __ATOMIC_RELAXED, __HIP_MEMORY_SCOPE_WORKGROUP); const int i2 = __hip_atomic_fetch_add(&hist[E2], 1, __ATOMIC_RELAXED, __HIP_MEMORY_SCOPE_WORKGROUP);
            sE[2 * it] = E1; sI[2 * it] = i1; sW[2 * it] = pg * p1; sE[2 * it + 1] = E2; sI[2 * it + 1] = i2; sW[2 * it + 1] = pg * p2;
        }
        LN1_BAR();
    }
    if (DRY) { __syncthreads(); return; }
    if (tid < 16) hbase[tid] = (int)__hip_atomic_fetch_add((unsigned*)(F.ctl + CW_CNT + layer * 16 + tid), (unsigned)hist[tid], RLX_AGENT);
    __syncthreads();
    int* TS = (int*)(F.ws + WS_TOKSLOT);
    if (tid < 128) { const int sl = tid; const int row = rbase + (sl >> 1); const int E = sE[sl];
        const int idx = hbase[E] + sI[sl];
        GAS v4u* dst = (GAS v4u*)(TS + (size_t)(row * 2 + (sl & 1)) * 4); v4u w; w.x = (unsigned)E; w.y = (unsigned)idx; w.z = __float_as_uint(sW[sl]); w.w = 0u; *dst = w;
        ((int*)(F.ws + WS_EXPTOK))[(size_t)E * T + idx] = row; ((float*)(F.ws + WS_EXPW))[(size_t)E * T + idx] = sW[sl]; }
    __syncthreads();
}
template <bool DRY = false> __device__ __forceinline__ void ln2_phase(Ctx& F, int layer) {
    const int tid = fresh_tid(F.wave); const int lane = tid & 63, wave = F.wave;
    const bool last = layer == DEPTH - 1; float* xout = DRY ? (float*)(F.ws + WS_ARENA + 1010 * MiB) : F.out; bf16_t* XB = (bf16_t*)(F.ws + WS_XB); bf16_t* XBO = DRY ? (bf16_t*)(F.ws + WS_ARENA + 944 * MiB) : XB;
    const float* gam = F.in[1] + (size_t)(layer * 2 + 1) * D; const float* bet = F.in[2] + (size_t)(layer * 2 + 1) * D;
    const bf16_t* YG = (const bf16_t*)(F.ws + WS_YG); const int* TOKPOS = (const int*)(F.ws + WS_TOKPOS);
    const int rbase = blockIdx.x * 64;
    LAS int* tabL = (LAS int*)(F.lds + RING_OFF); LAS f32x4* GL = (LAS f32x4*)(F.lds + RING_OFF + 256); LAS f32x4* BL = GL + 512;
    GL[tid] = ((const GAS f32x4*)gam)[tid]; BL[tid] = ((const GAS f32x4*)bet)[tid];
    if (tid == 0) { int acc = 0; for (int e = 0; e < 16; ++e) { const unsigned c = __hip_atomic_load((unsigned*)(F.ctl + CW_CNT + layer * 16 + e), RLX_AGENT); tabL[e] = acc; acc += (int)((c + 255u) >> 8); } }
    __syncthreads();
    int pos = 0; if (lane < 16) { const int* ts = (const int*)(F.ws + WS_TOKSLOT) + (size_t)((rbase + (lane >> 1) * 8 + wave) * 2 + (lane & 1)) * 4; pos = tabL[ts[0]] * 256 + ts[1]; }
#define LN2_LOAD(it_, XR, YA, YB) do { const int row_ = rbase + (it_) * 8 + wave; \
        const int p0_ = __builtin_amdgcn_readfirstlane(__builtin_amdgcn_ds_bpermute((2 * (it_)) << 2, pos)), p1_ = __builtin_amdgcn_readfirstlane(__builtin_amdgcn_ds_bpermute((2 * (it_) + 1) << 2, pos)); \
        const GAS v2u* xr_ = (const GAS v2u*)(XB + (size_t)row_ * D) + lane; const GAS v2u* y0_ = (const GAS v2u*)(YG + (size_t)p0_ * D) + lane; const GAS v2u* y1_ = (const GAS v2u*)(YG + (size_t)p1_ * D) + lane; \
        _Pragma("unroll") for (int j_ = 0; j_ < 8; ++j_) { XR[j_] = xr_[64 * j_]; YA[j_] = __builtin_nontemporal_load(y0_ + 64 * j_); YB[j_] = __builtin_nontemporal_load(y1_ + 64 * j_); } } while (0)
    auto ln2_row = [&](int it, const v2u (&XA)[8], const v2u (&YA)[8], const v2u (&YB)[8]) __attribute__((always_inline)) {
        const int row = rbase + it * 8 + wave; f32x4 v[8]; float s = 0.f;
#pragma unroll
        for (int j = 0; j < 8; ++j) { const v2u xw = XA[j]; const v2u a = YA[j], b = YB[j];
            v[j].x = ALPHA * bflo(xw.x) + (bflo(a.x) + bflo(b.x)); v[j].y = ALPHA * bfhi(xw.x) + (bfhi(a.x) + bfhi(b.x)); v[j].z = ALPHA * bflo(xw.y) + (bflo(a.y) + bflo(b.y)); v[j].w = ALPHA * bfhi(xw.y) + (bfhi(a.y) + bfhi(b.y));
            s += (v[j].x + v[j].y) + (v[j].z + v[j].w); }
        const float mean = wave_sum_dpp(s) * (1.f / D); float s2 = 0.f;
#pragma unroll
        for (int j = 0; j < 8; ++j) { v[j] = v[j] - mean; s2 += (v[j].x * v[j].x + v[j].y * v[j].y) + (v[j].z * v[j].z + v[j].w * v[j].w); }
        const float rstd = 1.f / sqrtf(wave_sum_dpp(s2) * (1.f / D) + LN_EPS);
        GAS f32x4* xo = (GAS f32x4*)(xout + (size_t)row * D) + lane; GAS v2u* bo = (GAS v2u*)(XBO + (size_t)row * D) + lane;
#pragma unroll
        for (int j = 0; j < 8; ++j) { const f32x4 gj = GL[lane + 64 * j], bj = BL[lane + 64 * j]; const f32x4 y = v[j] * rstd * gj + bj;
            if (last) xo[64 * j] = y; else { v2u w; w.x = pk2(y.x, y.y); w.y = pk2(y.z, y.w); bo[64 * j] = w; if (F8_HY_IN && (layer & 1)) ((GAS int*)(F.ws + WS_XIN8 + (size_t)row * D))[lane + 64 * j] = pk_fp8x4(y, 4.0f); } }
    };
    v2u xa[8], ya[8], yb[8], xb2[8], yc[8], yd[8];
    LN2_LOAD(0, xa, ya, yb);
#pragma unroll 1
    for (int it = 0; it < 8; it += 2) {
        LN2_LOAD(it + 1, xb2, yc, yd);
        ln2_row(it, xa, ya, yb);
        { const int i2 = it + 2 < 8 ? it + 2 : 7; LN2_LOAD(i2, xa, ya, yb); }
        ln2_row(it + 1, xb2, yc, yd);
    }
#undef LN2_LOAD
}
__device__ __forceinline__ void moe_tables(Ctx& F, int layer, int (&tab)[17]) {
    int acc = 0;
#pragma unroll
    for (int e = 0; e < 16; ++e) { const unsigned c = __hip_atomic_load((unsigned*)(F.ctl + CW_CNT + layer * 16 + e), RLX_AGENT); tab[e] = __builtin_amdgcn_readfirstlane(acc); acc += (int)((c + 255u) >> 8); }
    tab[16] = __builtin_amdgcn_readfirstlane(acc);
}
typedef float f32x4_t __attribute__((ext_vector_type(4)));
__device__ __forceinline__ float gelu_tanh_fast(float x) { const float u = 1.5957691216057308f * (x + 0.044715f * x * x * x); return x * __builtin_amdgcn_rcpf(1.0f + __expf(-u)); }
__device__ __forceinline__ void lru_local_item(Ctx& F, int jl, int item, int& hd_lds) {
    const int tid = fresh_tid(F.wave);
    const int lane = tid & 63, wave = __builtin_amdgcn_readfirstlane(tid >> 6);
    const int hd = item & 7, c = (item >> 3) & 63, b = item >> 9; const int r0 = b * SEQ + c * 64;
    const bf16_t* PROJ = (const bf16_t*)(F.ws + WS_PROJ);
    LAS float* XCF = (LAS float*)(F.lds + RING_OFF); LAS float* AF = (LAS float*)(F.lds + RING_OFF + 32768);
    LAS unsigned char* XCB = F.lds + RING_OFF + 65536;
    LAS float* QS = (LAS float*)(F.lds + RING_OFF + 65536 + 17408);
    LAS unsigned char* WL = F.lds + RING_OFF + 87040;
    LAS float* PT = (LAS float*)(F.lds + RING_OFF + 87040 + 65536);
    if (hd != hd_lds) { const bf16_t* W = (const bf16_t*)(F.ws + WS_WRI) + (size_t)(jl * 8 + hd) * 256 * 128; const int row = tid >> 1, hf = tid & 1;
        const GAS v4u* src = (const GAS v4u*)(W + (size_t)row * 128 + hf * 64);
#pragma unroll
        for (int i = 0; i < 8; ++i) *(LAS v4u*)(WL + row * 256 + (((hf * 8 + i) ^ (row & 15)) << 4)) = src[i];
        for (int i = tid; i < 8 * 128; i += NTHR) { const int k = i >> 7, jj = i & 127, ch = hd * 128 + jj;
            PT[i] = k < 4 ? F.in[4][(size_t)jl * 4 * 1024 + k * 1024 + ch] : k == 4 ? F.in[5][(size_t)jl * 1024 + ch] : k == 5 ? F.in[7][(size_t)jl * 1024 + ch] : k == 6 ? F.in[9][(size_t)jl * 1024 + ch] : ((const float*)(F.ws + WS_TOKPOS))[(size_t)jl * 1024 + ch]; }
        hd_lds = hd; __syncthreads(); }
    { const int tok = tid >> 3, cg = (tid & 7) * 16, ch0 = hd * 128 + cg; const int s = c * 64 + tok;
      float acc[16];
#pragma unroll
      for (int i = 0; i < 4; ++i) { const f32x4_t v = *(const LAS f32x4_t*)(PT + 4 * 128 + cg + 4 * i); acc[4 * i] = v.x; acc[4 * i + 1] = v.y; acc[4 * i + 2] = v.z; acc[4 * i + 3] = v.w; }
#pragma unroll
      for (int k = 0; k < 4; ++k) { const int sp = s - 3 + k;
          if (sp >= 0) { const GAS v4u* xr = (const GAS v4u*)(PROJ + (size_t)(r0 + tok - 3 + k) * HY_NP + ch0); const v4u x0 = xr[0], x1 = xr[1];
              const unsigned xw[8] = {x0.x, x0.y, x0.z, x0.w, x1.x, x1.y, x1.z, x1.w};
#pragma unroll
              for (int i = 0; i < 4; ++i) { const f32x4_t w = *(const LAS f32x4_t*)(PT + k * 128 + cg + 4 * i);
                  acc[4 * i] += bflo(xw[2 * i]) * w.x; acc[4 * i + 1] += bfhi(xw[2 * i]) * w.y; acc[4 * i + 2] += bflo(xw[2 * i + 1]) * w.z; acc[4 * i + 3] += bfhi(xw[2 * i + 1]) * w.w; } } }
#pragma unroll
      for (int i = 0; i < 4; ++i) *(LAS f32x4_t*)(XCF + tok * 128 + cg + 4 * i) = (f32x4_t){acc[4 * i], acc[4 * i + 1], acc[4 * i + 2], acc[4 * i + 3]};
      v4u o0, o1; o0.x = pk2(acc[0], acc[1]); o0.y = pk2(acc[2], acc[3]); o0.z = pk2(acc[4], acc[5]); o0.w = pk2(acc[6], acc[7]);
      o1.x = pk2(acc[8], acc[9]); o1.y = pk2(acc[10], acc[11]); o1.z = pk2(acc[12], acc[13]); o1.w = pk2(acc[14], acc[15]);
      *(LAS v4u*)(XCB + tok * 272 + cg * 2) = o0; *(LAS v4u*)(XCB + tok * 272 + cg * 2 + 16) = o1; }
    asm volatile("s_waitcnt lgkmcnt(0)" ::: "memory"); __builtin_amdgcn_s_barrier(); asm volatile("" ::: "memory");
    { const int rt = wave & 3, chalf = wave >> 2, fr = lane & 15, fq = lane >> 4;
      f32x4_t ar[4], ai[4];
#pragma unroll
      for (int nt = 0; nt < 4; ++nt) { ar[nt] = (f32x4_t){0.f, 0.f, 0.f, 0.f}; ai[nt] = (f32x4_t){0.f, 0.f, 0.f, 0.f}; }
#pragma unroll
      for (int ks = 0; ks < 4; ++ks) {
          const bf16x8 xa = *(const LAS bf16x8*)(XCB + (16 * rt + fr) * 272 + (32 * ks + 8 * fq) * 2);
#pragma unroll
          for (int nt = 0; nt < 4; ++nt) {
              const bf16x8 wr = *(const LAS bf16x8*)(WL + (64 * chalf + 16 * nt + fr) * 256 + (((4 * ks + fq) ^ fr) << 4));
              const bf16x8 wi = *(const LAS bf16x8*)(WL + (128 + 64 * chalf + 16 * nt + fr) * 256 + (((4 * ks + fq) ^ fr) << 4));
              ar[nt] = __builtin_amdgcn_mfma_f32_16x16x32_bf16(wr, xa, ar[nt], 0, 0, 0);
              ai[nt] = __builtin_amdgcn_mfma_f32_16x16x32_bf16(wi, xa, ai[nt], 0, 0, 0); } }
      const int tok = 16 * rt + fr;
#pragma unroll
      for (int nt = 0; nt < 4; ++nt) { const int cl = 64 * chalf + 16 * nt + 4 * fq, chg = hd * 128 + cl;
          const f32x4_t br = *(const LAS f32x4_t*)(PT + 5 * 128 + cl), bi = *(const LAS f32x4_t*)(PT + 6 * 128 + cl), lm = *(const LAS f32x4_t*)(PT + 7 * 128 + cl);
          const f32x4_t xc = *(LAS f32x4_t*)(XCF + tok * 128 + cl); f32x4_t av, uv;
#pragma unroll
          for (int e = 0; e < 4; ++e) { const float r = sigmoid_(ar[nt][e] + br[e]), ig = sigmoid_(ai[nt][e] + bi[e]);
              const float la = r * lm[e]; const float a = __expf(la); const float x2 = 2.0f * la;
              const float om = x2 > -0.1f ? -x2 * (1.0f + x2 * (0.5f + x2 * (0.16666667f + x2 * 0.041666667f))) : 1.0f - a * a;
              av[e] = a; uv[e] = sqrtf(om) * (ig * xc[e]); }
          *(LAS f32x4_t*)(AF + tok * 128 + cl) = av; *(LAS f32x4_t*)(XCF + tok * 128 + cl) = uv; } }
    asm volatile("s_waitcnt lgkmcnt(0)" ::: "memory"); __builtin_amdgcn_s_barrier(); asm volatile("" ::: "memory");
    { const int ch = tid & 127, q = tid >> 7; float hl[16], pl[16]; float h = 0.f, p = 1.f;
#pragma unroll
      for (int i = 0; i < 16; ++i) { const float a = AF[(16 * q + i) * 128 + ch], u = XCF[(16 * q + i) * 128 + ch]; h = a * h + u; p *= a; hl[i] = h; pl[i] = p; }
      QS[(q * 128 + ch) * 2] = p; QS[(q * 128 + ch) * 2 + 1] = h;
      asm volatile("s_waitcnt lgkmcnt(0)" ::: "memory"); __builtin_amdgcn_s_barrier(); asm volatile("" ::: "memory");
      float carry = 0.f, cump = 1.f;
      for (int q2 = 0; q2 < q; ++q2) { const float pq = QS[(q2 * 128 + ch) * 2], hq = QS[(q2 * 128 + ch) * 2 + 1]; carry = pq * carry + hq; cump *= pq; }
      bf16_t* HL = (bf16_t*)(F.ws + WS_HLOC) + (size_t)(r0 + 16 * q) * 1024 + hd * 128 + ch; bf16_t* CA = (bf16_t*)(F.ws + WS_CUMA) + (size_t)(r0 + 16 * q) * 1024 + hd * 128 + ch;
#pragma unroll
      for (int i = 0; i < 16; ++i) { hl[i] += pl[i] * carry; pl[i] *= cump; HL[(size_t)i * 1024] = (bf16_t)f2bf(hl[i]); CA[(size_t)i * 1024] = (bf16_t)f2bf(pl[i]); }
      if (q == 3) { float* LS = (float*)(F.ws + WS_LSUM) + ((size_t)(b * 64 + c) * 1024 + hd * 128 + ch) * 2; LS[0] = pl[15]; LS[1] = hl[15]; } }
    asm volatile("s_waitcnt lgkmcnt(0)" ::: "memory"); __builtin_amdgcn_s_barrier(); asm volatile("" ::: "memory");
}
__device__ __forceinline__ void lru_fix_item(Ctx& F, int item) {
    const int tid = fresh_tid(F.wave);
    const int c = item & 63, b = item >> 6; const int ch = 2 * tid;
    const float* LS = (const float*)(F.ws + WS_LSUM) + ((size_t)(b * 64) * 1024 + ch) * 2;
    float c0 = 0.f, c1 = 0.f;
    { int c2 = 0;
      for (; c2 + 8 <= c; c2 += 8) { f32x4_t v[8];
#pragma unroll
          for (int i = 0; i < 8; ++i) v[i] = *(const GAS f32x4_t*)(LS + (size_t)(c2 + i) * 2048);
#pragma unroll
          for (int i = 0; i < 8; ++i) { c0 = v[i].x * c0 + v[i].y; c1 = v[i].z * c1 + v[i].w; } }
      for (; c2 < c; ++c2) { const f32x4_t v = *(const GAS f32x4_t*)(LS + (size_t)c2 * 2048); c0 = v.x * c0 + v.y; c1 = v.z * c1 + v.w; } }
    const int r0 = b * SEQ + c * 64;
    const bf16_t* HL = (const bf16_t*)(F.ws + WS_HLOC) + (size_t)r0 * 1024 + ch; const bf16_t* CA = (const bf16_t*)(F.ws + WS_CUMA) + (size_t)r0 * 1024 + ch;
    const bf16_t* G = (const bf16_t*)(F.ws + WS_PROJ) + (size_t)r0 * HY_NP + 1024 + ch; bf16_t* Y = (bf16_t*)(F.ws + WS_YMIX) + (size_t)r0 * 2048 + ch;
#pragma unroll 1
    for (int i0 = 0; i0 < 64; i0 += 8) {
        unsigned hv[8], cv[8], gw[8];
#pragma unroll
        for (int k = 0; k < 8; ++k) { hv[k] = __builtin_nontemporal_load((const GAS unsigned*)(HL + (size_t)(i0 + k) * 1024)); cv[k] = __builtin_nontemporal_load((const GAS unsigned*)(CA + (size_t)(i0 + k) * 1024)); gw[k] = *(const GAS unsigned*)(G + (size_t)(i0 + k) * HY_NP); }
#pragma unroll
        for (int k = 0; k < 8; ++k) { const float h0 = bflo(hv[k]) + bflo(cv[k]) * c0, h1 = bfhi(hv[k]) + bfhi(cv[k]) * c1;
            const float o0 = h0 * gelu_tanh_fast(bflo(gw[k])), o1 = h1 * gelu_tanh_fast(bfhi(gw[k]));
            if (F8_HY_OUT) *(GAS unsigned short*)(F.ws + WS_YMIX8 + (size_t)(r0 + i0 + k) * 2048 + ch) = (unsigned short)__builtin_amdgcn_cvt_pk_fp8_f32(__builtin_amdgcn_fmed3f(4.0f * o0, -448.f, 448.f), __builtin_amdgcn_fmed3f(4.0f * o1, -448.f, 448.f), 0, false);
            else *(GAS unsigned*)(Y + (size_t)(i0 + k) * 2048) = pk2(o0, o1); } }
}
constexpr int SSD_LP = 136;
template <int NT> __device__ __forceinline__ void ssd_conv_load(const bf16_t* P, int row0, int s0, v4u (&xw)[NT + 3][2]) {
#pragma unroll
    for (int r = 0; r < NT + 3; ++r) { const bool ok = s0 - 3 + r >= 0;
        const GAS v4u* xr = (const GAS v4u*)(P + (size_t)(ok ? row0 - 3 + r : row0) * SS_NP); xw[r][0] = xr[0]; xw[r][1] = xr[1]; }
}
template <int NT, int WS = 768> __device__ __forceinline__ void ssd_conv_math(const v4u (&xr)[NT + 3][2], int s0, const LAS float* wl, float (&o)[NT][16]) {
    unsigned xw[NT + 3][8];
#pragma unroll
    for (int r = 0; r < NT + 3; ++r) { const unsigned m = (r >= 3 || s0 - 3 + r >= 0) ? 0xffffffffu : 0u;
#pragma unroll
        for (int q = 0; q < 8; ++q) xw[r][q] = xr[r][q >> 2][q & 3] & m; }
#pragma unroll
    for (int i4 = 0; i4 < 4; ++i4) { const f32x4_t bv = *(const LAS f32x4_t*)(wl + 4 * WS + 4 * i4);
        f32x4_t w[4];
#pragma unroll
        for (int k = 0; k < 4; ++k) w[k] = *(const LAS f32x4_t*)(wl + k * WS + 4 * i4);
#pragma unroll
        for (int t = 0; t < NT; ++t) { float a0 = bv.x, a1 = bv.y, a2 = bv.z, a3 = bv.w;
#pragma unroll
            for (int k = 0; k < 4; ++k) { a0 += bflo(xw[t + k][2 * i4]) * w[k].x; a1 += bfhi(xw[t + k][2 * i4]) * w[k].y; a2 += bflo(xw[t + k][2 * i4 + 1]) * w[k].z; a3 += bfhi(xw[t + k][2 * i4 + 1]) * w[k].w; }
            o[t][4 * i4] = silu_fast2(a0); o[t][4 * i4 + 1] = silu_fast2(a1); o[t][4 * i4 + 2] = silu_fast2(a2); o[t][4 * i4 + 3] = silu_fast2(a3); } }
}
template <int NT, int WS = 768> __device__ __forceinline__ void ssd_conv_tok(const bf16_t* P, int row0, int s0, const LAS float* wl, float (&o)[NT][16]) {
    v4u xw[NT + 3][2]; ssd_conv_load<NT>(P, row0, s0, xw); ssd_conv_math<NT, WS>(xw, s0, wl, o);
}
__device__ __forceinline__ void ssd_load_convw(Ctx& F, int jl, int g, LAS float* WL, int tid) {
    const float* cw = F.in[14] + (size_t)jl * 4 * SSD_CONV; const float* cb = F.in[15] + (size_t)jl * SSD_CONV;
    for (int i = tid; i < 5 * 768; i += NTHR) { const int k = i / 768, jj = i - k * 768; const int ch = jj < 512 ? g * 512 + jj : jj < 640 ? 4096 + g * 128 + (jj - 512) : 5120 + g * 128 + (jj - 640);
        WL[i] = k < 4 ? cw[(size_t)k * SSD_CONV + ch] : cb[ch]; }
}
__device__ __forceinline__ void ssd_states_item(Ctx& F, int jl, int item, int& g_lds) {
    const int tid = fresh_tid(F.wave);
    const int lane = tid & 63, wave = __builtin_amdgcn_readfirstlane(tid >> 6), fr = lane & 15, fq = lane >> 4;
    const int g = item & 7, c = (item >> 3) & 31, b = item >> 8, bc = b * 32 + c, r0 = bc * 128, s0 = c * 128;
    const bf16_t* PROJ = (const bf16_t*)(F.ws + WS_PROJ);
    const float* cw = F.in[14] + (size_t)jl * 4 * SSD_CONV; const float* cb = F.in[15] + (size_t)jl * SSD_CONV;
    LAS unsigned char* BT = F.lds + RING_OFF; LAS unsigned char* XT0 = F.lds + RING_OFF + 34816; LAS float* DTL = (LAS float*)(F.lds + RING_OFF + 104448); LAS float* ACSL = DTL + 1024;
    LAS float* WL = (LAS float*)(F.lds + RING_OFF + 112640);
    if (g != g_lds) { ssd_load_convw(F, jl, g, WL, tid); g_lds = g; __syncthreads(); }
    {
        const int h = 8 * g + wave; const float A = -__expf(F.in[17][jl * 64 + h]), dtb = F.in[16][jl * 64 + h];
        const int l0 = 2 * lane;
        const float* DTR = (const float*)(F.ws + WS_DTB);
        const float d0 = softplus_(DTR[(size_t)(r0 + l0) * 64 + h] + dtb), d1 = softplus_(DTR[(size_t)(r0 + l0 + 1) * 64 + h] + dtb);
        float sc = (d0 + d1) * A;
#pragma unroll
        for (int o = 1; o < 64; o <<= 1) { const float u = shfl_up_l(sc, o, lane); if (lane >= o) sc += u; }
        const float a1 = sc, a0 = sc - d1 * A;
        DTL[l0 * 8 + wave] = d0; DTL[(l0 + 1) * 8 + wave] = d1; ACSL[l0 * 8 + wave] = a0; ACSL[(l0 + 1) * 8 + wave] = a1;
        float* DTB = (float*)(F.ws + WS_DTB); float* ACSB = (float*)(F.ws + WS_ACSB);
        DTB[(size_t)(r0 + l0) * 64 + h] = d0; DTB[(size_t)(r0 + l0 + 1) * 64 + h] = d1; ACSB[(size_t)(r0 + l0) * 64 + h] = a0; ACSB[(size_t)(r0 + l0 + 1) * 64 + h] = a1;
    }
    {
        const int lp = tid >> 3, cg = (tid & 7) * 16; float o[2][16];
        ssd_conv_tok<2>(PROJ + 8192 + g * 128 + cg, r0 + 2 * lp, s0 + 2 * lp, WL + 512 + cg, o);
#pragma unroll
        for (int i = 0; i < 16; ++i) *(LAS unsigned*)(BT + ((cg + i) * SSD_LP + 2 * lp) * 2) = pk2(o[0][i], o[1][i]);
#pragma unroll
        for (int t = 0; t < 2; ++t) { v4u w0, w1; w0.x = pk2(o[t][0], o[t][1]); w0.y = pk2(o[t][2], o[t][3]); w0.z = pk2(o[t][4], o[t][5]); w0.w = pk2(o[t][6], o[t][7]); w1.x = pk2(o[t][8], o[t][9]); w1.y = pk2(o[t][10], o[t][11]); w1.z = pk2(o[t][12], o[t][13]); w1.w = pk2(o[t][14], o[t][15]);
            GAS v4u* d = (GAS v4u*)((bf16_t*)(F.ws + WS_BS) + (size_t)(r0 + 2 * lp + t) * 1024 + g * 128 + cg); d[0] = w0; d[1] = w1; }
    }
    __syncthreads();
    v4u xwc[5][2];
    { const int hh = tid >> 8, t2 = tid & 255, lp = t2 >> 2, pg = (t2 & 3) * 16; ssd_conv_load<2>(PROJ + 4096 + (8 * g + hh) * 64 + pg, r0 + 2 * lp, s0 + 2 * lp, xwc); }
#pragma unroll 1
    for (int hp = 0; hp < 4; ++hp) {
        LAS unsigned char* XT = XT0 + (hp & 1) * 34816;
        {
            int tq = tid; asm volatile("" : "+v"(tq));
            const int hh = tq >> 8, t2 = tq & 255, lp = t2 >> 2, pg = (t2 & 3) * 16, e = 2 * hp + hh, h = 8 * g + e; float o[2][16];
            ssd_conv_math<2>(xwc, s0 + 2 * lp, WL + e * 64 + pg, o);
            __builtin_amdgcn_sched_barrier(0);
            { const int hn = hp < 3 ? h + 2 : h; ssd_conv_load<2>(PROJ + 4096 + hn * 64 + pg, r0 + 2 * lp, s0 + 2 * lp, xwc); }
            const float al = ACSL[127 * 8 + e]; const float f0 = DTL[(2 * lp) * 8 + e] * __expf(al - ACSL[(2 * lp) * 8 + e]), f1 = DTL[(2 * lp + 1) * 8 + e] * __expf(al - ACSL[(2 * lp + 1) * 8 + e]);
#pragma unroll
            for (int i = 0; i < 16; ++i) *(LAS unsigned*)(XT + hh * 17408 + ((pg + i) * SSD_LP + 2 * lp) * 2) = pk2(o[0][i] * f0, o[1][i] * f1);
#pragma unroll
            for (int t = 0; t < 2; ++t) { v4u w0, w1; w0.x = pk2(o[t][0], o[t][1]); w0.y = pk2(o[t][2], o[t][3]); w0.z = pk2(o[t][4], o[t][5]); w0.w = pk2(o[t][6], o[t][7]); w1.x = pk2(o[t][8], o[t][9]); w1.y = pk2(o[t][10], o[t][11]); w1.z = pk2(o[t][12], o[t][13]); w1.w = pk2(o[t][14], o[t][15]);
                GAS v4u* d = (GAS v4u*)((bf16_t*)(F.ws + WS_XS) + (size_t)(r0 + 2 * lp + t) * 4096 + h * 64 + pg); d[0] = w0; d[1] = w1; }
        }
        asm volatile("s_waitcnt lgkmcnt(0)" ::: "memory"); __builtin_amdgcn_s_barrier(); asm volatile("" ::: "memory");
        {
            int lq = lane; asm volatile("" : "+v"(lq)); const int fr = lq & 15, fq = lq >> 4;
            const int hh = wave >> 2, pt = wave & 3, h = 8 * g + 2 * hp + hh;
            f32x4_t acc[8];
#pragma unroll
            for (int nt = 0; nt < 8; ++nt) acc[nt] = (f32x4_t){0.f, 0.f, 0.f, 0.f};
#pragma unroll
            for (int ks = 0; ks < 4; ++ks) { bf16x8 xa = *(const LAS bf16x8*)(XT + hh * 17408 + ((16 * pt + fr) * SSD_LP + 32 * ks + 8 * fq) * 2), bb[8];
#pragma unroll
                for (int nt = 0; nt < 8; ++nt) bb[nt] = *(const LAS bf16x8*)(BT + ((16 * nt + fr) * SSD_LP + 32 * ks + 8 * fq) * 2);
                asm volatile("s_waitcnt lgkmcnt(0)" : "+v"(xa), "+v"(bb[0]), "+v"(bb[1]), "+v"(bb[2]), "+v"(bb[3]), "+v"(bb[4]), "+v"(bb[5]), "+v"(bb[6]), "+v"(bb[7]));
#pragma unroll
                for (int nt = 0; nt < 8; ++nt) acc[nt] = __builtin_amdgcn_mfma_f32_16x16x32_bf16(bb[nt], xa, acc[nt], 0, 0, 0); }
            bf16_t* ST = (bf16_t*)(F.ws + WS_STATES) + (((size_t)bc * 64 + h) * 64 + 16 * pt + fr) * 128 + 4 * fq;
#pragma unroll
            for (int nt = 0; nt < 8; ++nt) { v2u w; w.x = pk2(acc[nt][0], acc[nt][1]); w.y = pk2(acc[nt][2], acc[nt][3]); *(GAS v2u*)(ST + 16 * nt) = w; }
        }
    }
    __syncthreads();
}
__device__ __forceinline__ void ssd_scan_item(Ctx& F, int item) {
    const int tid = fresh_tid(F.wave);
    const int b = item >> 6, h = item & 63;
    bf16_t* ST = (bf16_t*)(F.ws + WS_STATES) + ((size_t)(b * 32) * 64 + h) * 8192 + 16 * tid; const float* ACSB = (const float*)(F.ws + WS_ACSB) + (size_t)(b * 32) * 128 * 64 + 127 * 64 + h;
    float s[16];
#pragma unroll
    for (int i = 0; i < 16; ++i) s[i] = 0.f;
#pragma unroll 1
    for (int c0 = 0; c0 < 32; c0 += 8) {
        v4u la[8], lb[8]; float dec[8];
#pragma unroll
        for (int k = 0; k < 8; ++k) { const GAS v4u* p = (const GAS v4u*)(ST + (size_t)(c0 + k) * 64 * 8192); la[k] = __builtin_nontemporal_load(p); lb[k] = __builtin_nontemporal_load(p + 1); dec[k] = ACSB[(size_t)(c0 + k) * 128 * 64]; }
#pragma unroll
        for (int k = 0; k < 8; ++k) { GAS v4u* p = (GAS v4u*)(ST + (size_t)(c0 + k) * 64 * 8192); const float d = __expf(dec[k]);
            const unsigned w[8] = {la[k].x, la[k].y, la[k].z, la[k].w, lb[k].x, lb[k].y, lb[k].z, lb[k].w}; v4u o0, o1;
            o0.x = pk2(s[0], s[1]); o0.y = pk2(s[2], s[3]); o0.z = pk2(s[4], s[5]); o0.w = pk2(s[6], s[7]); o1.x = pk2(s[8], s[9]); o1.y = pk2(s[10], s[11]); o1.z = pk2(s[12], s[13]); o1.w = pk2(s[14], s[15]);
            p[0] = o0; p[1] = o1;
#pragma unroll
            for (int i = 0; i < 8; ++i) { s[2 * i] = s[2 * i] * d + bflo(w[i]); s[2 * i + 1] = s[2 * i + 1] * d + bfhi(w[i]); } }
    }
}
__device__ __forceinline__ void ssd_y_item(Ctx& F, int jl, int item, int& g_lds) {
    const int tid = fresh_tid(F.wave);
    const int lane = tid & 63, wave = F.wave, fr = lane & 15, fq = lane >> 4;
    const int g = item & 7, c = (item >> 3) & 31, b = item >> 8, bc = b * 32 + c, r0 = bc * 128, s0 = c * 128;
    const bf16_t* PROJ = (const bf16_t*)(F.ws + WS_PROJ);
    const float* cw = F.in[14] + (size_t)jl * 4 * SSD_CONV; const float* cb = F.in[15] + (size_t)jl * SSD_CONV;
    LAS unsigned char* CT = F.lds + RING_OFF; LAS unsigned char* BN = F.lds + RING_OFF + 34816; LAS unsigned char* MT = BN;
    LAS unsigned char* XT = F.lds + RING_OFF + 69632;
    LAS unsigned char* PV = F.lds + RING_OFF + 104448;
    LAS float* DTL = (LAS float*)(F.lds + RING_OFF + 139264); LAS float* ACSL = DTL + 1024; LAS float* WL = (LAS float*)(F.lds + RING_OFF + 147456); LAS float* NG = WL + 5 * 128;
    LAS float* DPL = NG + 512;
    if (g != g_lds) { const float* cwg = F.in[14] + (size_t)jl * 4 * SSD_CONV + 5120 + g * 128; const float* cbg = F.in[15] + (size_t)jl * SSD_CONV + 5120 + g * 128;
        for (int i = tid; i < 5 * 128; i += NTHR) { const int k = i >> 7, jj = i & 127; WL[i] = k < 4 ? cwg[(size_t)k * SSD_CONV + jj] : cbg[jj]; }
        NG[tid] = F.in[19][(size_t)jl * 4096 + g * 512 + tid];
        g_lds = g; }
    __syncthreads();
    {
        const float* DTB = (const float*)(F.ws + WS_DTB); const float* ACSB = (const float*)(F.ws + WS_ACSB);
#pragma unroll
        for (int i = 0; i < 2; ++i) { const int idx = tid + 512 * i, l = idx >> 3, e = idx & 7; DTL[e * 128 + l] = DTB[(size_t)(r0 + l) * 64 + 8 * g + e]; ACSL[e * 128 + l] = 1.4426950408889634f * ACSB[(size_t)(r0 + l) * 64 + 8 * g + e]; }
        if (tid < 8) DPL[tid] = F.in[18][jl * 64 + 8 * g + tid];
    }
    {
        const int l = tid >> 2, cg = (tid & 3) * 32;
#pragma unroll
        for (int hf = 0; hf < 2; ++hf) { float o[1][16];
            ssd_conv_tok<1, 128>(PROJ + 9216 + g * 128 + cg + 16 * hf, r0 + l, s0 + l, WL + cg + 16 * hf, o);
            v4u w0, w1; w0.x = pk2(o[0][0], o[0][1]); w0.y = pk2(o[0][2], o[0][3]); w0.z = pk2(o[0][4], o[0][5]); w0.w = pk2(o[0][6], o[0][7]); w1.x = pk2(o[0][8], o[0][9]); w1.y = pk2(o[0][10], o[0][11]); w1.z = pk2(o[0][12], o[0][13]); w1.w = pk2(o[0][14], o[0][15]);
            *(LAS v4u*)(CT + (l * SSD_LP + cg + 16 * hf) * 2) = w0; *(LAS v4u*)(CT + (l * SSD_LP + cg + 16 * hf) * 2 + 16) = w1;
            const GAS v4u* bs = (const GAS v4u*)((const bf16_t*)(F.ws + WS_BS) + (size_t)(r0 + l) * 1024 + g * 128 + cg + 16 * hf);
            *(LAS v4u*)(BN + (l * SSD_LP + cg + 16 * hf) * 2) = bs[0]; *(LAS v4u*)(BN + (l * SSD_LP + cg + 16 * hf) * 2 + 16) = bs[1]; }
    }
    const int lp = tid >> 3, pg = (tid & 7) * 8, l0 = 2 * lp; const int l = 16 * wave + fr, row = r0 + l;
    const bf16_t* xsrc = (const bf16_t*)(F.ws + WS_XS) + (size_t)(r0 + l0) * 4096 + (8 * g) * 64 + pg;
    const bf16_t* psrc = (const bf16_t*)(F.ws + WS_STATES) + (((size_t)bc * 64 + 8 * g) * 64 + (tid >> 3)) * 128 + (tid & 7) * 16;
    const bf16_t* zsrc = PROJ + (size_t)row * SS_NP + (8 * g) * 64 + 4 * fq;
    v4u xraw[2], pvr[2]; v2u zc[4];
#define SSD_PREFETCH(e_) do { xraw[0] = *(const GAS v4u*)(xsrc + (e_) * 64); xraw[1] = *(const GAS v4u*)(xsrc + 4096 + (e_) * 64); \
        pvr[0] = *(const GAS v4u*)(psrc + (size_t)(e_) * 8192); pvr[1] = *(const GAS v4u*)(psrc + (size_t)(e_) * 8192 + 8); } while (0)
#define SSD_PREFETCH_Z(e_) do { _Pragma("unroll") for (int pt_ = 0; pt_ < 4; ++pt_) zc[pt_] = *(const GAS v2u*)(zsrc + (e_) * 64 + 16 * pt_); } while (0)
    SSD_PREFETCH(0); SSD_PREFETCH_Z(0);
    __syncthreads();
    f32x4_t cbt[8];
#pragma unroll
    for (int st = 0; st < 8; ++st) cbt[st] = (f32x4_t){0.f, 0.f, 0.f, 0.f};
#pragma unroll
    for (int ks = 0; ks < 4; ++ks) { bf16x8 cf = *(const LAS bf16x8*)(CT + ((16 * wave + fr) * SSD_LP + 32 * ks + 8 * fq) * 2), bf[8];
#pragma unroll
        for (int st = 0; st < 8; ++st) bf[st] = *(const LAS bf16x8*)(BN + ((16 * st + fr) * SSD_LP + 32 * ks + 8 * fq) * 2);
        asm volatile("s_waitcnt lgkmcnt(0)" : "+v"(cf), "+v"(bf[0]), "+v"(bf[1]), "+v"(bf[2]), "+v"(bf[3]), "+v"(bf[4]), "+v"(bf[5]), "+v"(bf[6]), "+v"(bf[7]));
#pragma unroll
        for (int st = 0; st < 8; ++st) if (st <= wave) cbt[st] = __builtin_amdgcn_mfma_f32_16x16x32_bf16(bf[st], cf, cbt[st], 0, 0, 0); }
    __syncthreads();
    float ssq = 0.f; bf16_t* YN = (bf16_t*)(F.ws + WS_YN) + (size_t)row * 4096;
    v2u ykeep[8][4];
#pragma unroll
    for (int i = 0; i < 8; ++i)
#pragma unroll
        for (int pt = 0; pt < 4; ++pt) ykeep[i][pt] = (v2u){0u, 0u};
#pragma unroll 1
    for (int e = 0; e < 8; ++e) {
        const int h = 8 * g + e; LAS unsigned char* XTe = XT + (e & 1) * 17408; LAS unsigned char* PVe = PV + (e & 1) * 17408;
        float sz[16];
#pragma unroll
        for (int pt = 0; pt < 4; ++pt) { const v2u zw = zc[pt]; sz[4 * pt] = silu_fast2(bflo(zw.x)); sz[4 * pt + 1] = silu_fast2(bfhi(zw.x)); sz[4 * pt + 2] = silu_fast2(bflo(zw.y)); sz[4 * pt + 3] = silu_fast2(bfhi(zw.y)); }
        int wv = wave; asm volatile("" : "+s"(wv));
        {
            const float f0 = DTL[e * 128 + l0], f1 = DTL[e * 128 + l0 + 1];
            const unsigned xa[4] = {xraw[0].x, xraw[0].y, xraw[0].z, xraw[0].w}, xb[4] = {xraw[1].x, xraw[1].y, xraw[1].z, xraw[1].w};
#pragma unroll
            for (int i = 0; i < 4; ++i) { *(LAS unsigned*)(XTe + ((pg + 2 * i) * SSD_LP + l0) * 2) = pk2(bflo(xa[i]) * f0, bflo(xb[i]) * f1); *(LAS unsigned*)(XTe + ((pg + 2 * i + 1) * SSD_LP + l0) * 2) = pk2(bfhi(xa[i]) * f0, bfhi(xb[i]) * f1); }
            *(LAS v4u*)(PVe + ((tid >> 3) * SSD_LP + (tid & 7) * 16) * 2) = pvr[0]; *(LAS v4u*)(PVe + ((tid >> 3) * SSD_LP + (tid & 7) * 16) * 2 + 16) = pvr[1];
        }
        if (e < 7) { SSD_PREFETCH(e + 1); SSD_PREFETCH_Z(e + 1); }
        {
            const float al = ACSL[e * 128 + l]; const float dsk = DPL[e] * __builtin_amdgcn_rcpf(DTL[e * 128 + l]);
            f32x4_t asv[8];
#pragma unroll
            for (int st = 0; st < 8; ++st) asv[st] = *(const LAS f32x4_t*)(ACSL + e * 128 + 16 * st + 4 * fq);
            asm volatile("s_waitcnt lgkmcnt(0)" : "+v"(asv[0]), "+v"(asv[1]), "+v"(asv[2]), "+v"(asv[3]), "+v"(asv[4]), "+v"(asv[5]), "+v"(asv[6]), "+v"(asv[7]));
#pragma unroll
            for (int st = 0; st < 8; ++st) if (st <= (wv | 1)) { float m[4];
                const f32x4_t as4 = asv[st];
                if (st < wv) {
#pragma unroll
                    for (int i = 0; i < 4; ++i) m[i] = cbt[st][i] * __builtin_amdgcn_exp2f(al - as4[i]);
                } else {
#pragma unroll
                    for (int i = 0; i < 4; ++i) { const int s = 16 * st + 4 * fq + i; float v = s <= l ? cbt[st][i] * __builtin_amdgcn_exp2f(al - as4[i]) : 0.f; if (s == l) v += dsk; m[i] = v; } }
                v2u w; w.x = pk2(m[0], m[1]); w.y = pk2(m[2], m[3]); *(LAS v2u*)(MT + (l * SSD_LP + 16 * st + 4 * fq) * 2) = w; }
        }
        asm volatile("s_waitcnt lgkmcnt(0)" ::: "memory"); __builtin_amdgcn_s_barrier(); asm volatile("" ::: "memory");
        f32x4_t yd[4], yo[4];
#pragma unroll
        for (int pt = 0; pt < 4; ++pt) { yd[pt] = (f32x4_t){0.f, 0.f, 0.f, 0.f}; yo[pt] = (f32x4_t){0.f, 0.f, 0.f, 0.f}; }
        LAS unsigned char* pvl = PVe + (fr * SSD_LP + 8 * fq) * 2; LAS unsigned char* xtl = XTe + (fr * SSD_LP + 8 * fq) * 2; LAS unsigned char* ctl = CT + (l * SSD_LP + 8 * fq) * 2; LAS unsigned char* mtl = MT + (l * SSD_LP + 8 * fq) * 2;
        asm volatile("" : "+v"(pvl), "+v"(xtl), "+v"(ctl), "+v"(mtl));
#pragma unroll
        for (int ks = 0; ks < 4; ++ks) {
            const bool dk = 2 * ks <= wv;
            bf16x8 cf = *(const LAS bf16x8*)(ctl + 64 * ks), mf = *(const LAS bf16x8*)(mtl + 64 * ks), pf[4], xf[4];
#pragma unroll
            for (int pt = 0; pt < 4; ++pt) { pf[pt] = *(const LAS bf16x8*)(pvl + (16 * pt * SSD_LP + 32 * ks) * 2); xf[pt] = *(const LAS bf16x8*)(xtl + (16 * pt * SSD_LP + 32 * ks) * 2); }
            asm volatile("s_waitcnt lgkmcnt(0)" : "+v"(cf), "+v"(mf), "+v"(pf[0]), "+v"(pf[1]), "+v"(pf[2]), "+v"(pf[3]), "+v"(xf[0]), "+v"(xf[1]), "+v"(xf[2]), "+v"(xf[3]));
#pragma unroll
            for (int pt = 0; pt < 4; ++pt) yo[pt] = __builtin_amdgcn_mfma_f32_16x16x32_bf16(pf[pt], cf, yo[pt], 0, 0, 0);
            if (dk) {
#pragma unroll
                for (int pt = 0; pt < 4; ++pt) yd[pt] = __builtin_amdgcn_mfma_f32_16x16x32_bf16(xf[pt], mf, yd[pt], 0, 0, 0); }
        }
        {
            const float ea = __builtin_amdgcn_exp2f(ACSL[e * 128 + l]); v2u ynew[4];
#pragma unroll
            for (int pt = 0; pt < 4; ++pt) {
                const float y0 = (yd[pt][0] + ea * yo[pt][0]) * sz[4 * pt], y1 = (yd[pt][1] + ea * yo[pt][1]) * sz[4 * pt + 1];
                const float y2 = (yd[pt][2] + ea * yo[pt][2]) * sz[4 * pt + 2], y3 = (yd[pt][3] + ea * yo[pt][3]) * sz[4 * pt + 3];
                ssq += (y0 * y0 + y1 * y1) + (y2 * y2 + y3 * y3); v2u w; w.x = pk2(y0, y1); w.y = pk2(y2, y3); ynew[pt] = w; }
#pragma unroll
            for (int i = 0; i < 7; ++i)
#pragma unroll
                for (int pt = 0; pt < 4; ++pt) ykeep[i][pt] = ykeep[i + 1][pt];
#pragma unroll
            for (int pt = 0; pt < 4; ++pt) ykeep[7][pt] = ynew[pt];
        }

    }
#undef SSD_PREFETCH
#undef SSD_PREFETCH_Z
    ssq += shfl_xor_l(ssq, 16, lane); ssq += shfl_xor_l(ssq, 32, lane);
    const float rstd = 1.0f / sqrtf(ssq * (1.0f / 512.0f) + RMS_EPS);
    const float* ng = F.in[19] + (size_t)jl * 4096;
#pragma unroll
    for (int e = 0; e < 8; ++e)
#pragma unroll
        for (int pt = 0; pt < 4; ++pt) { const int ch = (8 * g + e) * 64 + 16 * pt + 4 * fq; const f32x4_t gv = *(const LAS f32x4_t*)(NG + e * 64 + 16 * pt + 4 * fq); const v2u yk = ykeep[e][pt];
            if (F8_SS_OUT) { const f32x4_t yv = {bflo(yk.x) * rstd * gv.x, bfhi(yk.x) * rstd * gv.y, bflo(yk.y) * rstd * gv.z, bfhi(yk.y) * rstd * gv.w}; *(GAS int*)(F.ws + WS_YN8 + (size_t)row * 4096 + ch) = pk_fp8x4(yv, 4.0f); }
            else { v2u w; w.x = pk2(bflo(yk.x) * rstd * gv.x, bfhi(yk.x) * rstd * gv.y); w.y = pk2(bflo(yk.y) * rstd * gv.z, bfhi(yk.y) * rstd * gv.w);
            *(GAS v2u*)(YN + ch) = w; } }
    __syncthreads();
}
template <int NT> __device__ __forceinline__ void skinny_proj(Ctx& F, const bf16_t* Wt, float* OUT, int NOUT) {
    const int tid = fresh_tid(F.wave); const int lane = tid & 63, fr = lane & 15, fq = lane >> 4, wave = F.wave;
    const bf16_t* XB = (const bf16_t*)(F.ws + WS_XB); LAS float* PART = (LAS float*)(F.lds + RING_OFF);
    const bf16_t* bp = Wt + (size_t)fr * D + 256 * wave + 8 * fq;
    bf16x8 wb[NT][8];
#pragma unroll
    for (int n = 0; n < NT; ++n)
#pragma unroll
        for (int ks = 0; ks < 8; ++ks) wb[n][ks] = *(const GAS bf16x8*)(bp + (size_t)n * 16 * D + 32 * ks);
    for (int rt = blockIdx.x; rt < T / 16; rt += F.G) {
        const bf16_t* ap = XB + (size_t)(rt * 16 + fr) * D + 256 * wave + 8 * fq;
        bf16x8 xa[8];
#pragma unroll
        for (int ks = 0; ks < 8; ++ks) xa[ks] = *(const GAS bf16x8*)(ap + 32 * ks);
#pragma unroll
        for (int n = 0; n < NT; ++n) {
            f32x4 acc = (f32x4){0.f, 0.f, 0.f, 0.f};
#pragma unroll
            for (int ks = 0; ks < 8; ++ks) acc = __builtin_amdgcn_mfma_f32_16x16x32_bf16(wb[n][ks], xa[ks], acc, 0, 0, 0);
            *(LAS f32x4*)(PART + (wave * 16 + fr) * (16 * NT) + 16 * n + 4 * fq) = acc; }
        __syncthreads();
        for (int o = tid; o < 16 * 16 * NT; o += NTHR) { const int r = o / (16 * NT), cidx = o - r * (16 * NT); float a = 0.f;
#pragma unroll
            for (int w = 0; w < 8; ++w) a += PART[(w * 16 + r) * (16 * NT) + cidx];
            if (cidx < NOUT) OUT[(size_t)(rt * 16 + r) * NOUT + cidx] = a; }
        __syncthreads();
    }
}
struct Params { const float* in[28]; float* out; unsigned char* ws; int layer_lo, layer_hi, st_lo, st_hi, bar_region, pad; };
constexpr int N_STEPS = 13;
#ifndef MK_ONE_LAUNCH
#define MK_ONE_LAUNCH 1
#endif
__host__ __device__ constexpr bool step_active(int layer, int k) {
    if (k == 5 || k == 6 || k == 9) return false;
    return (layer & 1) ? true : k != 4;
}
#define VB_LOOP(n) for (size_t vb = blockIdx.x; vb < (size_t)(n); vb += gridDim.x)
#ifndef PROBE_REP_MASK
#define PROBE_REP_MASK 0
#endif
#define REPS(k) _Pragma("unroll 1") for (int rep_ = 0; rep_ < (((PROBE_REP_MASK >> (k)) & 1) ? 2 : 1); ++rep_)
__global__ void __launch_bounds__(NTHR, 2) mk_fwd(Params args) {
    extern __shared__ __attribute__((aligned(16))) unsigned char lds_raw[];
    Ctx F;
    F.lds = (LAS unsigned char*)lds_raw; F.MISC = (volatile LAS unsigned*)(F.lds + MISC_OFF);
    F.wave = __builtin_amdgcn_readfirstlane((int)threadIdx.x >> 6); F.tid = fresh_tid(F.wave); F.lane = F.tid & 63;
    F.G = gridDim.x; { const int bx = blockIdx.x; F.vcu = (F.G % 8 == 0) ? (bx % 8) * (F.G / 8) + bx / 8 : bx; }
#pragma unroll
    for (int i = 0; i < 28; ++i) F.in[i] = args.in[i];
    F.out = args.out; F.ws = args.ws; F.ctl = (gu32*)(args.ws + WS_CTL);
    for (int u = F.tid; u < (LDS_BYTES - LDSCTL_OFF) / 4; u += NTHR) ((LAS unsigned*)(F.lds + LDSCTL_OFF))[u] = 0u;
    __syncthreads();
    XcdBarrier bar; bar.bar = (unsigned*)(F.ctl + CW_BAR); bar.x = 0; bar.st = nullptr;
    const bool has_bar = args.bar_region >= 0;
    if (has_bar) bar = xcd_barrier_post((unsigned*)(F.ctl + CW_BAR) + args.bar_region * XCD_BAR_WORDS, F.MISC + 8, F.tid);
    const int lo = args.st_lo, hi = args.st_hi;
#ifdef STEP_MASK
#define IN(k) (((STEP_MASK >> (k)) & 1) && lo <= (k) && (k) < hi && step_active(layer, (k)))
#else
#define IN(k) (lo <= (k) && (k) < hi && step_active(layer, (k)))
#endif
#define SEAM(k) do { bool more_ = layer + 1 < args.layer_hi; for (int k2 = (k) + 1; k2 < hi; ++k2) more_ = more_ || step_active(layer, k2); if (has_bar && more_) { const int bt_ = fresh_tid(F.wave); xcd_barrier(bar, bt_); if ((PROBE_REP_MASK >> 13) & 1) xcd_barrier(bar, bt_); } } while (0)
#define FRESH() do { F.tid = fresh_tid(F.wave); F.lane = F.tid & 63; } while (0)
    for (int layer = args.layer_lo; layer < args.layer_hi; ++layer) {
        const int j = layer >> 1; const bool even = (layer & 1) == 0;
        if (IN(0)) { FRESH(); REPS(0) s0_convert(F, layer); if (layer == 0 || hi <= 1) SEAM(0); else __syncthreads(); }
        if (IN(1)) {
            if (even ? F8_HY_IN : F8_SS_IN) {
                pg8::Gemm g{(const pg8::bf16_t*)(F.ws + WS_XIN8), even ? (const pg8::bf16_t*)(F.ws + WS_WHYIN8 + (size_t)j * 5120 * 2048) : (const pg8::bf16_t*)(F.ws + WS_WSSIN8 + (size_t)j * 10240 * 2048), T, even ? 5120 : 10240, D / 2};
                pg8::StaticOrder S; S.init(T, g.N, F.G, (int)blockIdx.x);
                pg8::EpiBf16P8 E{(pg8::bf16_t*)(F.ws + WS_PROJ), even ? HY_NP : SS_NP, 1.0f / 512.0f};
                REPS(1) pg8::gemm_phase<pg8::EpiBf16P8, pg8::StaticOrder, PG8_ALIGN, PG8_SP2>(F.lds + RING_OFF, g, S, E, F.wave);
            } else {
                pg8::Gemm g{(const pg8::bf16_t*)(F.ws + WS_XB), even ? (const pg8::bf16_t*)(F.ws + WS_WHYIN) + (size_t)j * HY_NP * 2048 : (const pg8::bf16_t*)(F.ws + WS_WSSIN) + (size_t)j * SS_NP * 2048, T, even ? 5120 : 10240, D};
                pg8::StaticOrder S; S.init(T, g.N, F.G, (int)blockIdx.x);
                pg8::EpiBf16P E{(pg8::bf16_t*)(F.ws + WS_PROJ), even ? HY_NP : SS_NP, 1.0f};
                REPS(1) pg8::gemm_phase<pg8::EpiBf16P, pg8::StaticOrder, PG8_ALIGN, PG8_SP2>(F.lds + RING_OFF, g, S, E, F.wave);
            }
            if (even) skinny_proj<1>(F, (const bf16_t*)(F.ws + WS_WHYIN) + ((size_t)j * HY_NP + 5120) * 2048, (float*)(F.ws + WS_FCUM), 8);
            else skinny_proj<4>(F, (const bf16_t*)(F.ws + WS_WSSIN) + ((size_t)j * SS_NP + 10240) * 2048, (float*)(F.ws + WS_DTB), 64);
            SEAM(1);
        }
        if (IN(2)) { FRESH();
            if (even) { const bf16_t* PROJ = (const bf16_t*)(F.ws + WS_PROJ); bf16_t* YMIX = (bf16_t*)(F.ws + WS_YMIX);
                REPS(2) for (int item = F.vcu; item < 256; item += F.G) fox::attn_item((char*)lds_raw, PROJ, (const float*)(F.ws + WS_FCUM), YMIX, F.in[11] + (size_t)j * 8, item, fresh_tid(F.wave));
                { int hd_lds = -1; REPS(3) for (int item = F.vcu; item < 2048; item += F.G) lru_local_item(F, j, item, hd_lds); }
            } else { int g_lds = -1; for (int item = F.vcu; item < 1024; item += F.G) ssd_states_item(F, j, item, g_lds); }
            SEAM(2); }
        if (IN(3)) { FRESH();
            if (even) { REPS(4) for (int item = F.vcu; item < 256; item += F.G) lru_fix_item(F, item); }
            else { for (int item = F.vcu; item < 256; item += F.G) ssd_scan_item(F, item); }
            SEAM(3); }
        if (IN(4)) { FRESH();
            { int g_lds = -1; REPS(6) for (int item = F.vcu; item < 1024; item += F.G) ssd_y_item(F, j, item, g_lds); }
            SEAM(4); }
        if (IN(7)) {
            pg8::StaticOrder S; S.init(T, D, F.G, (int)blockIdx.x);
            if (even ? F8_HY_OUT : F8_SS_OUT) {
                pg8::Gemm g{even ? (const pg8::bf16_t*)(F.ws + WS_YMIX8) : (const pg8::bf16_t*)(F.ws + WS_YN8), even ? (const pg8::bf16_t*)(F.ws + WS_WHYOUT + (size_t)j * 2048 * 2048) : (const pg8::bf16_t*)(F.ws + WS_WSSOUT + (size_t)j * 2048 * 4096), T, D, even ? 1024 : 2048};
                pg8::EpiBf16P8 E{(pg8::bf16_t*)(F.ws + WS_MBUF), D, 1.0f / 512.0f};
                REPS(7) pg8::gemm_phase<pg8::EpiBf16P8, pg8::StaticOrder, PG8_ALIGN, PG8_SP2>(F.lds + RING_OFF, g, S, E, F.wave);
            } else {
                pg8::Gemm g{even ? (const pg8::bf16_t*)(F.ws + WS_YMIX) : (const pg8::bf16_t*)(F.ws + WS_YN), even ? (const pg8::bf16_t*)(F.ws + WS_WHYOUT) + (size_t)j * 2048 * 2048 : (const pg8::bf16_t*)(F.ws + WS_WSSOUT) + (size_t)j * 2048 * 4096, T, D, even ? 2048 : 4096};
                pg8::EpiBf16P E{(pg8::bf16_t*)(F.ws + WS_MBUF), D, 1.0f};
                REPS(7) pg8::gemm_phase<pg8::EpiBf16P, pg8::StaticOrder, PG8_ALIGN, PG8_SP2>(F.lds + RING_OFF, g, S, E, F.wave);
            }
            SEAM(7);
        }
        if (IN(8)) { FRESH(); if ((PROBE_REP_MASK >> 8) & 1) ln1_router<true>(F, layer); ln1_router<false>(F, layer); SEAM(8); }
        if (IN(10)) {
            pg8::MoeGatherOrder S; moe_tables(F, layer, S.tab); const int Gg = moe_gemm_wgs(F, S.tab[16], layer + 1 < DEPTH); S.G = Gg; S.c = (int)blockIdx.x < Gg ? (int)blockIdx.x : 8 * S.tab[16]; S.exptok = (const int*)(F.ws + WS_EXPTOK); S.cnt = (const unsigned*)(F.ctl + CW_CNT + layer * 16); S.cap = T;
            pg8::Gemm g{(const pg8::bf16_t*)(F.ws + WS_XB8), (const pg8::bf16_t*)(F.ws + ((layer & 1) ? WS_WGU_B : WS_WGU)), T, 2048, D / 2};
            pg8::EpiSwiglu E{F.ws + WS_HID, (const float*)(F.ws + WS_EXPW), S.cnt, T, MOE_FF};
            REPS(10) pg8::gemm_phase<pg8::EpiSwiglu, pg8::MoeGatherOrder, PG8_ALIGN, PG8_SP2>(F.lds + RING_OFF, g, S, E, F.wave);
            if (layer + 1 < DEPTH) moe_tail_convert(F, layer + 1, Gg, 0);
            SEAM(10);
        }
        if (IN(11)) {
            pg8::MoeOrder S; moe_tables(F, layer, S.tab); const int Gg = moe_gemm_wgs(F, S.tab[16], layer + 1 < DEPTH); S.G = Gg; S.c = (int)blockIdx.x < Gg ? (int)blockIdx.x : 8 * S.tab[16];
            pg8::Gemm g{(const pg8::bf16_t*)(F.ws + WS_HID), (const pg8::bf16_t*)(F.ws + ((layer & 1) ? WS_WD_B : WS_WD)), MOE_ROWS, 2048, MOE_FF / 2};
            pg8::EpiBf16P8 E{(pg8::bf16_t*)(F.ws + WS_YG), D, 1.0f / 512.0f};
            REPS(11) pg8::gemm_phase<pg8::EpiBf16P8, pg8::MoeOrder, PG8_ALIGN, PG8_SP2>(F.lds + RING_OFF, g, S, E, F.wave);
            if (layer + 1 < DEPTH) moe_tail_convert(F, layer + 1, Gg, 1);
            SEAM(11);
        }
        if (IN(12)) { FRESH(); if ((PROBE_REP_MASK >> 12) & 1) { ln2_phase<true>(F, layer); __syncthreads(); } ln2_phase<false>(F, layer); SEAM(12); }
    }
#undef IN
#undef SEAM
}
extern "C" void kernel_launch(void* const* d_in, const int* in_sizes, int n_in, void* d_out, int out_size, void* d_ws, size_t ws_size, hipStream_t stream) {
    static int grid = 0;
    if (grid == 0) {
        if (n_in != 28 || out_size != T * D || ws_size < WS_END) { fprintf(stderr, "kernel_launch: unexpected shapes (n_in %d out %d ws %zu need %zu)\n", n_in, out_size, ws_size, (size_t)WS_END); grid = -1; return; }
        int dev = 0, cus = 0; (void)hipGetDevice(&dev); (void)hipDeviceGetAttribute(&cus, hipDeviceAttributeMultiprocessorCount, dev);
        if (hipFuncSetAttribute((const void*)mk_fwd, hipFuncAttributeMaxDynamicSharedMemorySize, LDS_BYTES) != hipSuccess) { fprintf(stderr, "kernel_launch: hipFuncSetAttribute failed\n"); grid = -1; return; }
        int per_cu = 0; (void)hipOccupancyMaxActiveBlocksPerMultiprocessor(&per_cu, (const void*)mk_fwd, NTHR, LDS_BYTES); (void)hipGetLastError();
        grid = 256; if (cus != 256 || per_cu < 1) fprintf(stderr, "kernel_launch: built for 256 CUs x 1 workgroup (144 KiB LDS each); device has %d CUs, occupancy query says %d\n", cus, per_cu);
    }
    if (grid < 0) return;
    (void)hipMemsetAsync((char*)d_ws + WS_CTL, 0, CTL_ZERO_BYTES, stream);
    Params a{};
    for (int i = 0; i < 28; ++i) a.in[i] = (const float*)d_in[i];
    a.out = (float*)d_out; a.ws = (unsigned char*)d_ws;
#if MK_ONE_LAUNCH
    a.layer_lo = 0; a.layer_hi = DEPTH; a.st_lo = 0; a.st_hi = N_STEPS; a.bar_region = 0;
    hipLaunchKernelGGL(mk_fwd, dim3(grid), dim3(NTHR), LDS_BYTES, stream, a);
#else
    for (int layer = 0; layer < DEPTH; ++layer)
        for (int s = 0; s < N_STEPS; ++s) if (step_active(layer, s)) {
            a.layer_lo = layer; a.layer_hi = layer + 1; a.st_lo = s; a.st_hi = s + 1; a.bar_region = -1;
            hipLaunchKernelGGL(mk_fwd, dim3(grid), dim3(NTHR), LDS_BYTES, stream, a);
        }
#endif
}
```
